# Optimizing an MI355X kernel written in HIP

```python
import math
import jax, jax.numpy as jnp
from jax import lax
import numpy as np

D_MODEL = 1024
BATCH = 4
SEQ = 8192
DEPTH = 4

HEAD_DIM = 64
SWA_HEADS = 8
SWA_KV_HEADS = 2
SWA_WINDOW = 128
SWA_BLOCK = 128
RNN_WIDTH = D_MODEL
RNN_BLOCKS = 16
RNN_BLOCK_WIDTH = RNN_WIDTH // RNN_BLOCKS
RNN_CONV = 4
RGLRU_C = 8.0
MOBA_HEADS = 8
MOBA_BLOCK = 256
MOBA_TOPK = 3
NUM_BUCKETS = 32
MAX_DISTANCE = 2048
D_FF = 2816
FFN_CONV = 3

RMS_EPS = 1e-6
NEG_INF = -1e30
N_BRANCH = 3
SWA_Q = SWA_HEADS * HEAD_DIM
SWA_KV = SWA_KV_HEADS * HEAD_DIM
MOBA_W = MOBA_HEADS * HEAD_DIM
IN_WIDTHS = (SWA_Q, SWA_KV, SWA_KV, RNN_WIDTH, RNN_WIDTH, MOBA_W, MOBA_W, MOBA_W, N_BRANCH * D_MODEL)
IN_OFFSETS = tuple(sum(IN_WIDTHS[:i + 1]) for i in range(len(IN_WIDTHS) - 1))
D_IN = sum(IN_WIDTHS)
D_MIX = SWA_Q + RNN_WIDTH + MOBA_W

kernel_name = "hybrid_swa_rglru_moba_convffn_trunk"


def rms_norm(x, gain):
    xf = x.astype(jnp.float32)
    y = xf * lax.rsqrt(jnp.mean(xf * xf, axis=-1, keepdims=True) + RMS_EPS)
    return (y * gain.astype(jnp.float32)).astype(x.dtype)


def t5_bucket(dist):
    dist = jnp.maximum(dist, 0)
    max_exact = NUM_BUCKETS // 2
    log_ratio = jnp.log(jnp.maximum(dist, 1).astype(jnp.float32) / max_exact) / math.log(MAX_DISTANCE / max_exact)
    large = max_exact + (log_ratio * (NUM_BUCKETS - max_exact)).astype(jnp.int32)
    large = jnp.minimum(large, NUM_BUCKETS - 1)
    return jnp.where(dist < max_exact, dist, large)


def causal_dwconv(x, w, b):
    k_width = w.shape[0]
    s = x.shape[1]
    xp = jnp.pad(x, ((0, 0), (k_width - 1, 0), (0, 0)))
    return sum(xp[:, k:k + s] * w[k] for k in range(k_width)) + b


def swa_attention(q, k, v, sinks, bias_a):
    b_sz, s_len = q.shape[:2]
    L = SWA_BLOCK
    nblk = s_len // L
    grp = SWA_HEADS // SWA_KV_HEADS
    qb = q.reshape(b_sz, nblk, L, SWA_KV_HEADS, grp, HEAD_DIM)

    def band(t):
        tp = jnp.pad(t, ((0, 0), (L, 0), (0, 0), (0, 0))).reshape(b_sz, nblk + 1, L, SWA_KV_HEADS, HEAD_DIM)
        return jnp.concatenate([tp[:, :-1], tp[:, 1:]], axis=2)

    kb, vb = band(k), band(v)
    s = jnp.einsum('bnqkgd,bnskd->bnkgqs', qb, kb).astype(jnp.float32) * (HEAD_DIM ** -0.5)
    qi = jnp.arange(L)
    sj = jnp.arange(2 * L)
    diff = qi[:, None] + L - sj[None, :]
    bias = bias_a[t5_bucket(diff)].astype(jnp.float32).transpose(2, 0, 1).reshape(SWA_KV_HEADS, grp, L, 2 * L)
    key_pos = jnp.arange(nblk)[:, None] * L - L + sj[None, :]
    valid = ((diff >= 0) & (diff < SWA_WINDOW))[None] & (key_pos >= 0)[:, None, :]
    s = jnp.where(valid[None, :, None, None], s + bias, NEG_INF)
    sink = sinks.astype(jnp.float32).reshape(SWA_KV_HEADS, grp)[:, :, None, None]
    m = jnp.maximum(jnp.max(s, axis=-1, keepdims=True), sink)
    p = jnp.exp(s - m)
    p = p / (jnp.sum(p, axis=-1, keepdims=True) + jnp.exp(sink - m))
    o = jnp.einsum('bnkgqs,bnskd->bnqkgd', p.astype(v.dtype), vb)
    return o.reshape(b_sz, s_len, SWA_Q)


def rg_lru(x, ga_w, ga_b, gx_w, gx_b, lam):
    b_sz, s_len, width = x.shape
    xb = x.reshape(b_sz, s_len, RNN_BLOCKS, RNN_BLOCK_WIDTH)
    r = jax.nn.sigmoid(jnp.einsum('bsnc,ncd->bsnd', xb, ga_w).reshape(b_sz, s_len, width) + ga_b)
    i = jax.nn.sigmoid(jnp.einsum('bsnc,ncd->bsnd', xb, gx_w).reshape(b_sz, s_len, width) + gx_b)
    log_a = -RGLRU_C * r.astype(jnp.float32) * jax.nn.softplus(-lam.astype(jnp.float32))
    a = jnp.exp(log_a)
    mult = jnp.sqrt(-jnp.expm1(2.0 * log_a))
    mult = jnp.where((jnp.arange(s_len) == 0)[None, :, None], 1.0, mult)
    u = mult * (i * x).astype(jnp.float32)

    def combine(left, right):
        a_l, b_l = left
        a_r, b_r = right
        return (a_l * a_r, a_r * b_l + b_r)

    _, h = lax.associative_scan(combine, (a, u), axis=1)
    return h.astype(x.dtype)


def moba_attention(q, k, v, bias_c):
    b_sz, s_len = q.shape[:2]
    MB = MOBA_BLOCK
    nb = -(-s_len // MB)
    s_pad = nb * MB
    pad = ((0, 0), (0, s_pad - s_len), (0, 0), (0, 0))
    q, k, v = jnp.pad(q, pad), jnp.pad(k, pad), jnp.pad(v, pad)
    topk = min(MOBA_TOPK, nb)
    kb = k.reshape(b_sz, nb, MB, MOBA_HEADS, HEAD_DIM)
    vb = v.reshape(b_sz, nb, MB, MOBA_HEADS, HEAD_DIM)
    k_mean = jnp.mean(kb.astype(jnp.float32), axis=2).astype(k.dtype)
    k_bh = kb.transpose(0, 3, 1, 2, 4)
    v_bh = vb.transpose(0, 3, 1, 2, 4)
    q_chunks = q.reshape(b_sz, nb, MB, MOBA_HEADS, HEAD_DIM).transpose(1, 0, 2, 3, 4)
    k_own = kb.transpose(1, 0, 2, 3, 4)
    v_own = vb.transpose(1, 0, 2, 3, 4)
    pos = jnp.arange(MB)
    own_diff = pos[:, None] - pos[None, :]
    own_mask = own_diff >= 0
    own_bias = bias_c[t5_bucket(own_diff)].astype(jnp.float32).transpose(0, 2, 1)
    b_ix = jnp.arange(b_sz)[:, None, None, None]
    h_ix = jnp.arange(MOBA_HEADS)[None, None, :, None]
    blk_ids = jnp.arange(nb)
    scale = HEAD_DIM ** -0.5

    def one_block(args):
        n, q_c, k_c, v_c = args
        gate = jnp.einsum('bqhd,bmhd->bqhm', q_c, k_mean).astype(jnp.float32)
        gate = jnp.where(blk_ids < n, gate, NEG_INF)
        _, sel = lax.top_k(gate, topk)
        sel_valid = sel < n
        k_sel = k_bh[b_ix, h_ix, sel]
        v_sel = v_bh[b_ix, h_ix, sel]
        s_sel = jnp.einsum('bqhd,bqhtsd->bqhts', q_c, k_sel).astype(jnp.float32) * scale
        dist = (n * MB + pos)[None, :, None, None, None] - (sel[..., None] * MB + pos)
        s_sel = s_sel + bias_c[t5_bucket(dist), h_ix[..., None]].astype(jnp.float32)
        s_sel = jnp.where(sel_valid[..., None], s_sel, NEG_INF).reshape(b_sz, MB, MOBA_HEADS, topk * MB)
        s_own = jnp.einsum('bqhd,bshd->bqhs', q_c, k_c).astype(jnp.float32) * scale + own_bias
        s_own = jnp.where(own_mask[:, None, :], s_own, NEG_INF)
        p = jax.nn.softmax(jnp.concatenate([s_sel, s_own], axis=-1), axis=-1).astype(v.dtype)
        p_sel = p[..., :topk * MB].reshape(b_sz, MB, MOBA_HEADS, topk, MB)
        p_own = p[..., topk * MB:]
        return jnp.einsum('bqhts,bqhtsd->bqhd', p_sel, v_sel) + jnp.einsum('bqhs,bshd->bqhd', p_own, v_c)

    o = lax.map(one_block, (blk_ids, q_chunks, k_own, v_own))
    return o.transpose(1, 0, 2, 3, 4).reshape(b_sz, s_pad, MOBA_W)[:, :s_len]


def setup_inputs(seed: int = 0) -> dict:
    key = jax.random.key(seed)
    ks = jax.random.split(key, 32)
    f32 = jnp.float32

    def nrm(k, shape, fan_in, scale=1.0):
        return jax.random.normal(k, shape, f32) * (scale * fan_in ** -0.5)

    def gain(k, shape):
        return 1.0 + 0.05 * jax.random.normal(k, shape, f32)

    def small(k, shape, scale=0.02):
        return scale * jax.random.normal(k, shape, f32)

    a_init = jax.random.uniform(ks[16], (DEPTH, RNN_WIDTH), f32, 0.9, 0.999)
    w_branch = jnp.concatenate([
        nrm(ks[20], (DEPTH, SWA_Q, D_MODEL), SWA_Q),
        nrm(ks[21], (DEPTH, RNN_WIDTH, D_MODEL), RNN_WIDTH),
        nrm(ks[22], (DEPTH, MOBA_W, D_MODEL), MOBA_W)], axis=1)
    return {
        'x': jax.random.normal(ks[0], (BATCH, SEQ, D_MODEL), f32),
        'c': jax.random.normal(ks[1], (BATCH, D_MODEL), f32),
        'w_mod': nrm(ks[2], (DEPTH, D_MODEL, 6 * D_MODEL), D_MODEL, 0.5),
        'b_mod': small(ks[3], (DEPTH, 6 * D_MODEL)),
        'norm_mix': gain(ks[4], (DEPTH, D_MODEL)),
        'norm_ffn': gain(ks[5], (DEPTH, D_MODEL)),
        'w_in': nrm(ks[6], (DEPTH, D_MODEL, D_IN), D_MODEL),
        'qnorm_a': gain(ks[7], (DEPTH, HEAD_DIM)),
        'knorm_a': gain(ks[8], (DEPTH, HEAD_DIM)),
        'sinks': small(ks[9], (DEPTH, SWA_HEADS), 0.5),
        'rnn_conv_w': nrm(ks[10], (DEPTH, RNN_CONV, RNN_WIDTH), RNN_CONV),
        'rnn_conv_b': small(ks[11], (DEPTH, RNN_WIDTH)),
        'rnn_gate_a_w': nrm(ks[12], (DEPTH, RNN_BLOCKS, RNN_BLOCK_WIDTH, RNN_BLOCK_WIDTH), RNN_BLOCK_WIDTH),
        'rnn_gate_a_b': small(ks[13], (DEPTH, RNN_WIDTH)),
        'rnn_gate_x_w': nrm(ks[14], (DEPTH, RNN_BLOCKS, RNN_BLOCK_WIDTH, RNN_BLOCK_WIDTH), RNN_BLOCK_WIDTH),
        'rnn_gate_x_b': small(ks[15], (DEPTH, RNN_WIDTH)),
        'rnn_lambda': jnp.log(a_init) - jnp.log1p(-a_init),
        'qnorm_c': gain(ks[17], (DEPTH, HEAD_DIM)),
        'knorm_c': gain(ks[18], (DEPTH, HEAD_DIM)),
        'rel_bias': small(ks[19], (NUM_BUCKETS, SWA_HEADS + MOBA_HEADS), 0.5),
        'w_branch': w_branch,
        'w_out': nrm(ks[23], (DEPTH, D_MODEL, D_MODEL), D_MODEL),
        'w_up': nrm(ks[24], (DEPTH, D_MODEL, 2 * D_FF), D_MODEL),
        'ffn_conv_w': nrm(ks[25], (DEPTH, FFN_CONV, 2 * D_FF), FFN_CONV),
        'ffn_conv_b': small(ks[26], (DEPTH, 2 * D_FF)),
        'w_down': nrm(ks[27], (DEPTH, D_FF, D_MODEL), D_FF),
    }


def reference(x, c, w_mod, b_mod, norm_mix, norm_ffn, w_in, qnorm_a, knorm_a, sinks,
              rnn_conv_w, rnn_conv_b, rnn_gate_a_w, rnn_gate_a_b, rnn_gate_x_w, rnn_gate_x_b,
              rnn_lambda, qnorm_c, knorm_c, rel_bias, w_branch, w_out, w_up, ffn_conv_w,
              ffn_conv_b, w_down):
    b_sz, s_len, _ = x.shape
    c_act = jax.nn.silu(c)
    bias_a = rel_bias[:, :SWA_HEADS]
    bias_c = rel_bias[:, SWA_HEADS:]
    for l in range(DEPTH):
        mod = (c_act @ w_mod[l] + b_mod[l])[:, None, :]
        shift_m, scale_m, gate_m, shift_f, scale_f, gate_f = jnp.split(mod, 6, axis=-1)

        h = rms_norm(x, norm_mix[l]) * (1.0 + scale_m) + shift_m
        z = h @ w_in[l]
        qa, ka, va, xr, yr, qc, kc, vc, g_logits = jnp.split(z, IN_OFFSETS, axis=-1)

        qa = rms_norm(qa.reshape(b_sz, s_len, SWA_HEADS, HEAD_DIM), qnorm_a[l])
        ka = rms_norm(ka.reshape(b_sz, s_len, SWA_KV_HEADS, HEAD_DIM), knorm_a[l])
        va = va.reshape(b_sz, s_len, SWA_KV_HEADS, HEAD_DIM)
        o_a = swa_attention(qa, ka, va, sinks[l], bias_a)

        xr = causal_dwconv(xr, rnn_conv_w[l], rnn_conv_b[l])
        hr = rg_lru(xr, rnn_gate_a_w[l], rnn_gate_a_b[l], rnn_gate_x_w[l], rnn_gate_x_b[l], rnn_lambda[l])
        o_b = hr * jax.nn.gelu(yr)

        qc = rms_norm(qc.reshape(b_sz, s_len, MOBA_HEADS, HEAD_DIM), qnorm_c[l])
        kc = rms_norm(kc.reshape(b_sz, s_len, MOBA_HEADS, HEAD_DIM), knorm_c[l])
        vc = vc.reshape(b_sz, s_len, MOBA_HEADS, HEAD_DIM)
        o_c = moba_attention(qc, kc, vc, bias_c)

        wb = w_branch[l]
        p_a = o_a @ wb[:SWA_Q]
        p_b = o_b @ wb[SWA_Q:SWA_Q + RNN_WIDTH]
        p_c = o_c @ wb[SWA_Q + RNN_WIDTH:]
        g = jax.nn.sigmoid(g_logits.reshape(b_sz, s_len, N_BRANCH, D_MODEL))
        merged = g[:, :, 0] * p_a + g[:, :, 1] * p_b + g[:, :, 2] * p_c
        x = x + gate_m * (merged @ w_out[l])

        h = rms_norm(x, norm_ffn[l]) * (1.0 + scale_f) + shift_f
        u = causal_dwconv(h @ w_up[l], ffn_conv_w[l], ffn_conv_b[l])
        u_gate, u_val = jnp.split(u, 2, axis=-1)
        x = x + gate_f * ((jax.nn.silu(u_gate) * u_val) @ w_down[l])
    return x
```

```cpp
#include <hip/hip_runtime.h>
#include <hip/hip_cooperative_groups.h>
#include <cstdio>
#include <cstdint>
namespace cg = cooperative_groups;

#define LAS __attribute__((address_space(3)))
typedef unsigned short bf16_t;
typedef short bf16x8 __attribute__((ext_vector_type(8)));
typedef float f32x4 __attribute__((ext_vector_type(4)));
typedef unsigned u32x4 __attribute__((ext_vector_type(4)));
typedef unsigned u32x2 __attribute__((ext_vector_type(2)));
typedef int i32x8 __attribute__((ext_vector_type(8)));
typedef unsigned u32x8 __attribute__((ext_vector_type(8)));

constexpr int NB = 4, SEQ = 8192, DM = 1024, NTOK = NB * SEQ, DEPTH = 4;
constexpr int DIN = 7424, DFF = 2816, DFF2 = 5632;
constexpr int C_QA = 0, C_KA = 512, C_VA = 640, C_XR = 768, C_YR = 1792, C_QC = 2816, C_KC = 3328, C_VC = 3840, C_G = 4352;
constexpr int NCHUNK = 2, TC = NTOK / NCHUNK, BPC = NB / NCHUNK;
constexpr int NTHREADS = 512;
constexpr int LDS_BYTES = 160 * 1024;
constexpr float RMS_EPS = 1e-6f;

constexpr size_t alup(size_t x) { return (x + 255) & ~(size_t)255; }
constexpr size_t WS_MOD = 0;
constexpr size_t WS_BIASA = alup(WS_MOD + (size_t)DEPTH * NB * 6144 * 4);
constexpr size_t WS_BIASC = alup(WS_BIASA + 8 * 128 * 4);
constexpr size_t WS_KMEAN = alup(WS_BIASC + 8 * 8192 * 4);
constexpr size_t WS_RSUM = alup(WS_KMEAN + (size_t)BPC * 8 * 32 * 64 * 4);
constexpr size_t WS_WIN = alup(WS_RSUM + (size_t)BPC * 64 * 1024 * 2 * 4);
constexpr size_t WS_WB = alup(WS_WIN + (size_t)DIN * 1024 * 2);
constexpr size_t WS_WOUT = alup(WS_WB + (size_t)1024 * 2048 * 2);
constexpr size_t WS_WUP = alup(WS_WOUT + (size_t)1024 * 1024 * 2);
constexpr size_t WS_WDOWN = alup(WS_WUP + (size_t)DFF2 * 1024 * 2);
constexpr size_t WS_GT = alup(WS_WDOWN + (size_t)1024 * DFF * 2);
constexpr size_t WS_H = alup(WS_GT + (size_t)2 * 64 * 1024 * 2);
constexpr size_t WS_Z = alup(WS_H + (size_t)TC * 1024 * 2);
constexpr size_t WS_ACT = alup(WS_Z + (size_t)TC * DIN * 2);
constexpr size_t WS_VTC = alup(WS_ACT + (size_t)TC * DFF * 2);
constexpr size_t WS_BAR = alup(WS_VTC + (size_t)BPC * 8 * 64 * SEQ * 2);
constexpr int LCAP = 8192;
constexpr size_t WS_MCNT = alup(WS_BAR + 3456 * 4);
constexpr size_t WS_MQ = alup(WS_MCNT + (size_t)BPC * 8 * 32 * 4);
constexpr size_t WS_MLIST = alup(WS_MQ + 256);
constexpr size_t WS_MPART = alup(WS_MLIST + (size_t)BPC * 8 * 32 * LCAP * 4);
constexpr size_t WS_MLSUM = alup(WS_MPART + (size_t)TC * 8 * 4 * 64 * 2);
constexpr size_t WS_H8 = alup(WS_MLSUM + (size_t)TC * 8 * 4 * 4);
constexpr size_t WS_WG8 = alup(WS_H8 + (size_t)TC * 1024);
constexpr size_t WS_END = alup(WS_WG8 + (size_t)3072 * 1024);

struct P {
    const float *x, *c, *w_mod, *b_mod, *norm_mix, *norm_ffn, *w_in, *qnorm_a, *knorm_a, *sinks, *rnn_conv_w, *rnn_conv_b, *ga_w, *ga_b, *gx_w, *gx_b, *lam,
        *qnorm_c, *knorm_c, *rel_bias, *w_branch, *w_out, *w_up, *ffn_conv_w, *ffn_conv_b, *w_down;
    float* out; unsigned char* ws;
};

__device__ __forceinline__ P load_params() {
#if defined(__HIP_DEVICE_COMPILE__)
    unsigned long long v = (unsigned long long)__builtin_amdgcn_kernarg_segment_ptr(); asm volatile("" : "+s"(v));
    const P __attribute__((address_space(4)))* kp = (const P __attribute__((address_space(4)))*)v;
    return *kp;
#else
    return P{};
#endif
}
__device__ __forceinline__ int opaque_tid() { int t = threadIdx.x; asm volatile("" : "+v"(t)); return t; }
__device__ __forceinline__ float bf2f(unsigned v) { return __uint_as_float(v << 16); }
__device__ __forceinline__ bf16_t f2bf(float f) { unsigned u = __float_as_uint(f); u += 0x7FFFu + ((u >> 16) & 1u); return (bf16_t)(u >> 16); }
__device__ __forceinline__ unsigned pack2(float lo, float hi) { return (unsigned)f2bf(lo) | ((unsigned)f2bf(hi) << 16); }
__device__ __forceinline__ unsigned cvt_pk_bf16(float lo, float hi) { unsigned r; asm volatile("v_cvt_pk_bf16_f32 %0, %1, %2" : "=v"(r) : "v"(lo), "v"(hi)); return r; }
__device__ __forceinline__ void unpack8(const u32x4 v, float* f) {
    f[0] = bf2f(v[0] & 0xffffu); f[1] = bf2f(v[0] >> 16); f[2] = bf2f(v[1] & 0xffffu); f[3] = bf2f(v[1] >> 16);
    f[4] = bf2f(v[2] & 0xffffu); f[5] = bf2f(v[2] >> 16); f[6] = bf2f(v[3] & 0xffffu); f[7] = bf2f(v[3] >> 16);
}
__device__ __forceinline__ f32x4 mfma16(bf16x8 a, bf16x8 b, f32x4 c) { return __builtin_amdgcn_mfma_f32_16x16x32_bf16(a, b, c, 0, 0, 0); }
__device__ __forceinline__ int t5_bucket(int d) {
    if (d < 16) return d;
    const float lr = logf((float)d / 16.0f) / 4.852030263919617f;
    int large = 16 + (int)(lr * 16.0f);
    return large < 31 ? large : 31;
}
__device__ __forceinline__ float gelu_tanh(float y) { const float t = 0.7978845608028654f * (y + 0.044715f * y * y * y);
    return y / (1.0f + __expf(-2.0f * t)); }
__device__ __forceinline__ float log1p_small(float x) { return (x < 0.125f) ? x * (1.0f + x * (-0.5f + x * (0.33333334f + x * (-0.25f + x * (0.2f + x * (-0.16666667f + x * 0.14285715f)))))) : __logf(1.0f + x); }
__device__ __forceinline__ float sigmoidf_(float v) { return 1.0f / (1.0f + __expf(-v)); }

namespace pg8 {
constexpr int BM = 256, BK = 64, HALF = 128, HTB = HALF * BK * 2, STAGE_BYTES = 8 * HTB, NXCD = 8, WGM = 8;
__device__ __forceinline__ int lds_byte(int r, int c) { const int st = (r >> 4) * 2 + (c >> 5), rr = r & 15, cc = c & 31, ob = rr * 64 + cc * 2; return st * 1024 + (ob ^ (((ob >> 9) & 1) << 5)); }
__device__ __forceinline__ void stage_rc(int b, int& R, int& C) { const int st = b / 1024, sb = b % 1024, swz = sb ^ (((sb >> 9) & 1) << 5); R = (st >> 1) * 16 + swz / 64; C = (st & 1) * 32 + (swz % 64) / 2; }
__device__ __forceinline__ int perm32(int rho) { const int n = rho >> 4, i = rho & 15; return 8 * (i >> 2) + 4 * n + (i & 3); }

struct Seg { const char* A; const char* B; int nt, pm, pn, pass; };

__device__ __forceinline__ bool unit_of(int i, int G, int c, int nM, int nN, int& pm, int& pn) {
    const int nwg = nM * nN; const long L = (long)i * G + c; if (L >= nwg) return false;
    int wgid = (int)L; { const int q = nwg / NXCD, r = nwg % NXCD, xcd = wgid % NXCD, off = wgid / NXCD; wgid = (xcd < r ? xcd * (q + 1) : r * (q + 1) + (xcd - r) * q) + off; }
    const int nig = WGM * nN, gid = wgid / nig, fm = gid * WGM, gsz = (nM - fm) < WGM ? (nM - fm) : WGM;
    pm = fm + ((wgid % nig) % gsz); pn = (wgid % nig) / gsz; return true;
}
struct SchedGateBal {
    const char* A; const char* B; unsigned lda2, ldb2; int nt, nM, nN, G, c;
    __device__ __forceinline__ bool get(int i, Seg& s) const {
        int pm, pn;
        if (G == 256 && nM * nN == 768) {
            int L;
            if (c < 64) { if (i >= 2) return false; L = 2 * c + i; }
            else if (c < 128) { if (i >= 4) return false; L = 128 + 4 * (c - 64) + i; }
            else { if (i >= 3) return false; L = 384 + 3 * (c - 128) + i; }
            pm = L / nN; pn = L - pm * nN;
        } else if (!unit_of(i, G, c, nM, nN, pm, pn)) return false;
        s.A = A + (size_t)pm * 256 * lda2; s.B = B + (size_t)pn * 256 * ldb2; s.nt = nt; s.pm = pm; s.pn = pn; s.pass = 0; return true;
    }
};
struct SchedPlain {
    const char* A; const char* B; unsigned lda2, ldb2; int nt, nM, nN, G, c;
    __device__ __forceinline__ bool get(int i, Seg& s) const {
        int pm, pn; if (!unit_of(i, G, c, nM, nN, pm, pn)) return false;
        s.A = A + (size_t)pm * 256 * lda2; s.B = B + (size_t)pn * 256 * ldb2; s.nt = nt; s.pm = pm; s.pn = pn; s.pass = 0; return true;
    }
};
struct SchedMerge {
    const char* z; const char* wb; unsigned lda2, ldb2; int nM, nN, G, c;
    __device__ __forceinline__ bool get(int i, Seg& s) const {
        const int u = i / 3, ps = i - 3 * u; int pm, pn; if (!unit_of(u, G, c, nM, nN, pm, pn)) return false;
        const char* zr = z + (size_t)pm * 256 * (DIN * 2); const char* br = wb + (size_t)pn * 256 * 4096;
        s.pm = pm; s.pn = pn; s.pass = ps;
        if (ps == 0) { s.A = zr + C_QA * 2; s.B = br; s.nt = 8; }
        else if (ps == 1) { s.A = zr + C_YR * 2; s.B = br + 512 * 2; s.nt = 16; }
        else { s.A = zr + C_QC * 2; s.B = br + 1536 * 2; s.nt = 8; }
        return true;
    }
};

struct EpiStoreBf16 {
    static constexpr bool PERM = true;
    bf16_t* O; int ldc; int sig_from; float mul;
    __device__ __forceinline__ bool after(f32x4 (&acc)[2][2][4][2], const Seg& u, int wr, int wc, int fr, int fq) const {
        if (u.pn >= sig_from) {
#pragma unroll
            for (int ai = 0; ai < 2; ++ai)
#pragma unroll
                for (int bj = 0; bj < 2; ++bj)
#pragma unroll
                    for (int m = 0; m < 4; ++m)
#pragma unroll
                        for (int n = 0; n < 2; ++n)
#pragma unroll
                            for (int e = 0; e < 4; ++e) acc[ai][bj][m][n][e] = 1.0f + __builtin_amdgcn_exp2f(-1.4426950408889634f * fmaxf(acc[ai][bj][m][n][e] * mul, -60.0f));
        }
        const unsigned loff = (unsigned)((wr * 64 + fr) * ldc + wc * 32 + 8 * fq) * 2u;
        char* ub = (char*)O + ((size_t)u.pm * BM * ldc + (size_t)u.pn * BM) * 2;
#pragma unroll
        for (int ai = 0; ai < 2; ++ai)
#pragma unroll
            for (int m = 0; m < 4; ++m) { char* rb = ub + (size_t)(ai * HALF + m * 16) * ldc * 2;
#pragma unroll
                for (int bj = 0; bj < 2; ++bj) { const f32x4 v0 = acc[ai][bj][m][0], v1 = acc[ai][bj][m][1];
                    u32x4 pk; pk[0] = cvt_pk_bf16(v0[0], v0[1]); pk[1] = cvt_pk_bf16(v0[2], v0[3]); pk[2] = cvt_pk_bf16(v1[0], v1[1]); pk[3] = cvt_pk_bf16(v1[2], v1[3]);
                    { const unsigned vo = loff + (unsigned)(bj * HALF * 2); asm volatile("global_store_dwordx4 %0, %1, %2 sc1\n\ts_nop 1" :: "v"(vo), "v"(pk), "s"(rb) : "memory"); } } }
        return true;
    }
};
struct EpiResid {
    static constexpr bool PERM = false;
    const float* xin; float* xout; const float* gate; int b0;
    __device__ __forceinline__ bool after(f32x4 (&acc)[2][2][4][2], const Seg& u, int wr, int wc, int fr, int fq) const {
        const unsigned loff = (unsigned)((wr * 64 + fr) * DM + wc * 32 + 4 * fq) * 4u;
        const size_t uo = ((size_t)u.pm * BM * DM + (size_t)u.pn * BM) * 4;
        const char* ib = (const char*)xin + uo; char* ob = (char*)xout + uo;
        const char* gp = (const char*)(gate + (size_t)(b0 + (u.pm * BM) / SEQ) * 6144 + u.pn * BM);
        const unsigned goff = (unsigned)(wc * 32 + 4 * fq) * 4u;
        f32x4 gv[2][2];
#pragma unroll
        for (int bj = 0; bj < 2; ++bj)
#pragma unroll
            for (int n = 0; n < 2; ++n) gv[bj][n] = *(const f32x4*)(gp + goff + (bj * HALF + n * 16) * 4);
#pragma unroll
        for (int ai = 0; ai < 2; ++ai)
#pragma unroll
          for (int mh = 0; mh < 2; ++mh) {
            f32x4 xv[2][2][2];
#pragma unroll
            for (int m2 = 0; m2 < 2; ++m2) { const char* irb = ib + (size_t)(ai * HALF + (mh * 2 + m2) * 16) * DM * 4;
#pragma unroll
                for (int bj = 0; bj < 2; ++bj)
#pragma unroll
                    for (int n = 0; n < 2; ++n) xv[m2][bj][n] = *(const f32x4*)(irb + loff + (bj * HALF + n * 16) * 4); }
            __builtin_amdgcn_sched_barrier(0);
#pragma unroll
            for (int m2 = 0; m2 < 2; ++m2) { char* orb = ob + (size_t)(ai * HALF + (mh * 2 + m2) * 16) * DM * 4;
#pragma unroll
                for (int bj = 0; bj < 2; ++bj)
#pragma unroll
                    for (int n = 0; n < 2; ++n) *(f32x4*)(orb + loff + (bj * HALF + n * 16) * 4) = xv[m2][bj][n] + gv[bj][n] * acc[ai][bj][mh * 2 + m2][n]; }
            __builtin_amdgcn_sched_barrier(0); }
        return true;
    }
};
struct EpiMerge {
    static constexpr bool PERM = true;
    const bf16_t* z; bf16_t* O;
    __device__ __forceinline__ bool after(f32x4 (&acc)[2][2][4][2], const Seg& u, int wr, int wc, int fr, int fq) const {
        const int ps = u.pass;
        const int gA = (ps == 2) ? 2 : ps, gB = (ps == 2) ? 2 : ps + 1;
        const unsigned zoff = (unsigned)((wr * 64 + fr) * DIN + wc * 32 + 8 * fq) * 2u, ooff = (unsigned)((wr * 64 + fr) * DM + wc * 32 + 8 * fq) * 2u;
        const char* zb = (const char*)z + ((size_t)u.pm * BM * DIN + C_G + (size_t)u.pn * BM) * 2;
        const char* zA = zb + (size_t)gA * 2048; const char* zB = zb + (size_t)gB * 2048;
        char* ob = (char*)O + ((size_t)u.pm * BM * DM + (size_t)u.pn * BM) * 2;
#pragma unroll
        for (int ai = 0; ai < 2; ++ai)
#pragma unroll
          for (int mh = 0; mh < 2; ++mh) {
            u32x4 la[2][2], lb[2][2];
#pragma unroll
            for (int m2 = 0; m2 < 2; ++m2) { const size_t rz = (size_t)(ai * HALF + (mh * 2 + m2) * 16) * DIN * 2;
#pragma unroll
                for (int bj = 0; bj < 2; ++bj) { la[m2][bj] = *(const u32x4*)(zA + rz + zoff + bj * HALF * 2); lb[m2][bj] = *(const u32x4*)(zB + rz + zoff + bj * HALF * 2); } }
            __builtin_amdgcn_sched_barrier(0);
#pragma unroll
            for (int m2 = 0; m2 < 2; ++m2) { const int m = mh * 2 + m2; const size_t rO = (size_t)(ai * HALF + m * 16) * DM * 2;
#pragma unroll
                for (int bj = 0; bj < 2; ++bj) {
                    float fa[8], fb[8]; unpack8(la[m2][bj], fa); unpack8(lb[m2][bj], fb);
                    float sc[8];
#pragma unroll
                    for (int e = 0; e < 8; ++e) sc[e] = ((ps == 2) ? 1.0f : fb[e]) * __builtin_amdgcn_rcpf(fa[e]);
                    f32x4 v0 = acc[ai][bj][m][0], v1 = acc[ai][bj][m][1];
                    v0[0] *= sc[0]; v0[1] *= sc[1]; v0[2] *= sc[2]; v0[3] *= sc[3]; v1[0] *= sc[4]; v1[1] *= sc[5]; v1[2] *= sc[6]; v1[3] *= sc[7];
                    acc[ai][bj][m][0] = v0; acc[ai][bj][m][1] = v1;
                    if (ps == 2) { u32x4 pk; pk[0] = cvt_pk_bf16(v0[0], v0[1]); pk[1] = cvt_pk_bf16(v0[2], v0[3]); pk[2] = cvt_pk_bf16(v1[0], v1[1]); pk[3] = cvt_pk_bf16(v1[2], v1[3]);
                        *(u32x4*)(ob + rO + ooff + bj * HALF * 2) = pk; } } }
            __builtin_amdgcn_sched_barrier(0); }
        return ps == 2;
    }
};

template <class Sched, class Epi, bool FP8 = false, bool ALIGN_EPI = true, bool SP2 = true>
__device__ __forceinline__ void gemm_phase(LAS unsigned char* lds, const Sched& S, const Epi& E) {
    const int tid = opaque_tid(), wid = __builtin_amdgcn_readfirstlane(tid >> 6), lane = tid & 63, wr = wid >> 2, wc = wid & 3, fr = lane & 15, fq = lane >> 4;
    const unsigned cla = S.lda2, clb = S.ldb2;
    unsigned RA[2], RB[2];
#pragma unroll
    for (int i = 0; i < 2; ++i) { int R, C; stage_rc(tid * 16 + i * 8192, R, C); const int Rb = Epi::PERM ? ((R & ~31) + perm32(R & 31)) : R;
        RA[i] = (unsigned)R * cla + (unsigned)C * 2u; RB[i] = (unsigned)Rb * clb + (unsigned)C * 2u; }
    const size_t kstep = (size_t)(BK * 2);
    const unsigned ldsw = (unsigned)wid * 1024u;
    unsigned ofs_slot = (unsigned)tid * 16u;
    if constexpr (FP8) { u32x4 o4; o4[0] = RA[0]; o4[1] = RA[1]; o4[2] = RB[0]; o4[3] = RB[1]; *(LAS u32x4*)(lds + STAGE_BYTES + ofs_slot) = o4; asm volatile("" : "+v"(ofs_slot)); }
    const int aoff = lds_byte(wr * 64 + fr, fq * 8), boff = lds_byte(wc * 32 + fr, fq * 8);
#define PG8_SA(b, h) (((b) * 2 + (h)) * HTB)
#define PG8_SB(b, h) ((4 + (b) * 2 + (h)) * HTB)
#define PG8_STG(bufoff, gbase, RR, ld2) do { if constexpr (FP8) {   \
            const u32x4 _o4 = *(const LAS u32x4*)(lds + STAGE_BYTES + ofs_slot); const bool _isB = (&(RR)[0] == &RB[0]); \
            _Pragma("unroll") for (int _i = 0; _i < 2; ++_i) \
            __builtin_amdgcn_global_load_lds((const unsigned*)((const char*)(gbase) + (_isB ? _o4[2 + _i] : _o4[_i])), (LAS unsigned*)(lds + (bufoff) + ldsw + _i * 8192), 16, 0, 0); } \
        else { _Pragma("unroll") for (int _i = 0; _i < 2; ++_i) \
        __builtin_amdgcn_global_load_lds((const unsigned*)((const char*)(gbase) + (RR)[_i]), (LAS unsigned*)(lds + (bufoff) + ldsw + _i * 8192), 16, 0, 0); } } while (0)
#define PG8_LDA(dst, b, h) do { if constexpr (FP8) { _Pragma("unroll") for (int m = 0; m < 4; ++m) { \
            const u32x4 _lo = *(const LAS u32x4*)(lds + PG8_SA(b, h) + aoff + m * 2048), _hi = *(const LAS u32x4*)(lds + PG8_SA(b, h) + aoff + m * 2048 + 1024); \
            dst##_8[m] = __builtin_shufflevector(_lo, _hi, 0, 1, 2, 3, 4, 5, 6, 7); } } \
        else { _Pragma("unroll") for (int m = 0; m < 4; ++m) _Pragma("unroll") for (int k = 0; k < 2; ++k) dst[m][k] = *(const LAS bf16x8*)(lds + PG8_SA(b, h) + aoff + m * 2048 + k * 1024); } } while (0)
#define PG8_LDB(dst, b, h) do { if constexpr (FP8) { _Pragma("unroll") for (int n = 0; n < 2; ++n) { \
            const u32x4 _lo = *(const LAS u32x4*)(lds + PG8_SB(b, h) + boff + n * 2048), _hi = *(const LAS u32x4*)(lds + PG8_SB(b, h) + boff + n * 2048 + 1024); \
            dst##_8[n] = __builtin_shufflevector(_lo, _hi, 0, 1, 2, 3, 4, 5, 6, 7); } } \
        else { _Pragma("unroll") for (int n = 0; n < 2; ++n) _Pragma("unroll") for (int k = 0; k < 2; ++k) dst[n][k] = *(const LAS bf16x8*)(lds + PG8_SB(b, h) + boff + n * 2048 + k * 1024); } } while (0)
#define PG8_MMA(ai, bj, At, Bt) do { __builtin_amdgcn_s_setprio(1); \
        if constexpr (FP8) { _Pragma("unroll") for (int m = 0; m < 4; ++m) _Pragma("unroll") for (int n = 0; n < 2; ++n) \
            acc[ai][bj][m][n] = __builtin_amdgcn_mfma_scale_f32_16x16x128_f8f6f4(__builtin_bit_cast(i32x8, Bt##_8[n]), __builtin_bit_cast(i32x8, At##_8[m]), acc[ai][bj][m][n], 0, 0, 0, 0x7f7f7f7f, 0, 0x7f7f7f7f); } \
        else { _Pragma("unroll") for (int m = 0; m < 4; ++m) _Pragma("unroll") for (int n = 0; n < 2; ++n) _Pragma("unroll") for (int k = 0; k < 2; ++k) \
            acc[ai][bj][m][n] = __builtin_amdgcn_mfma_f32_16x16x32_bf16(Bt[n][k], At[m][k], acc[ai][bj][m][n], 0, 0, 0); } \
        __builtin_amdgcn_s_setprio(0); } while (0)
#define PG8_WAIT_V(n) asm volatile("s_waitcnt vmcnt(" #n ")" ::: "memory")
#define PG8_WAIT_L(n) asm volatile("s_waitcnt lgkmcnt(" #n ")" ::: "memory")
#define PG8_BAR __builtin_amdgcn_s_barrier()
#define PG8_SCHED __builtin_amdgcn_sched_barrier(0)
    Seg cur, nxt; int si = 0;
    if (!S.get(0, cur)) return;
    f32x4 acc[2][2][4][2];
#pragma unroll
    for (int a = 0; a < 2; ++a)
#pragma unroll
        for (int b = 0; b < 2; ++b)
#pragma unroll
            for (int m = 0; m < 4; ++m)
#pragma unroll
                for (int n = 0; n < 2; ++n) acc[a][b][m][n] = (f32x4){0.f, 0.f, 0.f, 0.f};
    bf16x8 At[4][2], B0[2][2], B1[2][2];
    u32x8 At_8[4], B0_8[2], B1_8[2];
    const char* cA = cur.A; const char* cB = cur.B;
    if constexpr (SP2) {
        PG8_STG(PG8_SB(0, 0), cB, RB, clb); PG8_STG(PG8_SB(0, 1), cB + (size_t)HALF * clb, RB, clb); PG8_STG(PG8_SA(0, 0), cA, RA, cla); PG8_STG(PG8_SA(0, 1), cA + (size_t)HALF * cla, RA, cla);
        if (wr == 1) PG8_BAR;
        PG8_WAIT_V(2); PG8_BAR;
        PG8_STG(PG8_SB(1, 0), cB + kstep, RB, clb); PG8_STG(PG8_SA(1, 0), cA + kstep, RA, cla); PG8_STG(PG8_SB(1, 1), cB + (size_t)HALF * clb + kstep, RB, clb);
        PG8_WAIT_V(6); PG8_BAR;
    } else {
    PG8_STG(PG8_SB(0, 0), cB, RB, clb); PG8_STG(PG8_SA(0, 0), cA, RA, cla); PG8_STG(PG8_SB(0, 1), cB + (size_t)HALF * clb, RB, clb); PG8_STG(PG8_SA(0, 1), cA + (size_t)HALF * cla, RA, cla);
    if (wr == 1) PG8_BAR;
    PG8_WAIT_V(4); PG8_BAR;
    PG8_STG(PG8_SB(1, 0), cB + kstep, RB, clb); PG8_STG(PG8_SA(1, 0), cA + kstep, RA, cla); PG8_STG(PG8_SB(1, 1), cB + (size_t)HALF * clb + kstep, RB, clb);
    PG8_WAIT_V(6); PG8_BAR;
    }
    for (;;) {
        const bool has_next = S.get(si + 1, nxt);
        const char* nA = has_next ? nxt.A : cA; const char* nB = has_next ? nxt.B : cB;
        const int nt = cur.nt;
        for (int t = 0; t < nt; t += 2) {
            const bool last = (t == nt - 2);
            const char* a1 = cA + (size_t)(t + 1) * kstep;
            const char* a2 = last ? nA : cA + (size_t)(t + 2) * kstep; const char* b2 = last ? nB : cB + (size_t)(t + 2) * kstep;
            const unsigned la2 = cla, lb2 = clb;
            const char* a3 = a2 + kstep; const char* b3 = b2 + kstep;
            if constexpr (SP2) {
            PG8_LDB(B0, 0, 0); PG8_LDB(B1, 0, 1); PG8_SCHED; PG8_LDA(At, 0, 0); PG8_STG(PG8_SA(1, 1), a1 + (size_t)HALF * cla, RA, cla);
            PG8_WAIT_V(8); PG8_WAIT_L(0); PG8_BAR; PG8_MMA(0, 0, At, B0); PG8_MMA(0, 1, At, B1); PG8_BAR; PG8_SCHED;
            PG8_LDA(At, 0, 1); PG8_STG(PG8_SB(0, 0), b2, RB, lb2); PG8_STG(PG8_SB(0, 1), b2 + (size_t)HALF * lb2, RB, lb2); PG8_STG(PG8_SA(0, 0), a2, RA, la2);
            PG8_WAIT_V(8); PG8_WAIT_L(0); PG8_BAR; PG8_MMA(1, 0, At, B0); PG8_MMA(1, 1, At, B1); PG8_BAR; PG8_SCHED;
            PG8_LDB(B0, 1, 0); PG8_LDB(B1, 1, 1); PG8_SCHED; PG8_LDA(At, 1, 0); PG8_STG(PG8_SA(0, 1), a2 + (size_t)HALF * la2, RA, la2);
            PG8_WAIT_V(8); PG8_WAIT_L(0); PG8_BAR; PG8_MMA(0, 0, At, B0); PG8_MMA(0, 1, At, B1); PG8_BAR; PG8_SCHED;
            PG8_LDA(At, 1, 1); PG8_STG(PG8_SB(1, 0), b3, RB, lb2); PG8_STG(PG8_SB(1, 1), b3 + (size_t)HALF * lb2, RB, lb2); PG8_STG(PG8_SA(1, 0), a3, RA, la2);
            PG8_WAIT_V(8); PG8_WAIT_L(0); PG8_BAR; PG8_MMA(1, 0, At, B0); PG8_MMA(1, 1, At, B1); PG8_BAR; PG8_SCHED;
            } else {
            PG8_LDB(B0, 0, 0); PG8_SCHED; PG8_LDA(At, 0, 0); PG8_STG(PG8_SA(1, 1), a1 + (size_t)HALF * cla, RA, cla);
            PG8_WAIT_L(8); PG8_BAR; PG8_WAIT_L(0); PG8_MMA(0, 0, At, B0); PG8_BAR; PG8_SCHED;
            PG8_LDB(B1, 0, 1); PG8_STG(PG8_SB(0, 0), b2, RB, lb2);
            PG8_BAR; PG8_WAIT_L(0); PG8_MMA(0, 1, At, B1); PG8_BAR;
            PG8_LDA(At, 0, 1); PG8_STG(PG8_SA(0, 0), a2, RA, la2);
            PG8_BAR; PG8_WAIT_L(0); PG8_MMA(1, 0, At, B0); PG8_BAR; PG8_SCHED;
            PG8_STG(PG8_SB(0, 1), b2 + (size_t)HALF * lb2, RB, lb2);
            PG8_WAIT_V(6); PG8_BAR; PG8_MMA(1, 1, At, B1); PG8_BAR;
            PG8_LDB(B0, 1, 0); PG8_SCHED; PG8_LDA(At, 1, 0); PG8_STG(PG8_SA(0, 1), a2 + (size_t)HALF * la2, RA, la2);
            PG8_WAIT_L(8); PG8_BAR; PG8_WAIT_L(0); PG8_MMA(0, 0, At, B0); PG8_BAR; PG8_SCHED;
            PG8_LDB(B1, 1, 1); PG8_STG(PG8_SB(1, 0), b3, RB, lb2);
            PG8_BAR; PG8_WAIT_L(0); PG8_MMA(0, 1, At, B1); PG8_BAR;
            PG8_LDA(At, 1, 1); PG8_STG(PG8_SA(1, 0), a3, RA, la2);
            PG8_BAR; PG8_WAIT_L(0); PG8_MMA(1, 0, At, B0); PG8_BAR; PG8_SCHED;
            PG8_STG(PG8_SB(1, 1), b3 + (size_t)HALF * lb2, RB, lb2);
            PG8_WAIT_V(6); PG8_BAR; PG8_MMA(1, 1, At, B1); PG8_BAR;
            }
        }
        if constexpr (ALIGN_EPI) { if (wr == 0) PG8_BAR; }
        const bool done = E.after(acc, cur, wr, wc, fr, fq);
        if (!has_next) break;
        if (done) {
#pragma unroll
            for (int a = 0; a < 2; ++a)
#pragma unroll
                for (int b = 0; b < 2; ++b)
#pragma unroll
                    for (int m = 0; m < 4; ++m)
#pragma unroll
                        for (int n = 0; n < 2; ++n) acc[a][b][m][n] = (f32x4){0.f, 0.f, 0.f, 0.f};
        }
        cur = nxt; cA = nA; cB = nB; ++si;
        if constexpr (ALIGN_EPI) { if (wr == 1) PG8_BAR; }
    }
    PG8_WAIT_V(0);
    if constexpr (!ALIGN_EPI) { if (wr == 0) PG8_BAR; }
    PG8_BAR;
#undef PG8_SA
#undef PG8_SB
#undef PG8_STG
#undef PG8_LDA
#undef PG8_LDB
#undef PG8_MMA
#undef PG8_WAIT_V
#undef PG8_WAIT_L
#undef PG8_BAR
#undef PG8_SCHED
}
}

__device__ __forceinline__ void phase0(const P& p, LAS unsigned char* lds) {
    float* mod = (float*)(p.ws + WS_MOD);
    LAS float* sc = (LAS float*)lds;
    LAS float* red = sc + 4096;
    const int tid = opaque_tid();
    for (int i = tid; i < 4096; i += NTHREADS) { const float v = p.c[i]; sc[i] = v / (1.0f + __expf(-v)); }
    __syncthreads();
    const int cl = tid & 63, kg = tid >> 6;
    for (int item = blockIdx.x; item < DEPTH * 96; item += gridDim.x) {
        const int l = item / 96, j = (item % 96) * 64 + cl;
        const float* w = p.w_mod + (size_t)l * 1024 * 6144 + j;
        float a0 = 0.f, a1 = 0.f, a2 = 0.f, a3 = 0.f;
#pragma unroll 8
        for (int k = kg * 128; k < kg * 128 + 128; ++k) { const float wv = w[(size_t)k * 6144]; a0 += sc[k] * wv; a1 += sc[1024 + k] * wv; a2 += sc[2048 + k] * wv; a3 += sc[3072 + k] * wv; }
        red[(kg * 64 + cl) * 4 + 0] = a0; red[(kg * 64 + cl) * 4 + 1] = a1; red[(kg * 64 + cl) * 4 + 2] = a2; red[(kg * 64 + cl) * 4 + 3] = a3;
        __syncthreads();
        if (tid < 256) { const int b = tid >> 6, c2 = tid & 63; float s = 0.f;
#pragma unroll
            for (int g = 0; g < 8; ++g) s += red[(g * 64 + c2) * 4 + b];
            const int jj = (item % 96) * 64 + c2; mod[(size_t)(l * 4 + b) * 6144 + jj] = s + p.b_mod[l * 6144 + jj]; }
        __syncthreads();
    }
    float* biasA = (float*)(p.ws + WS_BIASA); float* biasC = (float*)(p.ws + WS_BIASC);
    for (int i = blockIdx.x * NTHREADS + tid; i < 8 * 8192; i += gridDim.x * NTHREADS) { const int h = i >> 13, d = i & 8191; biasC[i] = p.rel_bias[t5_bucket(d) * 16 + 8 + h]; }
    for (int i = blockIdx.x * NTHREADS + tid; i < 8 * 128; i += gridDim.x * NTHREADS) { const int h = i >> 7, d = i & 127; biasA[i] = p.rel_bias[t5_bucket(d) * 16 + h]; }
}

__device__ __forceinline__ void phase_norm(const float* xsrc, const float* gain, const float* mod_l, int shift_off, int scale_off, int b0, bf16_t* H, unsigned char* H8) {
    const int tid = opaque_tid(), wid = tid >> 6, lane = tid & 63;
    constexpr int RPW = TC / (256 * 8);
    const int wglob = blockIdx.x * 8 + wid, nw = gridDim.x * 8;
    for (int r0 = wglob * 4; r0 < TC; r0 += nw * 4) {
        f32x4 v[4][4]; float ss[4];
#pragma unroll
        for (int q = 0; q < 4; ++q) { const f32x4* xr = (const f32x4*)(xsrc + (size_t)(r0 + q) * DM);
#pragma unroll
            for (int i = 0; i < 4; ++i) v[q][i] = xr[lane + 64 * i]; }
#pragma unroll
        for (int q = 0; q < 4; ++q) { float a = 0.f;
#pragma unroll
            for (int i = 0; i < 4; ++i) a += v[q][i][0] * v[q][i][0] + v[q][i][1] * v[q][i][1] + v[q][i][2] * v[q][i][2] + v[q][i][3] * v[q][i][3];
            ss[q] = a; }
#pragma unroll
        for (int off = 32; off >= 1; off >>= 1) {
#pragma unroll
            for (int q = 0; q < 4; ++q) ss[q] += __shfl_xor(ss[q], off); }
        const float* mb = mod_l + (size_t)(b0 + r0 / SEQ) * 6144;
#pragma unroll
        for (int i = 0; i < 4; ++i) { const int col = (lane + 64 * i) * 4;
            const f32x4 g = *(const f32x4*)(gain + col), sc = *(const f32x4*)(mb + scale_off + col), sh = *(const f32x4*)(mb + shift_off + col);
#pragma unroll
            for (int q = 0; q < 4; ++q) { const float rinv = rsqrtf(ss[q] * (1.0f / 1024.0f) + RMS_EPS);
                float h[4];
#pragma unroll
                for (int e = 0; e < 4; ++e) h[e] = (v[q][i][e] * rinv * g[e]) * (1.0f + sc[e]) + sh[e];
                u32x2 pk; pk[0] = cvt_pk_bf16(h[0], h[1]); pk[1] = cvt_pk_bf16(h[2], h[3]);
                *(u32x2*)(H + (size_t)(r0 + q) * DM + col) = pk;
                if (H8) { unsigned p8 = 0u; p8 = __builtin_amdgcn_cvt_pk_fp8_f32(h[0], h[1], p8, false); p8 = __builtin_amdgcn_cvt_pk_fp8_f32(h[2], h[3], p8, true);
                    *(unsigned*)(H8 + (size_t)(r0 + q) * DM + col) = p8; } } }
    }
    (void)RPW;
}

__device__ __forceinline__ void phase_convert(const P& p, int l, LAS unsigned char* lds) {
    LAS float* t = (LAS float*)lds;
    constexpr int NJ = 8;
    const float* srcs[NJ] = { p.w_in + (size_t)l * 1024 * DIN, p.w_branch + (size_t)l * 2048 * 1024, p.w_out + (size_t)l * 1024 * 1024, p.w_up + (size_t)l * 1024 * DFF2,
        p.w_down + (size_t)l * DFF * 1024, p.ga_w + (size_t)l * 1024 * 64, p.gx_w + (size_t)l * 1024 * 64, p.w_in + (size_t)l * 1024 * DIN + C_G };
    const int Ks[NJ] = { 1024, 2048, 1024, 1024, DFF, 1024, 1024, 1024 };
    const int Ns[NJ] = { C_G, 1024, 1024, DFF2, 1024, 64, 64, 3072 };
    const int Ls[NJ] = { DIN, 1024, 1024, DFF2, 1024, 64, 64, DIN };
    const size_t dsts[NJ] = { WS_WIN, WS_WB, WS_WOUT, WS_WUP, WS_WDOWN, WS_GT, WS_GT + (size_t)64 * 1024 * 2, WS_WG8 };
    const int tid = opaque_tid();
    const int r = tid >> 4, c4 = (tid & 15) * 4, n = tid >> 3, kk = (tid & 7) * 8;
    int base = 0;
#pragma unroll
    for (int j = 0; j < NJ; ++j) {
        const int tn = Ns[j] / 64, ntile = (Ks[j] / 64) * tn;
        const float* src = srcs[j]; const int ldn = Ls[j], ldk = Ks[j]; bf16_t* dst = (bf16_t*)(p.ws + dsts[j]);
        int ti = (int)blockIdx.x - (base % (int)gridDim.x); if (ti < 0) ti += gridDim.x;
        f32x4 v0 = (f32x4){0.f, 0.f, 0.f, 0.f}, v1 = v0;
        if (ti < ntile) { const int kt = ti / tn, nn = ti - kt * tn; const float* sp = src + (size_t)(kt * 64 + r) * ldn + nn * 64 + c4; v0 = *(const f32x4*)sp; v1 = *(const f32x4*)(sp + (size_t)32 * ldn); }
        for (; ti < ntile; ti += gridDim.x) {
            const int kt = ti / tn, nn = ti - kt * tn;
            t[r * 65 + c4 + 0] = v0[0]; t[r * 65 + c4 + 1] = v0[1]; t[r * 65 + c4 + 2] = v0[2]; t[r * 65 + c4 + 3] = v0[3];
            t[(r + 32) * 65 + c4 + 0] = v1[0]; t[(r + 32) * 65 + c4 + 1] = v1[1]; t[(r + 32) * 65 + c4 + 2] = v1[2]; t[(r + 32) * 65 + c4 + 3] = v1[3];
            __syncthreads();
            const int tnx = ti + (int)gridDim.x;
            if (tnx < ntile) { const int kt2 = tnx / tn, nn2 = tnx - kt2 * tn; const float* sp = src + (size_t)(kt2 * 64 + r) * ldn + nn2 * 64 + c4; v0 = *(const f32x4*)sp; v1 = *(const f32x4*)(sp + (size_t)32 * ldn); }
            if (j == 7) { u32x2 p8; p8[0] = 0u; p8[1] = 0u;
#pragma unroll
                for (int q = 0; q < 2; ++q) { p8[q] = __builtin_amdgcn_cvt_pk_fp8_f32(t[(kk + 4 * q) * 65 + n] * 64.0f, t[(kk + 4 * q + 1) * 65 + n] * 64.0f, p8[q], false);
                    p8[q] = __builtin_amdgcn_cvt_pk_fp8_f32(t[(kk + 4 * q + 2) * 65 + n] * 64.0f, t[(kk + 4 * q + 3) * 65 + n] * 64.0f, p8[q], true); }
                *(u32x2*)((unsigned char*)dst + (size_t)(nn * 64 + n) * ldk + kt * 64 + kk) = p8; }
            else { u32x4 pk;
#pragma unroll
                for (int q = 0; q < 4; ++q) pk[q] = cvt_pk_bf16(t[(kk + 2 * q) * 65 + n], t[(kk + 2 * q + 1) * 65 + n]);
                *(u32x4*)(dst + (size_t)(nn * 64 + n) * ldk + kt * 64 + kk) = pk; }
            __syncthreads();
        }
        base += ntile;
    }
}

__device__ __forceinline__ void phase_qknorm(const P& p, int l, bf16_t* z) {
    const int tid = opaque_tid(), wid = tid >> 6, lane = tid & 63, g8 = lane & 7;
    float gqa[8], gka[8], gqc[8];
#pragma unroll
    for (int j = 0; j < 8; ++j) { gqa[j] = p.qnorm_a[l * 64 + g8 * 8 + j]; gka[j] = p.knorm_a[l * 64 + g8 * 8 + j]; gqc[j] = p.qnorm_c[l * 64 + g8 * 8 + j]; }
    for (int r0 = (blockIdx.x * 8 + wid) * 4; r0 < TC; r0 += gridDim.x * 8 * 4) {
        u32x4 raw[4][3];
#pragma unroll
        for (int q = 0; q < 4; ++q) { const bf16_t* rowp = z + (size_t)(r0 + q) * DIN;
            raw[q][0] = *(const u32x4*)(rowp + C_QA + lane * 8); raw[q][1] = *(const u32x4*)(rowp + C_KA + (lane & 15) * 8); raw[q][2] = *(const u32x4*)(rowp + C_QC + lane * 8); }
#pragma unroll
        for (int q = 0; q < 4; ++q) { bf16_t* rowp = z + (size_t)(r0 + q) * DIN;
#pragma unroll
            for (int it = 0; it < 3; ++it) {
                const int col = (it == 0) ? C_QA + lane * 8 : (it == 1) ? C_KA + (lane & 15) * 8 : C_QC + lane * 8;
                float f[8]; unpack8(raw[q][it], f);
                float ss = 0.f;
#pragma unroll
                for (int j = 0; j < 8; ++j) ss += f[j] * f[j];
                ss += __shfl_xor(ss, 1); ss += __shfl_xor(ss, 2); ss += __shfl_xor(ss, 4);
                const float rinv = rsqrtf(ss * (1.0f / 64.0f) + RMS_EPS);
                u32x4 pk;
#pragma unroll
                for (int j = 0; j < 4; ++j) { const float g0 = (it == 0) ? gqa[2 * j] : (it == 1) ? gka[2 * j] : gqc[2 * j], g1 = (it == 0) ? gqa[2 * j + 1] : (it == 1) ? gka[2 * j + 1] : gqc[2 * j + 1];
                    pk[j] = cvt_pk_bf16(f[2 * j] * rinv * g0, f[2 * j + 1] * rinv * g1); }
                if (it != 1 || lane < 16) *(u32x4*)(rowp + col) = pk;
            } }
    }
}
__device__ __forceinline__ void phase_kcnorm(const P& p, int l, bf16_t* z, LAS unsigned char* lds) {
    LAS float* red = (LAS float*)lds;
    LAS bf16_t* sT = (LAS bf16_t*)(lds + 16384);
    float* kmean = (float*)(p.ws + WS_KMEAN);
    const int tid = opaque_tid(), g8 = tid & 7, tg = tid >> 3;
    float gk[8];
#pragma unroll
    for (int j = 0; j < 8; ++j) gk[j] = p.knorm_c[l * 64 + g8 * 8 + j];
    for (int item = blockIdx.x; item < BPC * 8 * 32; item += gridDim.x) {
        const int m = item & 31, h = (item >> 5) & 7, bl = item >> 8;
        bf16_t* kbase = z + ((size_t)bl * SEQ + m * 256 + tg) * DIN + C_KC + h * 64 + g8 * 8;
        u32x4 kraw[4], vraw[4];
#pragma unroll
        for (int ps = 0; ps < 4; ++ps) kraw[ps] = *(const u32x4*)(kbase + (size_t)ps * 64 * DIN);
#pragma unroll
        for (int k = 0; k < 4; ++k) { const int i = tid + k * NTHREADS, kj = i >> 3, c8 = (i & 7) * 8;
            vraw[k] = *(const u32x4*)(z + ((size_t)bl * SEQ + m * 256 + kj) * DIN + C_VC + h * 64 + c8); }
        float ms[8];
#pragma unroll
        for (int j = 0; j < 8; ++j) ms[j] = 0.f;
#pragma unroll
        for (int ps = 0; ps < 4; ++ps) {
            float f[8]; unpack8(kraw[ps], f);
            float ss = 0.f;
#pragma unroll
            for (int j = 0; j < 8; ++j) ss += f[j] * f[j];
            ss += __shfl_xor(ss, 1); ss += __shfl_xor(ss, 2); ss += __shfl_xor(ss, 4);
            const float rinv = rsqrtf(ss * (1.0f / 64.0f) + RMS_EPS);
            float y[8];
#pragma unroll
            for (int j = 0; j < 8; ++j) { y[j] = f[j] * rinv * gk[j]; ms[j] += y[j]; }
            u32x4 pk;
#pragma unroll
            for (int j = 0; j < 4; ++j) pk[j] = cvt_pk_bf16(y[2 * j], y[2 * j + 1]);
            *(u32x4*)(kbase + (size_t)ps * 64 * DIN) = pk;
        }
#pragma unroll
        for (int j = 0; j < 8; ++j) red[tg * 64 + g8 * 8 + j] = ms[j];
#pragma unroll
        for (int k = 0; k < 4; ++k) { const int i = tid + k * NTHREADS, kj = i >> 3, c8 = (i & 7) * 8; *(LAS u32x4*)(sT + kj * 72 + c8) = vraw[k]; }
        __syncthreads();
        if (tid < 64) { float sm = 0.f; for (int g = 0; g < 64; ++g) sm += red[g * 64 + tid]; kmean[((size_t)(bl * 8 + h) * 32 + m) * 64 + tid] = sm * (1.0f / 256.0f); }
        {
            bf16_t* Vtg = (bf16_t*)(p.ws + WS_VTC) + (size_t)(bl * 8 + h) * 64 * SEQ;
            const int d = tid >> 3, tgp = tid & 7;
#pragma unroll
            for (int g = 0; g < 4; ++g) { const int t8 = tgp * 32 + g * 8; u32x4 pk;
#pragma unroll
                for (int j = 0; j < 4; ++j) pk[j] = (unsigned)sT[(t8 + 2 * j) * 72 + d] | ((unsigned)sT[(t8 + 2 * j + 1) * 72 + d] << 16);
                *(u32x4*)(Vtg + (size_t)d * SEQ + m * 256 + t8) = pk; }
        }
        __syncthreads();
    }
}

__device__ __forceinline__ void phase_rnn0(const P& p, int l, LAS unsigned char* lds, const bf16_t* z) {
    LAS float* sX = (LAS float*)lds;
    LAS float* sA = sX + 131 * 64 + 64;
    LAS float* sU = sA + 128 * 64;
    LAS float* sS = sU + 128 * 64;
    LAS bf16_t* sXb = (LAS bf16_t*)(sS + 8 * 64 * 2);
    LAS bf16_t* sGt = sXb + 128 * 72;
    float* rsum = (float*)(p.ws + WS_RSUM);
    const bf16_t* Gt = (const bf16_t*)(p.ws + WS_GT);
    bf16_t* OM = (bf16_t*)(p.ws + WS_ACT); bf16_t* UU = OM + (size_t)TC * 1024;
    const int tid = opaque_tid(), wid = tid >> 6, lane = tid & 63, fr = lane & 15, fq = lane >> 4;
    const int nbg = (int)gridDim.x >> 4;
    const int nb = blockIdx.x & 15, first = (int)blockIdx.x >> 4;
    if (first >= nbg) return;
    for (int i = tid; i < 2 * 64 * 8; i += NTHREADS) { const int g = i >> 9, d = (i >> 3) & 63, c8 = (i & 7) * 8;
        *(LAS u32x4*)(sGt + (g * 64 + d) * 72 + c8) = *(const u32x4*)(Gt + (size_t)g * 64 * 1024 + (size_t)d * 1024 + nb * 64 + c8); }
    const int ch = nb * 64 + lane;
    const float w0 = p.rnn_conv_w[(size_t)(l * 4 + 0) * 1024 + ch], w1 = p.rnn_conv_w[(size_t)(l * 4 + 1) * 1024 + ch], w2 = p.rnn_conv_w[(size_t)(l * 4 + 2) * 1024 + ch],
                w3 = p.rnn_conv_w[(size_t)(l * 4 + 3) * 1024 + ch], cb = p.rnn_conv_b[l * 1024 + ch];
    float bra[4], bix[4], spv[4];
#pragma unroll
    for (int nt = 0; nt < 4; ++nt) { const int chd = nb * 64 + nt * 16 + fr; bra[nt] = p.ga_b[l * 1024 + chd]; bix[nt] = p.gx_b[l * 1024 + chd];
        const float lamv = p.lam[l * 1024 + chd]; spv[nt] = (lamv > 15.f) ? __expf(-lamv) : log1p_small(__expf(-lamv)); }
    u32x4 xr[3];
#define RNN_PREFETCH(idx_) do { const int bl_ = (idx_) >> 6, t0_ = ((idx_) & 63) * 128; _Pragma("unroll") for (int k_ = 0; k_ < 3; ++k_) { const int i_ = tid + k_ * NTHREADS; const int rr_ = i_ >> 3, c8_ = (i_ & 7) * 8, t_ = t0_ - 3 + rr_; \
        xr[k_] = (u32x4){0u, 0u, 0u, 0u}; if (i_ < 131 * 8 && t_ >= 0) xr[k_] = *(const u32x4*)(z + ((size_t)bl_ * SEQ + t_) * DIN + C_XR + nb * 64 + c8_); } } while (0)
    RNN_PREFETCH(first);
    for (int idx = first; idx < BPC * 64; idx += nbg) {
        const int bl = idx >> 6, seg = idx & 63, t0 = seg * 128;
#pragma unroll
        for (int k = 0; k < 3; ++k) { const int i = tid + k * NTHREADS; if (i < 131 * 8) { const int rr = i >> 3, c8 = (i & 7) * 8; float f[8]; unpack8(xr[k], f);
            *(LAS f32x4*)(sX + rr * 64 + c8) = (f32x4){f[0], f[1], f[2], f[3]}; *(LAS f32x4*)(sX + rr * 64 + c8 + 4) = (f32x4){f[4], f[5], f[6], f[7]}; } }
        __syncthreads();
        if (idx + nbg < BPC * 64) RNN_PREFETCH(idx + nbg);
#pragma unroll
        for (int i = 0; i < 16; ++i) { const int tt = wid * 16 + i;
            const float xc = cb + w0 * sX[(tt + 0) * 64 + lane] + w1 * sX[(tt + 1) * 64 + lane] + w2 * sX[(tt + 2) * 64 + lane] + w3 * sX[(tt + 3) * 64 + lane];
            sXb[tt * 72 + lane] = f2bf(xc); }
        __syncthreads();
        { bf16x8 a[2];
#pragma unroll
          for (int ks = 0; ks < 2; ++ks) a[ks] = *(const LAS bf16x8*)(sXb + (16 * wid + fr) * 72 + ks * 32 + fq * 8);
#pragma unroll
          for (int nt = 0; nt < 4; ++nt) {
              f32x4 ar = (f32x4){0.f, 0.f, 0.f, 0.f}, ai = (f32x4){0.f, 0.f, 0.f, 0.f};
#pragma unroll
              for (int ks = 0; ks < 2; ++ks) {
                  const bf16x8 br = *(const LAS bf16x8*)(sGt + (nt * 16 + fr) * 72 + ks * 32 + fq * 8);
                  const bf16x8 bi = *(const LAS bf16x8*)(sGt + (64 + nt * 16 + fr) * 72 + ks * 32 + fq * 8);
                  ar = mfma16(a[ks], br, ar); ai = mfma16(a[ks], bi, ai); }
              const int d = nt * 16 + fr;
#pragma unroll
              for (int j = 0; j < 4; ++j) { const int tok = 16 * wid + 4 * fq + j;
                  const float r = __builtin_amdgcn_rcpf(1.0f + __expf(-(ar[j] + bra[nt]))), ig = __builtin_amdgcn_rcpf(1.0f + __expf(-(ai[j] + bix[nt])));
                  const float log_a = -8.0f * r * spv[nt]; const float av = __expf(log_a);
                  const float x2 = 2.0f * log_a;
                  const float om2 = (x2 > -0.25f) ? -x2 * (1.0f + x2 * (0.5f + x2 * (0.16666667f + x2 * (0.041666668f + x2 * (0.0083333338f + x2 * 0.0013888889f))))) : 1.0f - av * av;
                  float mult = __builtin_amdgcn_sqrtf(fmaxf(om2, 0.f));
                  if (t0 + tok == 0) mult = 1.0f;
                  sA[tok * 64 + d] = av; sU[tok * 64 + d] = mult * (ig * bf2f((unsigned)sXb[tok * 72 + d])); }
          } }
        __syncthreads();
        { float hl = 0.f, Pp = 1.f;
          const unsigned go0 = (unsigned)((bl * SEQ + t0 + wid * 16) * 1024 + ch);
#pragma unroll 4
          for (int i = 0; i < 16; ++i) { const int tt = wid * 16 + i;
              const bf16_t omb = f2bf(1.0f - sA[tt * 64 + lane]), ub = f2bf(sU[tt * 64 + lane]);
              const float av = 1.0f - bf2f((unsigned)omb), uv = bf2f((unsigned)ub);
              OM[go0 + (unsigned)i * 1024u] = omb; UU[go0 + (unsigned)i * 1024u] = ub;
              hl = av * hl + uv; Pp *= av; }
          sS[(wid * 64 + lane) * 2] = Pp; sS[(wid * 64 + lane) * 2 + 1] = hl; }
        __syncthreads();
        if (wid == 0) { float Pt = 1.f, Ht = 0.f;
#pragma unroll
            for (int w = 0; w < 8; ++w) { const float Pw = sS[(w * 64 + lane) * 2], Hw = sS[(w * 64 + lane) * 2 + 1]; Ht = Pw * Ht + Hw; Pt *= Pw; }
            float* o = rsum + ((size_t)(bl * 64 + seg) * 1024 + ch) * 2; o[0] = Pt; o[1] = Ht; }
    }
#undef RNN_PREFETCH
    __syncthreads();
}

__device__ __forceinline__ void phase_rnn_apply(const P& p, LAS unsigned char* lds, bf16_t* z) {
    LAS float* sS = (LAS float*)lds;
    LAS float* sC = sS + 8 * 64 * 2;
    const float* rsum = (const float*)(p.ws + WS_RSUM);
    const bf16_t* OM = (const bf16_t*)(p.ws + WS_ACT); const bf16_t* UU = OM + (size_t)TC * 1024;
    const int tid = opaque_tid(), wid = tid >> 6, lane = tid & 63;
    constexpr int N_RNN = BPC * 16 * 64;
    unsigned short ra[16], ru[16], ry[16]; float pp[8], hh[8];
#define RNN1_PREFETCH(j_) do { const int seg_ = (j_) & 63, nb_ = ((j_) >> 6) & 15, bl_ = (j_) >> 10; const int ch_ = nb_ * 64 + lane; const unsigned r_ = (unsigned)(bl_ * SEQ + seg_ * 128 + wid * 16); \
        _Pragma("unroll") for (int i_ = 0; i_ < 16; ++i_) { ra[i_] = OM[(r_ + i_) * 1024u + ch_]; ru[i_] = UU[(r_ + i_) * 1024u + ch_]; ry[i_] = z[(size_t)(r_ + i_) * DIN + C_YR + ch_]; } \
        _Pragma("unroll") for (int k_ = 0; k_ < 8; ++k_) { const int s2_ = wid * 8 + k_; pp[k_] = 1.f; hh[k_] = 0.f; \
            if (s2_ < seg_) { const float2 o_ = *(const float2*)(rsum + ((size_t)(bl_ * 64 + s2_) * 1024 + ch_) * 2); pp[k_] = o_.x; hh[k_] = o_.y; } } } while (0)
    int j = blockIdx.x;
    if (j < N_RNN) RNN1_PREFETCH(j);
    for (; j < N_RNN; j += gridDim.x) {
        const int seg = j & 63, nb = (j >> 6) & 15, bl = j >> 10; const int ch = nb * 64 + lane; const unsigned r0 = (unsigned)(bl * SEQ + seg * 128 + wid * 16);
        float a16[16], u16[16], y16[16];
#pragma unroll
        for (int i = 0; i < 16; ++i) { a16[i] = 1.0f - bf2f((unsigned)ra[i]); u16[i] = bf2f((unsigned)ru[i]); y16[i] = bf2f((unsigned)ry[i]); }
        { float Pw = 1.f, Hw = 0.f;
#pragma unroll
          for (int k = 0; k < 8; ++k) { Hw = pp[k] * Hw + hh[k]; Pw *= pp[k]; }
          sC[(wid * 64 + lane) * 2] = Pw; sC[(wid * 64 + lane) * 2 + 1] = Hw; }
        if (j + (int)gridDim.x < N_RNN) RNN1_PREFETCH(j + (int)gridDim.x);
        { float hl = 0.f, Pp = 1.f;
#pragma unroll
          for (int i = 0; i < 16; ++i) { hl = a16[i] * hl + u16[i]; Pp *= a16[i]; }
          sS[(wid * 64 + lane) * 2] = Pp; sS[(wid * 64 + lane) * 2 + 1] = hl; }
        __syncthreads();
        float h = 0.f;
#pragma unroll
        for (int w = 0; w < 8; ++w) h = sC[(w * 64 + lane) * 2] * h + sC[(w * 64 + lane) * 2 + 1];
        for (int w = 0; w < wid; ++w) h = sS[(w * 64 + lane) * 2] * h + sS[(w * 64 + lane) * 2 + 1];
#pragma unroll 4
        for (int i = 0; i < 16; ++i) { h = a16[i] * h + u16[i];
            z[(size_t)(r0 + i) * DIN + C_YR + ch] = f2bf(h * gelu_tanh(y16[i])); }
        __syncthreads();
    }
#undef RNN1_PREFETCH
}

__device__ __forceinline__ void swa_item(const P& p, int l, LAS unsigned char* lds, bf16_t* z, int bl, int kvh, int qb, float Mb) {
    LAS bf16_t* sK = (LAS bf16_t*)lds;
    LAS bf16_t* sVt = sK + 256 * 72;
    LAS float* sBA = (LAS float*)(lds + 70656);
    const float* biasA = (const float*)(p.ws + WS_BIASA);
    const int tid = opaque_tid(), wid = tid >> 6, lane = tid & 63, fr = lane & 15, fq = lane >> 4;
    const size_t rq0 = (size_t)bl * SEQ + (size_t)qb * 128;
    bf16x8 q[2][4];
#pragma unroll
    for (int i = 0; i < 2; ++i) { const int tile = wid + 8 * i, g = tile >> 2, q0 = (tile & 3) * 32;
        const bf16_t* qp = z + (rq0 + q0 + fr) * DIN + C_QA + (kvh * 4 + g) * 64 + fq * 8;
        q[i][0] = *(const bf16x8*)qp; q[i][1] = *(const bf16x8*)(qp + 32); q[i][2] = *(const bf16x8*)(qp + (size_t)16 * DIN); q[i][3] = *(const bf16x8*)(qp + (size_t)16 * DIN + 32); }
    for (int i = tid; i < 256 * 8; i += NTHREADS) { const int sj = i >> 3, c8 = (i & 7) * 8; const int tk = (qb - 1) * 128 + sj;
        u32x4 kv = (u32x4){0u, 0u, 0u, 0u}, vv = (u32x4){0u, 0u, 0u, 0u};
        if (tk >= 0) { const bf16_t* rowp = z + ((size_t)bl * SEQ + tk) * DIN; kv = *(const u32x4*)(rowp + C_KA + kvh * 64 + c8); vv = *(const u32x4*)(rowp + C_VA + kvh * 64 + c8); }
        *(LAS u32x4*)(sK + sj * 72 + c8) = kv;
#pragma unroll
        for (int j = 0; j < 4; ++j) { sVt[(c8 + 2 * j) * 264 + sj] = (bf16_t)(vv[j] & 0xffffu); sVt[(c8 + 2 * j + 1) * 264 + sj] = (bf16_t)(vv[j] >> 16); } }
    for (int i = tid; i < 4 * 384; i += NTHREADS) { const int g = i / 384, diff = i - g * 384 - 128; const int hq = kvh * 4 + g;
        const float Mh = fmaxf(Mb, p.sinks[l * 8 + hq]);
        sBA[i] = (diff >= 0 && diff < 128) ? (biasA[hq * 128 + diff] - Mh) * 1.4426950408889634f : -1.0e30f; }
    __syncthreads();
#pragma unroll
    for (int i = 0; i < 2; ++i) { const int tile = wid + 8 * i, g = tile >> 2, q0 = (tile & 3) * 32; const int hq = kvh * 4 + g;
        const LAS float* pbA = sBA + g * 384 + 128 + (q0 + fr + 128 - 4 * fq - 255); const LAS float* pbB = pbA + 16;
        float lsA = 0.f, lsB = 0.f;
        f32x4 oA[4], oB[4];
#pragma unroll
        for (int nd = 0; nd < 4; ++nd) { oA[nd] = (f32x4){0.f, 0.f, 0.f, 0.f}; oB[nd] = (f32x4){0.f, 0.f, 0.f, 0.f}; }
        int kq0 = (q0 + 1) >> 6; const int kq1 = ((q0 + 159) >> 6) + 1;
        if (qb == 0 && kq0 < 2) kq0 = 2;
        for (int kq = kq0; kq < kq1; ++kq) {
            unsigned pkA[4][2], pkB[4][2];
            const LAS float* pa = pbA - kq * 64; const LAS float* pb = pbB - kq * 64;
#pragma unroll
            for (int nt = 0; nt < 4; ++nt) {
                const LAS bf16_t* kp = sK + (kq * 64 + nt * 16 + fr) * 72 + fq * 8;
                const bf16x8 k0 = *(const LAS bf16x8*)kp, k1 = *(const LAS bf16x8*)(kp + 32);
                f32x4 aA = (f32x4){0.f, 0.f, 0.f, 0.f}, aB = (f32x4){0.f, 0.f, 0.f, 0.f};
                aA = mfma16(k0, q[i][0], aA); aB = mfma16(k0, q[i][2], aB); aA = mfma16(k1, q[i][1], aA); aB = mfma16(k1, q[i][3], aB);
                float pjA[4], pjB[4];
#pragma unroll
                for (int j = 0; j < 4; ++j) {
                    const float pvA = __builtin_amdgcn_exp2f(aA[j] * 0.18033688011112042f + pa[255 - nt * 16 - j]), pvB = __builtin_amdgcn_exp2f(aB[j] * 0.18033688011112042f + pb[255 - nt * 16 - j]);
                    lsA += pvA; lsB += pvB; pjA[j] = pvA; pjB[j] = pvB; }
                pkA[nt][0] = cvt_pk_bf16(pjA[0], pjA[1]); pkA[nt][1] = cvt_pk_bf16(pjA[2], pjA[3]);
                pkB[nt][0] = cvt_pk_bf16(pjB[0], pjB[1]); pkB[nt][1] = cvt_pk_bf16(pjB[2], pjB[3]); }
#pragma unroll
            for (int tt = 0; tt < 2; ++tt) {
                u32x4 bwA, bwB; bwA[0] = pkA[2 * tt][0]; bwA[1] = pkA[2 * tt][1]; bwA[2] = pkA[2 * tt + 1][0]; bwA[3] = pkA[2 * tt + 1][1];
                bwB[0] = pkB[2 * tt][0]; bwB[1] = pkB[2 * tt][1]; bwB[2] = pkB[2 * tt + 1][0]; bwB[3] = pkB[2 * tt + 1][1];
                const bf16x8 bfA = __builtin_bit_cast(bf16x8, bwA), bfB = __builtin_bit_cast(bf16x8, bwB);
#pragma unroll
                for (int nd = 0; nd < 4; ++nd) { const LAS bf16_t* vp = sVt + (nd * 16 + fr) * 264 + kq * 64 + 32 * tt + 4 * fq;
                    const u32x2 lo = *(const LAS u32x2*)vp, hi = *(const LAS u32x2*)(vp + 16);
                    u32x4 aw; aw[0] = lo[0]; aw[1] = lo[1]; aw[2] = hi[0]; aw[3] = hi[1];
                    const bf16x8 vf = __builtin_bit_cast(bf16x8, aw);
                    oA[nd] = mfma16(vf, bfA, oA[nd]); oB[nd] = mfma16(vf, bfB, oB[nd]); } }
        }
        lsA += __shfl_xor(lsA, 16); lsA += __shfl_xor(lsA, 32); lsB += __shfl_xor(lsB, 16); lsB += __shfl_xor(lsB, 32);
        const float sinkv = p.sinks[l * 8 + hq]; const float es = __expf(sinkv - fmaxf(Mb, sinkv));
        const float invA = 1.0f / (lsA + es), invB = 1.0f / (lsB + es);
        bf16_t* opA = z + (rq0 + q0 + fr) * DIN + C_QA + hq * 64 + 4 * fq; bf16_t* opB = opA + (size_t)16 * DIN;
#pragma unroll
        for (int nd = 0; nd < 4; ++nd) { u32x2 pa2, pb2; pa2[0] = cvt_pk_bf16(oA[nd][0] * invA, oA[nd][1] * invA); pa2[1] = cvt_pk_bf16(oA[nd][2] * invA, oA[nd][3] * invA);
            pb2[0] = cvt_pk_bf16(oB[nd][0] * invB, oB[nd][1] * invB); pb2[1] = cvt_pk_bf16(oB[nd][2] * invB, oB[nd][3] * invB);
            *(u32x2*)(opA + nd * 16) = pa2; *(u32x2*)(opB + nd * 16) = pb2; }
    }
    __syncthreads();
}

constexpr int N_MSUB = 52;
__device__ const unsigned short MOBA_SUB[N_MSUB] = {269, 270, 271, 517, 549, 272, 518, 550, 770, 802, 834, 273, 519, 551, 1024, 1056, 1088, 1120, 274, 771, 803, 835, 520, 552, 275, 1025, 1057, 1089, 1121, 521, 553, 276, 772, 804, 836, 522, 554, 277, 523, 555, 278, 524, 556, 279, 280, 281, 282, 283, 284, 285, 286, 287};
__device__ __forceinline__ void moba_gate_item(const P& p, LAS unsigned char* lds, const bf16_t* z, int bl, int h, int n) {
    LAS float* sKm = (LAS float*)lds;
    LAS int* sCnt = (LAS int*)(lds + 8192);
    int* CNT = (int*)(p.ws + WS_MCNT) + (bl * 8 + h) * 32;
    unsigned* LIST = (unsigned*)(p.ws + WS_MLIST) + (size_t)(bl * 8 + h) * 32 * LCAP;
    const float* kmean = (const float*)(p.ws + WS_KMEAN) + (size_t)(bl * 8 + h) * 32 * 64;
    const int tid = opaque_tid();
    if (tid < 64) sCnt[tid] = 0;
    for (int i = tid; i < n * 64; i += NTHREADS) sKm[i] = kmean[i];
    __syncthreads();
    int s0 = -1, s1 = -1, s2 = -1, p0 = 0, p1 = 0, p2 = 0;
    if (tid < 256) {
        float qv[64];
        const bf16_t* qp = z + ((size_t)bl * SEQ + (size_t)n * 256 + tid) * DIN + C_QC + h * 64;
#pragma unroll
        for (int c = 0; c < 8; ++c) { const u32x4 raw = *(const u32x4*)(qp + c * 8); unpack8(raw, qv + c * 8); }
        float v0 = -3.0e38f, v1 = -3.0e38f, v2 = -3.0e38f;
        for (int m = 0; m < n; ++m) { float g = 0.f;
#pragma unroll
            for (int d = 0; d < 64; ++d) g += qv[d] * sKm[m * 64 + d];
            if (g > v0) { v2 = v1; s2 = s1; v1 = v0; s1 = s0; v0 = g; s0 = m; }
            else if (g > v1) { v2 = v1; s2 = s1; v1 = g; s1 = m; }
            else if (g > v2) { v2 = g; s2 = m; } }
        if (s0 >= 0) p0 = atomicAdd((int*)(sCnt + s0), 1);
        if (s1 >= 0) p1 = atomicAdd((int*)(sCnt + s1), 1);
        if (s2 >= 0) p2 = atomicAdd((int*)(sCnt + s2), 1);
    }
    __syncthreads();
    if (tid < n) { const int c = sCnt[tid]; sCnt[32 + tid] = (c > 0) ? atomicAdd(CNT + tid, c) : 0; }
    __syncthreads();
    if (tid < 256) { const unsigned qpos = (unsigned)(n * 256 + tid);
        if (s0 >= 0) LIST[(size_t)s0 * LCAP + sCnt[32 + s0] + p0] = qpos;
        if (s1 >= 0) LIST[(size_t)s1 * LCAP + sCnt[32 + s1] + p1] = qpos | (1u << 16);
        if (s2 >= 0) LIST[(size_t)s2 * LCAP + sCnt[32 + s2] + p2] = qpos | (2u << 16); }
    __syncthreads();
}

template <bool OWN>
__device__ __forceinline__ void moba_tile(unsigned ecA, unsigned ecB, bool vA, bool vB, bf16x8 qA0, bf16x8 qA1, bf16x8 qB0, bf16x8 qB1, int kqn, int m, int bl, int h, float cb,
                                          const LAS bf16_t* sK, const LAS bf16_t* sVt, const LAS float* sB2, bf16_t* PART, float* LSUM, int fr, int fq) {
    const int qposA = (int)(ecA & 0xffffu), slotA = (int)(ecA >> 16), qposB = (int)(ecB & 0xffffu), slotB = (int)(ecB >> 16);
    const int dqfA = qposA - m * 256 - 4 * fq, dqfB = qposB - m * 256 - 4 * fq;
    const bool farb = !OWN && (__all(dqfA + 4 * fq - 255 >= 1513 && dqfB + 4 * fq - 255 >= 1513) != 0);
    const LAS float* pbA = sB2 + (272 + dqfA - 255); const LAS float* pbB = sB2 + (272 + dqfB - 255);
    float lsA = 0.f, lsB = 0.f;
    f32x4 oA[4], oB[4];
#pragma unroll
    for (int nd = 0; nd < 4; ++nd) { oA[nd] = (f32x4){0.f, 0.f, 0.f, 0.f}; oB[nd] = (f32x4){0.f, 0.f, 0.f, 0.f}; }
    for (int kq = 0; kq < kqn; ++kq) {
        unsigned pkA[4][2], pkB[4][2];
        const LAS float* pa = pbA - kq * 64; const LAS float* pb = pbB - kq * 64;
#pragma unroll
        for (int nt = 0; nt < 4; ++nt) {
            const LAS bf16_t* kp = sK + (kq * 64 + nt * 16 + fr) * 72 + fq * 8;
            const bf16x8 k0 = *(const LAS bf16x8*)kp, k1 = *(const LAS bf16x8*)(kp + 32);
            f32x4 aA = (f32x4){0.f, 0.f, 0.f, 0.f}, aB = (f32x4){0.f, 0.f, 0.f, 0.f};
            aA = mfma16(k0, qA0, aA); aB = mfma16(k0, qB0, aB); aA = mfma16(k1, qA1, aA); aB = mfma16(k1, qB1, aB);
            float pjA[4], pjB[4];
#pragma unroll
            for (int j = 0; j < 4; ++j) {
                const float b2A = farb ? cb : pa[255 - nt * 16 - j], b2B = farb ? cb : pb[255 - nt * 16 - j];
                float pvA = __builtin_amdgcn_exp2f(aA[j] * 0.18033688011112042f + b2A), pvB = __builtin_amdgcn_exp2f(aB[j] * 0.18033688011112042f + b2B);
                if (OWN) { if (dqfA - (kq * 64 + nt * 16 + j) < 0) pvA = 0.f; if (dqfB - (kq * 64 + nt * 16 + j) < 0) pvB = 0.f; }
                lsA += pvA; lsB += pvB; pjA[j] = pvA; pjB[j] = pvB; }
            pkA[nt][0] = cvt_pk_bf16(pjA[0], pjA[1]); pkA[nt][1] = cvt_pk_bf16(pjA[2], pjA[3]);
            pkB[nt][0] = cvt_pk_bf16(pjB[0], pjB[1]); pkB[nt][1] = cvt_pk_bf16(pjB[2], pjB[3]); }
#pragma unroll
        for (int tt = 0; tt < 2; ++tt) {
            u32x4 bwA, bwB; bwA[0] = pkA[2 * tt][0]; bwA[1] = pkA[2 * tt][1]; bwA[2] = pkA[2 * tt + 1][0]; bwA[3] = pkA[2 * tt + 1][1];
            bwB[0] = pkB[2 * tt][0]; bwB[1] = pkB[2 * tt][1]; bwB[2] = pkB[2 * tt + 1][0]; bwB[3] = pkB[2 * tt + 1][1];
            const bf16x8 bfA = __builtin_bit_cast(bf16x8, bwA), bfB = __builtin_bit_cast(bf16x8, bwB);
#pragma unroll
            for (int nd = 0; nd < 4; ++nd) { const LAS bf16_t* vp = sVt + (nd * 16 + fr) * 264 + kq * 64 + 32 * tt + 4 * fq;
                const u32x2 lo = *(const LAS u32x2*)vp, hi = *(const LAS u32x2*)(vp + 16);
                u32x4 aw; aw[0] = lo[0]; aw[1] = lo[1]; aw[2] = hi[0]; aw[3] = hi[1];
                const bf16x8 vf = __builtin_bit_cast(bf16x8, aw);
                oA[nd] = mfma16(vf, bfA, oA[nd]); oB[nd] = mfma16(vf, bfB, oB[nd]); } }
    }
    lsA += __shfl_xor(lsA, 16); lsA += __shfl_xor(lsA, 32); lsB += __shfl_xor(lsB, 16); lsB += __shfl_xor(lsB, 32);
    if (vA) { const size_t pi = (((size_t)bl * SEQ + qposA) * 8 + h) * 4 + slotA;
        if (fq == 0) LSUM[pi] = lsA;
#pragma unroll
        for (int nd = 0; nd < 4; ++nd) { u32x2 pk2; pk2[0] = cvt_pk_bf16(oA[nd][0], oA[nd][1]); pk2[1] = cvt_pk_bf16(oA[nd][2], oA[nd][3]);
            *(u32x2*)(PART + pi * 64 + nd * 16 + 4 * fq) = pk2; } }
    if (vB) { const size_t pi = (((size_t)bl * SEQ + qposB) * 8 + h) * 4 + slotB;
        if (fq == 0) LSUM[pi] = lsB;
#pragma unroll
        for (int nd = 0; nd < 4; ++nd) { u32x2 pk2; pk2[0] = cvt_pk_bf16(oB[nd][0], oB[nd][1]); pk2[1] = cvt_pk_bf16(oB[nd][2], oB[nd][3]);
            *(u32x2*)(PART + pi * 64 + nd * 16 + 4 * fq) = pk2; } }
}
__device__ __forceinline__ void moba_attn_item(const P& p, LAS unsigned char* lds, const bf16_t* z, int bl, int h, int m, int part, int parts, float M) {
    LAS bf16_t* sK = (LAS bf16_t*)lds;
    LAS bf16_t* sVt = sK + 256 * 72;
    LAS float* sB2 = (LAS float*)(lds + 70656);
    const int tid = opaque_tid(), wid = tid >> 6, lane = tid & 63, fr = lane & 15, fq = lane >> 4;
    const bf16_t* Vtg = (const bf16_t*)(p.ws + WS_VTC) + (size_t)(bl * 8 + h) * 64 * SEQ;
    const float* biasC = (const float*)(p.ws + WS_BIASC) + h * 8192;
    const unsigned* LIST = (const unsigned*)(p.ws + WS_MLIST) + ((size_t)(bl * 8 + h) * 32 + m) * LCAP;
    bf16_t* PART = (bf16_t*)(p.ws + WS_MPART); float* LSUM = (float*)(p.ws + WS_MLSUM);
    const int cnt = ((const int*)(p.ws + WS_MCNT))[(bl * 8 + h) * 32 + m];
    const int ntl = (cnt + 31) >> 5, ntot = ntl + 8;
    const int tlo = (part * ntot) / parts, thi = ((part + 1) * ntot) / parts;
#define MOBA_ENTRY1(ix_, e, v) do { v = (ix_) < cnt; e = LIST[(ix_) < cnt ? (ix_) : (cnt > 0 ? cnt - 1 : 0)]; } while (0)
#define MOBA_ENTRY(t, ea, va, eb, vb) do { if ((t) < ntl) { MOBA_ENTRY1((t) * 32 + fr, ea, va); MOBA_ENTRY1((t) * 32 + 16 + fr, eb, vb); } \
        else { va = vb = (t) < thi; ea = (unsigned)(m * 256 + (((t) - ntl) & 7) * 32 + fr) | (3u << 16); eb = ea + 16u; } } while (0)
#define MOBA_QGATHER(e, a0, a1) do { const bf16_t* qp_ = z + ((size_t)bl * SEQ + ((e) & 0xffffu)) * DIN + C_QC + h * 64 + fq * 8; a0 = *(const bf16x8*)qp_; a1 = *(const bf16x8*)(qp_ + 32); } while (0)
#define MOBA_KQN(t) ((((((t) - ntl) & 7) * 32 + 31) >> 6) + 1)
    int t = tlo + wid;
    unsigned e0a = 0u, e0b = 0u, e1a = 0u, e1b = 0u, e2a = 0u, e2b = 0u; bool v0a = false, v0b = false, v1a = false, v1b = false, v2a = false, v2b = false;
    bf16x8 qa0, qa1, qa2, qa3, qb0, qb1, qb2, qb3, qc0, qc1, qc2, qc3;
    MOBA_ENTRY(t, e0a, v0a, e0b, v0b); MOBA_ENTRY(t + 8, e1a, v1a, e1b, v1b); MOBA_ENTRY(t + 16, e2a, v2a, e2b, v2b);
    MOBA_QGATHER(e0a, qa0, qa1); MOBA_QGATHER(e0b, qa2, qa3); MOBA_QGATHER(e1a, qb0, qb1); MOBA_QGATHER(e1b, qb2, qb3);
    qc0 = qa0; qc1 = qa1; qc2 = qa2; qc3 = qa3;
#pragma unroll
    for (int k = 0; k < 4; ++k) { const int i = tid + k * NTHREADS;
        const u32x4 kv = *(const u32x4*)(z + ((size_t)bl * SEQ + (size_t)m * 256 + (i >> 3)) * DIN + C_KC + h * 64 + (i & 7) * 8);
        const u32x4 vv = *(const u32x4*)(Vtg + (size_t)(i >> 5) * SEQ + m * 256 + (i & 31) * 8);
        *(LAS u32x4*)(sK + (i >> 3) * 72 + (i & 7) * 8) = kv; *(LAS u32x4*)(sVt + (i >> 5) * 264 + (i & 31) * 8) = vv;
    }
    for (int i = tid; i < 8192 + 272; i += NTHREADS) { const int dist = i - 272; sB2[i] = (biasC[dist < 0 ? 0 : dist] - M) * 1.4426950408889634f; }
    __syncthreads();
    const float cb = sB2[272 + 8191];
#define MOBA_RUN(ea, eb, va, vb, q0, q1, q2, q3) do { if (t >= ntl) moba_tile<true>(ea, eb, (va) && t < thi, (vb) && t < thi, q0, q1, q2, q3, MOBA_KQN(t), m, bl, h, cb, sK, sVt, sB2, PART, LSUM, fr, fq); \
        else moba_tile<false>(ea, eb, (va) && t < thi, (vb) && t < thi, q0, q1, q2, q3, 4, m, bl, h, cb, sK, sVt, sB2, PART, LSUM, fr, fq); } while (0)
    for (;;) {
        if (t >= thi) break;
        { const unsigned ca = e0a, cbb = e0b; const bool wa = v0a, wb = v0b; MOBA_QGATHER(e2a, qc0, qc1); MOBA_QGATHER(e2b, qc2, qc3); MOBA_ENTRY(t + 24, e0a, v0a, e0b, v0b);
          MOBA_RUN(ca, cbb, wa, wb, qa0, qa1, qa2, qa3); t += 8; }
        if (t >= thi) break;
        { const unsigned ca = e1a, cbb = e1b; const bool wa = v1a, wb = v1b; MOBA_QGATHER(e0a, qa0, qa1); MOBA_QGATHER(e0b, qa2, qa3); MOBA_ENTRY(t + 24, e1a, v1a, e1b, v1b);
          MOBA_RUN(ca, cbb, wa, wb, qb0, qb1, qb2, qb3); t += 8; }
        if (t >= thi) break;
        { const unsigned ca = e2a, cbb = e2b; const bool wa = v2a, wb = v2b; MOBA_QGATHER(e1a, qb0, qb1); MOBA_QGATHER(e1b, qb2, qb3); MOBA_ENTRY(t + 24, e2a, v2a, e2b, v2b);
          MOBA_RUN(ca, cbb, wa, wb, qc0, qc1, qc2, qc3); t += 8; }
    }
#undef MOBA_ENTRY1
#undef MOBA_ENTRY
#undef MOBA_QGATHER
#undef MOBA_KQN
#undef MOBA_RUN
    __syncthreads();
}

__device__ __forceinline__ void phase_moba_combine(const P& p, bf16_t* z) {
    const bf16_t* PART = (const bf16_t*)(p.ws + WS_MPART); const float* LSUM = (const float*)(p.ws + WS_MLSUM);
    const int tid = opaque_tid(), wid = tid >> 6, lane = tid & 63, h = lane >> 3, d8 = (lane & 7) * 8;
    for (int r0 = (blockIdx.x * 8 + wid) * 2; r0 < TC; r0 += gridDim.x * 8 * 2) {
#pragma unroll
        for (int q = 0; q < 2; ++q) { const int r = r0 + q; const int n = (r % SEQ) >> 8; const int nsel = n < 3 ? n : 3;
            const size_t pi = ((size_t)r * 8 + h) * 4;
            float acc[8], lt = LSUM[pi + 3];
            unpack8(*(const u32x4*)(PART + (pi + 3) * 64 + d8), acc);
#pragma unroll
            for (int k = 0; k < 3; ++k) if (k < nsel) { float f[8]; unpack8(*(const u32x4*)(PART + (pi + k) * 64 + d8), f); lt += LSUM[pi + k];
#pragma unroll
                for (int j = 0; j < 8; ++j) acc[j] += f[j]; }
            const float inv = 1.0f / lt; u32x4 pk;
#pragma unroll
            for (int j = 0; j < 4; ++j) pk[j] = cvt_pk_bf16(acc[2 * j] * inv, acc[2 * j + 1] * inv);
            *(u32x4*)(z + (size_t)r * DIN + C_QC + h * 64 + d8) = pk; }
    }
}

__device__ __forceinline__ void phase_act(const P& p, int l, const bf16_t* u, bf16_t* act) {
    const int tid = opaque_tid();
    if (tid >= DFF / 8) return;
    const int c0 = tid * 8;
    float wg[3][8], wv[3][8], bg[8], bv[8];
#pragma unroll
    for (int k = 0; k < 3; ++k)
#pragma unroll
        for (int j = 0; j < 8; ++j) { wg[k][j] = p.ffn_conv_w[(size_t)(l * 3 + k) * DFF2 + c0 + j]; wv[k][j] = p.ffn_conv_w[(size_t)(l * 3 + k) * DFF2 + DFF + c0 + j]; }
#pragma unroll
    for (int j = 0; j < 8; ++j) { bg[j] = p.ffn_conv_b[(size_t)l * DFF2 + c0 + j]; bv[j] = p.ffn_conv_b[(size_t)l * DFF2 + DFF + c0 + j]; }
    for (int item = blockIdx.x; item < TC / 64; item += gridDim.x) {
        const int r0 = item * 64;
        float g1[8], g2[8], v1[8], v2[8];
        if ((r0 % SEQ) == 0) {
#pragma unroll
            for (int j = 0; j < 8; ++j) { g1[j] = 0.f; g2[j] = 0.f; v1[j] = 0.f; v2[j] = 0.f; }
        } else {
            unpack8(*(const u32x4*)(u + (size_t)(r0 - 1) * DFF2 + c0), g1); unpack8(*(const u32x4*)(u + (size_t)(r0 - 2) * DFF2 + c0), g2);
            unpack8(*(const u32x4*)(u + (size_t)(r0 - 1) * DFF2 + DFF + c0), v1); unpack8(*(const u32x4*)(u + (size_t)(r0 - 2) * DFF2 + DFF + c0), v2);
        }
        for (int i0 = 0; i0 < 64; i0 += 8) {
            u32x4 rg[8], rv[8];
#pragma unroll
            for (int i = 0; i < 8; ++i) { const size_t r = (size_t)(r0 + i0 + i); rg[i] = *(const u32x4*)(u + r * DFF2 + c0); rv[i] = *(const u32x4*)(u + r * DFF2 + DFF + c0); }
#pragma unroll
            for (int i = 0; i < 8; ++i) { const size_t r = (size_t)(r0 + i0 + i);
                float g0[8], v0[8]; unpack8(rg[i], g0); unpack8(rv[i], v0);
                float o[8];
#pragma unroll
                for (int j = 0; j < 8; ++j) { const float cgv = bg[j] + wg[0][j] * g2[j] + wg[1][j] * g1[j] + wg[2][j] * g0[j]; const float cvv = bv[j] + wv[0][j] * v2[j] + wv[1][j] * v1[j] + wv[2][j] * v0[j];
                    o[j] = (cgv / (1.0f + __expf(-cgv))) * cvv; g2[j] = g1[j]; g1[j] = g0[j]; v2[j] = v1[j]; v1[j] = v0[j]; }
                u32x4 pk;
#pragma unroll
                for (int j = 0; j < 4; ++j) pk[j] = pack2(o[2 * j], o[2 * j + 1]);
                *(u32x4*)(act + r * DFF + c0) = pk; }
        }
    }
}

#ifndef PHASE_MASK
#define PHASE_MASK 0xFFFFF
#endif
#define PH(k) ((PHASE_MASK >> (k)) & 1)
#ifndef REP_GRP
#define REP_GRP 0
#endif
#ifndef REP_P2
#define REP_P2 0
#endif
#ifndef REP_P8
#define REP_P8 0
#endif
#ifndef REP_MISC
#define REP_MISC 0
#endif
#ifndef DRY_MOBA
#define DRY_MOBA 0
#endif
#ifndef DRY_SWA
#define DRY_SWA 0
#endif
#ifndef DRY_RNN
#define DRY_RNN 0
#endif

#define XB_TMO      128
#define XB_XCNT(j)  (256  + 64 * (j))
#define XB_XSUB(j)  (1280 + 64 * (j))
#define XB_XGEN(j)  (2304 + 64 * (j))
#define XB_TOP      3328
#define XB_TOPGEN   3392
#define XCD_BAR_WORDS 3456
#define XB_SPIN_CAP (1u << 18)
__device__ __forceinline__ unsigned xb_ld(unsigned* p)              { return __hip_atomic_load(p, __ATOMIC_RELAXED, __HIP_MEMORY_SCOPE_AGENT); }
__device__ __forceinline__ unsigned xb_add(unsigned* p, unsigned v) { return __hip_atomic_fetch_add(p, v, __ATOMIC_RELAXED, __HIP_MEMORY_SCOPE_AGENT); }
__device__ __forceinline__ unsigned xb_xcc_id() { return (unsigned)__builtin_amdgcn_s_getreg((3 << 11) | 20) & 0xFu; }
#define XB_SPIN(cond, bar) do { unsigned _sp = 0; while (cond) { __builtin_amdgcn_s_sleep(1); \
    if ((++_sp & 255u) == 0u) { if (xb_ld(&(bar)[XB_TMO])) break; if (_sp > XB_SPIN_CAP) { atomicAdd(&(bar)[XB_TMO], 1u); break; } } } } while (0)
struct XcdBarrier { unsigned* bar; unsigned x; volatile LAS unsigned* st; };
__device__ __forceinline__ XcdBarrier xcd_barrier_post(unsigned* bar, volatile LAS unsigned* st) {
    XcdBarrier b; b.bar = bar; b.x = xb_xcc_id(); b.st = st;
    if (threadIdx.x == 0) (void)xb_add(&bar[XB_XCNT(b.x)], 1u);
    return b;
}
__device__ __forceinline__ void xcd_barrier_complete(unsigned* bar, unsigned x, unsigned& nloc, unsigned& nx) {
    const unsigned G = gridDim.x * gridDim.y * gridDim.z;
    unsigned sum, cnt, mine, sp = 0u;
    for (;;) {
        sum = 0u; cnt = 0u; mine = 0u;
#pragma unroll
        for (unsigned j = 0; j < 16; ++j) { const unsigned c = xb_ld(&bar[XB_XCNT(j)]); sum += c; cnt += (c > 0u) ? 1u : 0u; mine = (j == x) ? c : mine; }
        if (sum == G) break;
        __builtin_amdgcn_s_sleep(1);
        if ((++sp & 255u) == 0u) { if (xb_ld(&bar[XB_TMO])) break; if (sp > XB_SPIN_CAP) { atomicAdd(&bar[XB_TMO], 1u); break; } }
    }
    nloc = mine > 0u ? mine : 1u; nx = cnt > 0u ? cnt : 1u;
}
__device__ __forceinline__ void xcd_barrier(const XcdBarrier& b) {
    asm volatile("s_waitcnt vmcnt(0)" ::: "memory");
    __syncthreads();
    if (opaque_tid() == 0) {
        unsigned* bar = b.bar;
        __builtin_amdgcn_s_waitcnt(0);
        unsigned nloc = b.st[0], nx = b.st[1];
        if (nloc == 0u) { xcd_barrier_complete(bar, b.x, nloc, nx); b.st[0] = nloc; b.st[1] = nx; }
        const unsigned old = xb_add(&bar[XB_XSUB(b.x)], 1u);
        const unsigned gen = old / nloc;
        if (old + 1u == (gen + 1u) * nloc) {
            __builtin_amdgcn_fence(__ATOMIC_RELEASE, "agent");
            asm volatile("s_waitcnt vmcnt(0)" ::: "memory");
            const unsigned og = xb_add(&bar[XB_TOP], 1u);
            const unsigned tg = og / nx;
            if (og + 1u == (tg + 1u) * nx) xb_add(&bar[XB_TOPGEN], 1u);
            else XB_SPIN(xb_ld(&bar[XB_TOPGEN]) == tg, bar);
            __builtin_amdgcn_fence(__ATOMIC_ACQUIRE, "agent");
            xb_add(&bar[XB_XGEN(b.x)], 1u);
            asm volatile("s_waitcnt vmcnt(0)" ::: "memory");
        } else {
            XB_SPIN(xb_ld(&bar[XB_XGEN(b.x)]) == gen, bar);
            __builtin_amdgcn_fence(__ATOMIC_ACQUIRE, "agent");
            asm volatile("s_waitcnt vmcnt(0)" ::: "memory");
        }
    }
    __syncthreads();
}
#ifndef REP_SYNC
#define REP_SYNC 0
#endif
#define GSYNC() do { for (int _r = 0; _r < 1 + REP_SYNC; ++_r) xcd_barrier(xbar); } while (0)
__global__ void __launch_bounds__(NTHREADS, 2) fwd_megakernel(P p_arg) {
    extern __shared__ __attribute__((aligned(16))) unsigned char lds_raw[];
    LAS unsigned char* lds = (LAS unsigned char*)lds_raw;
    cg::grid_group grid = cg::this_grid();
    const int G = gridDim.x, bx = blockIdx.x;
#define RELOAD const P p = load_params(); const float* mod_l = (const float*)(p.ws + WS_MOD) + (size_t)l * NB * 6144; bf16_t* Hb = (bf16_t*)(p.ws + WS_H); bf16_t* Zb = (bf16_t*)(p.ws + WS_Z); bf16_t* ACTb = (bf16_t*)(p.ws + WS_ACT); \
    const float* xin = ((l == 0) ? p.x : p.out) + (size_t)ch * TC * DM; float* xout = p.out + (size_t)ch * TC * DM; (void)mod_l; (void)Hb; (void)Zb; (void)ACTb; (void)xin; (void)xout;

    { LAS unsigned* st = (LAS unsigned*)(lds + LDS_BYTES - 16); if (threadIdx.x == 0) { st[0] = 0u; st[1] = 0u; } __syncthreads(); }
    const XcdBarrier xbar = xcd_barrier_post((unsigned*)(p_arg.ws + WS_BAR), (volatile LAS unsigned*)(lds + LDS_BYTES - 16));
    if (PH(0)) { const P p = load_params(); phase0(p, lds); }
    grid.sync();

    for (int l = 0; l < DEPTH; ++l) {
        for (int ch = 0; ch < NCHUNK; ++ch) {
            const int b0 = ch * BPC;
            for (int rep3 = 0; rep3 < 1 + REP_MISC; ++rep3) { RELOAD
            if (PH(1)) if (ch == 0) phase_convert(p, l, lds);
            if (PH(2)) phase_norm(xin, p.norm_mix + l * DM, mod_l, 0, 1024, b0, Hb, p.ws + WS_H8); }
            GSYNC();
            for (int rep = 0; rep < 1 + REP_GRP; ++rep) {
            for (int rep2 = 0; rep2 < 1 + REP_P2; ++rep2) {
            if (PH(3)) { RELOAD
              { pg8::SchedPlain S{(const char*)Hb, (const char*)(p.ws + WS_WIN), DM * 2, DM * 2, DM / 64, TC / 256, C_G / 256, G, bx};
                pg8::EpiStoreBf16 E{Zb, DIN, 1 << 30, 1.0f};
                pg8::gemm_phase(lds, S, E); }
              {
                pg8::SchedGateBal S{(const char*)(p.ws + WS_H8), (const char*)(p.ws + WS_WG8), DM, DM, DM / 128, TC / 256, (DIN - C_G) / 256, G, bx};
                pg8::EpiStoreBf16 E{Zb + C_G, DIN, 0, 1.0f / 64.0f};
                pg8::gemm_phase<pg8::SchedGateBal, pg8::EpiStoreBf16, true>(lds, S, E); } }
            GSYNC();
            }
            { RELOAD
            if (PH(4)) phase_qknorm(p, l, Zb);
            if (PH(5)) phase_kcnorm(p, l, Zb, lds);
            if (bx == 0) { const int t_ = opaque_tid(); if (t_ < BPC * 8 * 32) ((int*)(p.ws + WS_MCNT))[t_] = 0; if (t_ == 0) *((int*)(p.ws + WS_MQ)) = 0; }
            if (PH(6)) phase_rnn0(p, l, lds, Zb); }
            GSYNC();
            { RELOAD
              for (int it = bx; it < BPC * 8 * 31; it += G) { const int n = 31 - it / (BPC * 8), h = it & 7, bl = (it >> 3) & 1; moba_gate_item(p, lds, Zb, bl, h, n); } }
            GSYNC();
            { RELOAD constexpr int N_MOBA = BPC * 8 * 32, N_SWA = BPC * 8 * 64, N_RNN = BPC * 16 * 64;
              float biasmax = 0.f, ga = 0.f, gc = 0.f;
              for (int i = 0; i < 32 * 16; ++i) biasmax = fmaxf(biasmax, fabsf(p.rel_bias[i]));
              for (int d = 0; d < 64; ++d) { ga = fmaxf(ga, fabsf(p.qnorm_a[l * 64 + d] * p.knorm_a[l * 64 + d])); gc = fmaxf(gc, fabsf(p.qnorm_c[l * 64 + d] * p.knorm_c[l * 64 + d])); }
              const float Mb_a = 8.0f * 1.03f * ga + biasmax, Mb_c = 8.0f * 1.03f * gc + biasmax;
              for (int j = bx; j < BPC * 2 * 64; j += G) { if (PH(8)) { const int qb = j & 63, kvh = (j >> 6) & 1, bl = j >> 7; swa_item(p, l, lds, Zb, bl, kvh, qb, Mb_a); } }
              if (PH(9)) phase_rnn_apply(p, lds, Zb);
              if (PH(7)) {
                  int* qhead = (int*)(p.ws + WS_MQ); LAS int* sQ = (LAS int*)(lds + LDS_BYTES - 32);
                  for (;;) {
                      if (opaque_tid() == 0) *sQ = __hip_atomic_fetch_add(qhead, 1, __ATOMIC_RELAXED, __HIP_MEMORY_SCOPE_AGENT);
                      __syncthreads();
                      const int i = *sQ;
                      __syncthreads();
                      if (i >= N_MSUB * BPC * 8) break;
                      const unsigned sv = MOBA_SUB[i >> 4]; const int h = i & 7, bl = (i >> 3) & 1;
                      moba_attn_item(p, lds, Zb, bl, h, (int)(sv & 31u), (int)((sv >> 5) & 7u), (int)(sv >> 8), Mb_c); } } }
            GSYNC();
            { RELOAD phase_moba_combine(p, Zb); }
            GSYNC();
            }
            if (PH(10)) { RELOAD pg8::SchedMerge S{(const char*)Zb, (const char*)(p.ws + WS_WB), DIN * 2, 2048 * 2, TC / 256, DM / 256, G, bx};
              pg8::EpiMerge E{Zb, Hb};
              pg8::gemm_phase(lds, S, E); }
            GSYNC();
            if (PH(11)) { RELOAD pg8::SchedPlain S{(const char*)Hb, (const char*)(p.ws + WS_WOUT), DM * 2, DM * 2, DM / 64, TC / 256, DM / 256, G, bx};
              pg8::EpiResid E{xin, xout, mod_l + 2048, b0};
              pg8::gemm_phase(lds, S, E); }
            GSYNC();
            for (int rep3 = 0; rep3 < 1 + REP_MISC; ++rep3) if (PH(12)) { RELOAD phase_norm(xout, p.norm_ffn + l * DM, mod_l, 3072, 4096, b0, Hb, nullptr); }
            GSYNC();
            for (int rep2 = 0; rep2 < 1 + REP_P8; ++rep2) {
            if (PH(13)) { RELOAD pg8::SchedPlain S{(const char*)Hb, (const char*)(p.ws + WS_WUP), DM * 2, DM * 2, DM / 64, TC / 256, DFF2 / 256, G, bx};
              pg8::EpiStoreBf16 E{Zb, DFF2, 1 << 30, 1.0f};
              pg8::gemm_phase(lds, S, E); }
            GSYNC();
            }
            for (int rep3 = 0; rep3 < 1 + REP_MISC; ++rep3) if (PH(14)) { RELOAD phase_act(p, l, Zb, ACTb); }
            GSYNC();
            if (PH(15)) { RELOAD pg8::SchedPlain S{(const char*)ACTb, (const char*)(p.ws + WS_WDOWN), DFF * 2, DFF * 2, DFF / 64, TC / 256, DM / 256, G, bx};
              pg8::EpiResid E{xout, xout, mod_l + 5120, b0};
              pg8::gemm_phase(lds, S, E); }
            GSYNC();
        }
    }
}

extern "C" void kernel_launch(void* const* d_in, const int* in_sizes, int n_in, void* d_out, int out_size, void* d_ws, size_t ws_size, hipStream_t stream) {
    static int grid = 0;
    if (grid == 0) {
        if (n_in != 26 || ws_size < WS_END) { fprintf(stderr, "kernel_launch: need 26 inputs and >= %zu bytes of workspace (got %d, %zu)\n", (size_t)WS_END, n_in, ws_size); grid = -1; return; }
        int dev = 0, cus = 0, per_cu = 0;
        (void)hipGetDevice(&dev);
        (void)hipDeviceGetAttribute(&cus, hipDeviceAttributeMultiprocessorCount, dev);
        if (hipFuncSetAttribute((const void*)fwd_megakernel, hipFuncAttributeMaxDynamicSharedMemorySize, LDS_BYTES) != hipSuccess) { fprintf(stderr, "kernel_launch: hipFuncSetAttribute failed\n"); grid = -1; return; }
        if (hipOccupancyMaxActiveBlocksPerMultiprocessor(&per_cu, (const void*)fwd_megakernel, NTHREADS, LDS_BYTES) != hipSuccess || per_cu < 1) { fprintf(stderr, "kernel_launch: occupancy query gives %d\n", per_cu); per_cu = 1; (void)hipGetLastError(); }
        grid = cus * per_cu;
        fprintf(stderr, "kernel_launch: grid %d (cus %d x %d)\n", grid, cus, per_cu);
    }
    if (grid < 0) return;
    P prm{};
    const float** pp = (const float**)&prm;
    for (int i = 0; i < 26; ++i) pp[i] = (const float*)d_in[i];
    prm.out = (float*)d_out; prm.ws = (unsigned char*)d_ws;
    if (hipMemsetAsync((char*)d_ws + WS_BAR, 0, 3456 * 4, stream) != hipSuccess) { fprintf(stderr, "kernel_launch: memset of barrier words failed\n"); return; }
    void* args[] = {&prm};
    hipError_t e = hipLaunchCooperativeKernel((const void*)fwd_megakernel, dim3(grid), dim3(NTHREADS), args, LDS_BYTES, stream);
    if (e != hipSuccess) fprintf(stderr, "kernel_launch: cooperative launch failed: %s (grid %d)\n", hipGetErrorString(e), grid);
}
```

```cpp
#include <hip/hip_runtime.h>
#include <hip/hip_cooperative_groups.h>
#include <cstdio>
#include <cstdint>
namespace cg = cooperative_groups;

#define LAS __attribute__((address_space(3)))
typedef unsigned short bf16_t;
typedef short bf16x8 __attribute__((ext_vector_type(8)));
typedef float f32x4 __attribute__((ext_vector_type(4)));
typedef unsigned u32x4 __attribute__((ext_vector_type(4)));
typedef unsigned u32x2 __attribute__((ext_vector_type(2)));
typedef int i32x8 __attribute__((ext_vector_type(8)));
typedef unsigned u32x8 __attribute__((ext_vector_type(8)));

constexpr int NB = 4, SEQ = 8192, DM = 1024, NTOK = NB * SEQ, DEPTH = 4;
constexpr int DIN = 7424, DFF = 2816, DFF2 = 5632;
constexpr int C_QA = 0, C_KA = 512, C_VA = 640, C_XR = 768, C_YR = 1792, C_QC = 2816, C_KC = 3328, C_VC = 3840, C_G = 4352;
constexpr int NCHUNK = 2, TC = NTOK / NCHUNK, BPC = NB / NCHUNK;
constexpr int NTHREADS = 512;
constexpr int LDS_BYTES = 160 * 1024;
constexpr float RMS_EPS = 1e-6f;

constexpr size_t alup(size_t x) { return (x + 255) & ~(size_t)255; }
constexpr size_t WS_MOD = 0;
constexpr size_t WS_BIASA = alup(WS_MOD + (size_t)DEPTH * NB * 6144 * 4);
constexpr size_t WS_BIASC = alup(WS_BIASA + 8 * 128 * 4);
constexpr size_t WS_KMEAN = alup(WS_BIASC + 8 * 8192 * 4);
constexpr size_t WS_RSUM = alup(WS_KMEAN + (size_t)BPC * 8 * 32 * 64 * 4);
constexpr size_t WS_WIN = alup(WS_RSUM + (size_t)BPC * 64 * 1024 * 2 * 4);
constexpr size_t WS_WB = alup(WS_WIN + (size_t)DIN * 1024 * 2);
constexpr size_t WS_WOUT = alup(WS_WB + (size_t)1024 * 2048 * 2);
constexpr size_t WS_WUP = alup(WS_WOUT + (size_t)1024 * 1024 * 2);
constexpr size_t WS_WDOWN = alup(WS_WUP + (size_t)DFF2 * 1024 * 2);
constexpr size_t WS_GT = alup(WS_WDOWN + (size_t)1024 * DFF * 2);
constexpr size_t WS_H = alup(WS_GT + (size_t)2 * 64 * 1024 * 2);
constexpr size_t WS_Z = alup(WS_H + (size_t)TC * 1024 * 2);
constexpr size_t WS_ACT = alup(WS_Z + (size_t)TC * DIN * 2);
constexpr size_t WS_VTC = alup(WS_ACT + (size_t)TC * DFF * 2);
constexpr size_t WS_BAR = alup(WS_VTC + (size_t)BPC * 8 * 64 * SEQ * 2);
constexpr int LCAP = 8192;
constexpr size_t WS_MCNT = alup(WS_BAR + 3456 * 4);
constexpr size_t WS_MQ = alup(WS_MCNT + (size_t)BPC * 8 * 32 * 4);
constexpr size_t WS_MLIST = alup(WS_MQ + 256);
constexpr size_t WS_MPART = alup(WS_MLIST + (size_t)BPC * 8 * 32 * LCAP * 4);
constexpr size_t WS_MLSUM = alup(WS_MPART + (size_t)TC * 8 * 4 * 64 * 2);
constexpr size_t WS_H8 = alup(WS_MLSUM + (size_t)TC * 8 * 4 * 4);
constexpr size_t WS_WG8 = alup(WS_H8 + (size_t)TC * 1024);
constexpr size_t WS_END = alup(WS_WG8 + (size_t)3072 * 1024);

struct P {
    const float *x, *c, *w_mod, *b_mod, *norm_mix, *norm_ffn, *w_in, *qnorm_a, *knorm_a, *sinks, *rnn_conv_w, *rnn_conv_b, *ga_w, *ga_b, *gx_w, *gx_b, *lam,
        *qnorm_c, *knorm_c, *rel_bias, *w_branch, *w_out, *w_up, *ffn_conv_w, *ffn_conv_b, *w_down;
    float* out; unsigned char* ws;
};

__device__ __forceinline__ P load_params() {
#if defined(__HIP_DEVICE_COMPILE__)
    unsigned long long v = (unsigned long long)__builtin_amdgcn_kernarg_segment_ptr(); asm volatile("" : "+s"(v));
    const P __attribute__((address_space(4)))* kp = (const P __attribute__((address_space(4)))*)v;
    return *kp;
#else
    return P{};
#endif
}
__device__ __forceinline__ int opaque_tid() { int t = threadIdx.x; asm volatile("" : "+v"(t)); return t; }
__device__ __forceinline__ float bf2f(unsigned v) { return __uint_as_float(v << 16); }
__device__ __forceinline__ bf16_t f2bf(float f) { unsigned u = __float_as_uint(f); u += 0x7FFFu + ((u >> 16) & 1u); return (bf16_t)(u >> 16); }
__device__ __forceinline__ unsigned pack2(float lo, float hi) { return (unsigned)f2bf(lo) | ((unsigned)f2bf(hi) << 16); }
__device__ __forceinline__ unsigned cvt_pk_bf16(float lo, float hi) { unsigned r; asm volatile("v_cvt_pk_bf16_f32 %0, %1, %2" : "=v"(r) : "v"(lo), "v"(hi)); return r; }
__device__ __forceinline__ void unpack8(const u32x4 v, float* f) {
    f[0] = bf2f(v[0] & 0xffffu); f[1] = bf2f(v[0] >> 16); f[2] = bf2f(v[1] & 0xffffu); f[3] = bf2f(v[1] >> 16);
    f[4] = bf2f(v[2] & 0xffffu); f[5] = bf2f(v[2] >> 16); f[6] = bf2f(v[3] & 0xffffu); f[7] = bf2f(v[3] >> 16);
}
__device__ __forceinline__ f32x4 mfma16(bf16x8 a, bf16x8 b, f32x4 c) { return __builtin_amdgcn_mfma_f32_16x16x32_bf16(a, b, c, 0, 0, 0); }
__device__ __forceinline__ int t5_bucket(int d) {
    if (d < 16) return d;
    const float lr = logf((float)d / 16.0f) / 4.852030263919617f;
    int large = 16 + (int)(lr * 16.0f);
    return large < 31 ? large : 31;
}
__device__ __forceinline__ float gelu_tanh(float y) { const float t = 0.7978845608028654f * (y + 0.044715f * y * y * y);
    return y * __builtin_amdgcn_rcpf(1.0f + __expf(-2.0f * t)); }
__device__ __forceinline__ float log1p_small(float x) { return (x < 0.125f) ? x * (1.0f + x * (-0.5f + x * (0.33333334f + x * (-0.25f + x * (0.2f + x * (-0.16666667f + x * 0.14285715f)))))) : __logf(1.0f + x); }
__device__ __forceinline__ float sigmoidf_(float v) { return 1.0f / (1.0f + __expf(-v)); }

namespace pg8 {
constexpr int BM = 256, BK = 64, HALF = 128, HTB = HALF * BK * 2, STAGE_BYTES = 8 * HTB, NXCD = 8, WGM = 8;
__device__ __forceinline__ int lds_byte(int r, int c) { const int st = (r >> 4) * 2 + (c >> 5), rr = r & 15, cc = c & 31, ob = rr * 64 + cc * 2; return st * 1024 + (ob ^ (((ob >> 9) & 1) << 5)); }
__device__ __forceinline__ void stage_rc(int b, int& R, int& C) { const int st = b / 1024, sb = b % 1024, swz = sb ^ (((sb >> 9) & 1) << 5); R = (st >> 1) * 16 + swz / 64; C = (st & 1) * 32 + (swz % 64) / 2; }
__device__ __forceinline__ int perm32(int rho) { const int n = rho >> 4, i = rho & 15; return 8 * (i >> 2) + 4 * n + (i & 3); }

struct Seg { const char* A; const char* B; int nt, pm, pn, pass; };

__device__ __forceinline__ bool unit_of(int i, int G, int c, int nM, int nN, int& pm, int& pn) {
    const int nwg = nM * nN; const long L = (long)i * G + c; if (L >= nwg) return false;
    int wgid = (int)L; { const int q = nwg / NXCD, r = nwg % NXCD, xcd = wgid % NXCD, off = wgid / NXCD; wgid = (xcd < r ? xcd * (q + 1) : r * (q + 1) + (xcd - r) * q) + off; }
    const int nig = WGM * nN, gid = wgid / nig, fm = gid * WGM, gsz = (nM - fm) < WGM ? (nM - fm) : WGM;
    pm = fm + ((wgid % nig) % gsz); pn = (wgid % nig) / gsz; return true;
}
struct SchedPlain {
    const char* A; const char* B; unsigned lda2, ldb2; int nt, nM, nN, G, c;
    __device__ __forceinline__ bool get(int i, Seg& s) const {
        int pm, pn; if (!unit_of(i, G, c, nM, nN, pm, pn)) return false;
        s.A = A + (size_t)pm * 256 * lda2; s.B = B + (size_t)pn * 256 * ldb2; s.nt = nt; s.pm = pm; s.pn = pn; s.pass = 0; return true;
    }
};
struct SchedMerge {
    const char* z; const char* wb; unsigned lda2, ldb2; int nM, nN, G, c;
    __device__ __forceinline__ bool get(int i, Seg& s) const {
        const int u = i / 3, ps = i - 3 * u; int pm, pn; if (!unit_of(u, G, c, nM, nN, pm, pn)) return false;
        const char* zr = z + (size_t)pm * 256 * (DIN * 2); const char* br = wb + (size_t)pn * 256 * 4096;
        s.pm = pm; s.pn = pn; s.pass = ps;
        if (ps == 0) { s.A = zr + C_QA * 2; s.B = br; s.nt = 8; }
        else if (ps == 1) { s.A = zr + C_YR * 2; s.B = br + 512 * 2; s.nt = 16; }
        else { s.A = zr + C_QC * 2; s.B = br + 1536 * 2; s.nt = 8; }
        return true;
    }
};

struct EpiStoreBf16 {
    static constexpr bool PERM = true;
    bf16_t* O; int ldc; int sig_from; float mul;
    __device__ __forceinline__ bool after(f32x4 (&acc)[2][2][4][2], const Seg& u, int wr, int wc, int fr, int fq) const {
        if (u.pn >= sig_from) {
#pragma unroll
            for (int ai = 0; ai < 2; ++ai)
#pragma unroll
                for (int bj = 0; bj < 2; ++bj)
#pragma unroll
                    for (int m = 0; m < 4; ++m)
#pragma unroll
                        for (int n = 0; n < 2; ++n)
#pragma unroll
                            for (int e = 0; e < 4; ++e) acc[ai][bj][m][n][e] = 1.0f + __builtin_amdgcn_exp2f(-1.4426950408889634f * fmaxf(acc[ai][bj][m][n][e] * mul, -60.0f));
        }
        const unsigned loff = (unsigned)((wr * 64 + fr) * ldc + wc * 32 + 8 * fq) * 2u;
        char* ub = (char*)O + ((size_t)u.pm * BM * ldc + (size_t)u.pn * BM) * 2;
#pragma unroll
        for (int ai = 0; ai < 2; ++ai)
#pragma unroll
            for (int m = 0; m < 4; ++m) { char* rb = ub + (size_t)(ai * HALF + m * 16) * ldc * 2;
#pragma unroll
                for (int bj = 0; bj < 2; ++bj) { const f32x4 v0 = acc[ai][bj][m][0], v1 = acc[ai][bj][m][1];
                    u32x4 pk; pk[0] = cvt_pk_bf16(v0[0], v0[1]); pk[1] = cvt_pk_bf16(v0[2], v0[3]); pk[2] = cvt_pk_bf16(v1[0], v1[1]); pk[3] = cvt_pk_bf16(v1[2], v1[3]);
                    { const unsigned vo = loff + (unsigned)(bj * HALF * 2); asm volatile("global_store_dwordx4 %0, %1, %2 sc1\n\ts_nop 1" :: "v"(vo), "v"(pk), "s"(rb) : "memory"); } } }
        return true;
    }
};
struct EpiResid {
    static constexpr bool PERM = false;
    const float* xin; float* xout; const float* gate; int b0;
    __device__ __forceinline__ bool after(f32x4 (&acc)[2][2][4][2], const Seg& u, int wr, int wc, int fr, int fq) const {
        const unsigned loff = (unsigned)((wr * 64 + fr) * DM + wc * 32 + 4 * fq) * 4u;
        const size_t uo = ((size_t)u.pm * BM * DM + (size_t)u.pn * BM) * 4;
        const char* ib = (const char*)xin + uo; char* ob = (char*)xout + uo;
        const char* gp = (const char*)(gate + (size_t)(b0 + (u.pm * BM) / SEQ) * 6144 + u.pn * BM);
        const unsigned goff = (unsigned)(wc * 32 + 4 * fq) * 4u;
        f32x4 gv[2][2];
#pragma unroll
        for (int bj = 0; bj < 2; ++bj)
#pragma unroll
            for (int n = 0; n < 2; ++n) gv[bj][n] = *(const f32x4*)(gp + goff + (bj * HALF + n * 16) * 4);
#pragma unroll
        for (int ai = 0; ai < 2; ++ai)
#pragma unroll
          for (int mh = 0; mh < 2; ++mh) {
            f32x4 xv[2][2][2];
#pragma unroll
            for (int m2 = 0; m2 < 2; ++m2) { const char* irb = ib + (size_t)(ai * HALF + (mh * 2 + m2) * 16) * DM * 4;
#pragma unroll
                for (int bj = 0; bj < 2; ++bj)
#pragma unroll
                    for (int n = 0; n < 2; ++n) xv[m2][bj][n] = *(const f32x4*)(irb + loff + (bj * HALF + n * 16) * 4); }
            __builtin_amdgcn_sched_barrier(0);
#pragma unroll
            for (int m2 = 0; m2 < 2; ++m2) { char* orb = ob + (size_t)(ai * HALF + (mh * 2 + m2) * 16) * DM * 4;
#pragma unroll
                for (int bj = 0; bj < 2; ++bj)
#pragma unroll
                    for (int n = 0; n < 2; ++n) *(f32x4*)(orb + loff + (bj * HALF + n * 16) * 4) = xv[m2][bj][n] + gv[bj][n] * acc[ai][bj][mh * 2 + m2][n]; }
            __builtin_amdgcn_sched_barrier(0); }
        return true;
    }
};
struct EpiMerge {
    static constexpr bool PERM = true;
    const bf16_t* z; bf16_t* O;
    __device__ __forceinline__ bool after(f32x4 (&acc)[2][2][4][2], const Seg& u, int wr, int wc, int fr, int fq) const {
        const int ps = u.pass;
        const int gA = (ps == 2) ? 2 : ps, gB = (ps == 2) ? 2 : ps + 1;
        const unsigned zoff = (unsigned)((wr * 64 + fr) * DIN + wc * 32 + 8 * fq) * 2u, ooff = (unsigned)((wr * 64 + fr) * DM + wc * 32 + 8 * fq) * 2u;
        const char* zb = (const char*)z + ((size_t)u.pm * BM * DIN + C_G + (size_t)u.pn * BM) * 2;
        const char* zA = zb + (size_t)gA * 2048; const char* zB = zb + (size_t)gB * 2048;
        char* ob = (char*)O + ((size_t)u.pm * BM * DM + (size_t)u.pn * BM) * 2;
#pragma unroll
        for (int ai = 0; ai < 2; ++ai)
#pragma unroll
          for (int mh = 0; mh < 2; ++mh) {
            u32x4 la[2][2], lb[2][2];
#pragma unroll
            for (int m2 = 0; m2 < 2; ++m2) { const size_t rz = (size_t)(ai * HALF + (mh * 2 + m2) * 16) * DIN * 2;
#pragma unroll
                for (int bj = 0; bj < 2; ++bj) { la[m2][bj] = *(const u32x4*)(zA + rz + zoff + bj * HALF * 2); lb[m2][bj] = *(const u32x4*)(zB + rz + zoff + bj * HALF * 2); } }
            __builtin_amdgcn_sched_barrier(0);
#pragma unroll
            for (int m2 = 0; m2 < 2; ++m2) { const int m = mh * 2 + m2; const size_t rO = (size_t)(ai * HALF + m * 16) * DM * 2;
#pragma unroll
                for (int bj = 0; bj < 2; ++bj) {
                    float fa[8], fb[8]; unpack8(la[m2][bj], fa); unpack8(lb[m2][bj], fb);
                    float sc[8];
#pragma unroll
                    for (int e = 0; e < 8; ++e) sc[e] = ((ps == 2) ? 1.0f : fb[e]) * __builtin_amdgcn_rcpf(fa[e]);
                    f32x4 v0 = acc[ai][bj][m][0], v1 = acc[ai][bj][m][1];
                    v0[0] *= sc[0]; v0[1] *= sc[1]; v0[2] *= sc[2]; v0[3] *= sc[3]; v1[0] *= sc[4]; v1[1] *= sc[5]; v1[2] *= sc[6]; v1[3] *= sc[7];
                    acc[ai][bj][m][0] = v0; acc[ai][bj][m][1] = v1;
                    if (ps == 2) { u32x4 pk; pk[0] = cvt_pk_bf16(v0[0], v0[1]); pk[1] = cvt_pk_bf16(v0[2], v0[3]); pk[2] = cvt_pk_bf16(v1[0], v1[1]); pk[3] = cvt_pk_bf16(v1[2], v1[3]);
                        *(u32x4*)(ob + rO + ooff + bj * HALF * 2) = pk; } } }
            __builtin_amdgcn_sched_barrier(0); }
        return ps == 2;
    }
};

template <class Sched, class Epi, bool FP8 = false, bool ALIGN_EPI = true, bool SP2 = true>
__device__ __forceinline__ void gemm_phase(LAS unsigned char* lds, const Sched& S, const Epi& E) {
    const int tid = opaque_tid(), wid = __builtin_amdgcn_readfirstlane(tid >> 6), lane = tid & 63, wr = wid >> 2, wc = wid & 3, fr = lane & 15, fq = lane >> 4;
    const unsigned cla = S.lda2, clb = S.ldb2;
    unsigned RA[2], RB[2];
#pragma unroll
    for (int i = 0; i < 2; ++i) { int R, C; stage_rc(tid * 16 + i * 8192, R, C); const int Rb = Epi::PERM ? ((R & ~31) + perm32(R & 31)) : R;
        RA[i] = (unsigned)R * cla + (unsigned)C * 2u; RB[i] = (unsigned)Rb * clb + (unsigned)C * 2u; }
    const size_t kstep = (size_t)(BK * 2);
    const unsigned ldsw = (unsigned)wid * 1024u;
    unsigned ofs_slot = (unsigned)tid * 16u;
    if constexpr (FP8) { u32x4 o4; o4[0] = RA[0]; o4[1] = RA[1]; o4[2] = RB[0]; o4[3] = RB[1]; *(LAS u32x4*)(lds + STAGE_BYTES + ofs_slot) = o4; asm volatile("" : "+v"(ofs_slot)); }
    const int aoff = lds_byte(wr * 64 + fr, fq * 8), boff = lds_byte(wc * 32 + fr, fq * 8);
#define PG8_SA(b, h) (((b) * 2 + (h)) * HTB)
#define PG8_SB(b, h) ((4 + (b) * 2 + (h)) * HTB)
#define PG8_STG(bufoff, gbase, RR, ld2) do { if constexpr (FP8) {   \
            const u32x4 _o4 = *(const LAS u32x4*)(lds + STAGE_BYTES + ofs_slot); const bool _isB = (&(RR)[0] == &RB[0]); \
            _Pragma("unroll") for (int _i = 0; _i < 2; ++_i) \
            __builtin_amdgcn_global_load_lds((const unsigned*)((const char*)(gbase) + (_isB ? _o4[2 + _i] : _o4[_i])), (LAS unsigned*)(lds + (bufoff) + ldsw + _i * 8192), 16, 0, 0); } \
        else { _Pragma("unroll") for (int _i = 0; _i < 2; ++_i) \
        __builtin_amdgcn_global_load_lds((const unsigned*)((const char*)(gbase) + (RR)[_i]), (LAS unsigned*)(lds + (bufoff) + ldsw + _i * 8192), 16, 0, 0); } } while (0)
#define PG8_LDA(dst, b, h) do { if constexpr (FP8) { _Pragma("unroll") for (int m = 0; m < 4; ++m) { \
            const u32x4 _lo = *(const LAS u32x4*)(lds + PG8_SA(b, h) + aoff + m * 2048), _hi = *(const LAS u32x4*)(lds + PG8_SA(b, h) + aoff + m * 2048 + 1024); \
            dst##_8[m] = __builtin_shufflevector(_lo, _hi, 0, 1, 2, 3, 4, 5, 6, 7); } } \
        else { _Pragma("unroll") for (int m = 0; m < 4; ++m) _Pragma("unroll") for (int k = 0; k < 2; ++k) dst[m][k] = *(const LAS bf16x8*)(lds + PG8_SA(b, h) + aoff + m * 2048 + k * 1024); } } while (0)
#define PG8_LDB(dst, b, h) do { if constexpr (FP8) { _Pragma("unroll") for (int n = 0; n < 2; ++n) { \
            const u32x4 _lo = *(const LAS u32x4*)(lds + PG8_SB(b, h) + boff + n * 2048), _hi = *(const LAS u32x4*)(lds + PG8_SB(b, h) + boff + n * 2048 + 1024); \
            dst##_8[n] = __builtin_shufflevector(_lo, _hi, 0, 1, 2, 3, 4, 5, 6, 7); } } \
        else { _Pragma("unroll") for (int n = 0; n < 2; ++n) _Pragma("unroll") for (int k = 0; k < 2; ++k) dst[n][k] = *(const LAS bf16x8*)(lds + PG8_SB(b, h) + boff + n * 2048 + k * 1024); } } while (0)
#define PG8_MMA(ai, bj, At, Bt) do { __builtin_amdgcn_s_setprio(1); \
        if constexpr (FP8) { _Pragma("unroll") for (int m = 0; m < 4; ++m) _Pragma("unroll") for (int n = 0; n < 2; ++n) \
            acc[ai][bj][m][n] = __builtin_amdgcn_mfma_scale_f32_16x16x128_f8f6f4(__builtin_bit_cast(i32x8, Bt##_8[n]), __builtin_bit_cast(i32x8, At##_8[m]), acc[ai][bj][m][n], 0, 0, 0, 0x7f7f7f7f, 0, 0x7f7f7f7f); } \
        else { _Pragma("unroll") for (int m = 0; m < 4; ++m) _Pragma("unroll") for (int n = 0; n < 2; ++n) _Pragma("unroll") for (int k = 0; k < 2; ++k) \
            acc[ai][bj][m][n] = __builtin_amdgcn_mfma_f32_16x16x32_bf16(Bt[n][k], At[m][k], acc[ai][bj][m][n], 0, 0, 0); } \
        __builtin_amdgcn_s_setprio(0); } while (0)
#define PG8_WAIT_V(n) asm volatile("s_waitcnt vmcnt(" #n ")" ::: "memory")
#define PG8_WAIT_L(n) asm volatile("s_waitcnt lgkmcnt(" #n ")" ::: "memory")
#define PG8_BAR __builtin_amdgcn_s_barrier()
#define PG8_SCHED __builtin_amdgcn_sched_barrier(0)
    Seg cur, nxt; int si = 0;
    if (!S.get(0, cur)) return;
    f32x4 acc[2][2][4][2];
#pragma unroll
    for (int a = 0; a < 2; ++a)
#pragma unroll
        for (int b = 0; b < 2; ++b)
#pragma unroll
            for (int m = 0; m < 4; ++m)
#pragma unroll
                for (int n = 0; n < 2; ++n) acc[a][b][m][n] = (f32x4){0.f, 0.f, 0.f, 0.f};
    bf16x8 At[4][2], B0[2][2], B1[2][2];
    u32x8 At_8[4], B0_8[2], B1_8[2];
    const char* cA = cur.A; const char* cB = cur.B;
    if constexpr (SP2) {
        PG8_STG(PG8_SB(0, 0), cB, RB, clb); PG8_STG(PG8_SB(0, 1), cB + (size_t)HALF * clb, RB, clb); PG8_STG(PG8_SA(0, 0), cA, RA, cla); PG8_STG(PG8_SA(0, 1), cA + (size_t)HALF * cla, RA, cla);
        if (wr == 1) PG8_BAR;
        PG8_WAIT_V(2); PG8_BAR;
        PG8_STG(PG8_SB(1, 0), cB + kstep, RB, clb); PG8_STG(PG8_SA(1, 0), cA + kstep, RA, cla); PG8_STG(PG8_SB(1, 1), cB + (size_t)HALF * clb + kstep, RB, clb);
        PG8_WAIT_V(6); PG8_BAR;
    } else {
    PG8_STG(PG8_SB(0, 0), cB, RB, clb); PG8_STG(PG8_SA(0, 0), cA, RA, cla); PG8_STG(PG8_SB(0, 1), cB + (size_t)HALF * clb, RB, clb); PG8_STG(PG8_SA(0, 1), cA + (size_t)HALF * cla, RA, cla);
    if (wr == 1) PG8_BAR;
    PG8_WAIT_V(4); PG8_BAR;
    PG8_STG(PG8_SB(1, 0), cB + kstep, RB, clb); PG8_STG(PG8_SA(1, 0), cA + kstep, RA, cla); PG8_STG(PG8_SB(1, 1), cB + (size_t)HALF * clb + kstep, RB, clb);
    PG8_WAIT_V(6); PG8_BAR;
    }
    for (;;) {
        const bool has_next = S.get(si + 1, nxt);
        const char* nA = has_next ? nxt.A : cA; const char* nB = has_next ? nxt.B : cB;
        const int nt = cur.nt;
        for (int t = 0; t < nt; t += 2) {
            const bool last = (t == nt - 2);
            const char* a1 = cA + (size_t)(t + 1) * kstep;
            const char* a2 = last ? nA : cA + (size_t)(t + 2) * kstep; const char* b2 = last ? nB : cB + (size_t)(t + 2) * kstep;
            const unsigned la2 = cla, lb2 = clb;
            const char* a3 = a2 + kstep; const char* b3 = b2 + kstep;
            if constexpr (SP2) {
            PG8_LDB(B0, 0, 0); PG8_LDB(B1, 0, 1); PG8_SCHED; PG8_LDA(At, 0, 0); PG8_STG(PG8_SA(1, 1), a1 + (size_t)HALF * cla, RA, cla);
            PG8_WAIT_V(8); PG8_WAIT_L(0); PG8_BAR; PG8_MMA(0, 0, At, B0); PG8_MMA(0, 1, At, B1); PG8_BAR; PG8_SCHED;
            PG8_LDA(At, 0, 1); PG8_STG(PG8_SB(0, 0), b2, RB, lb2); PG8_STG(PG8_SB(0, 1), b2 + (size_t)HALF * lb2, RB, lb2); PG8_STG(PG8_SA(0, 0), a2, RA, la2);
            PG8_WAIT_V(8); PG8_WAIT_L(0); PG8_BAR; PG8_MMA(1, 0, At, B0); PG8_MMA(1, 1, At, B1); PG8_BAR; PG8_SCHED;
            PG8_LDB(B0, 1, 0); PG8_LDB(B1, 1, 1); PG8_SCHED; PG8_LDA(At, 1, 0); PG8_STG(PG8_SA(0, 1), a2 + (size_t)HALF * la2, RA, la2);
            PG8_WAIT_V(8); PG8_WAIT_L(0); PG8_BAR; PG8_MMA(0, 0, At, B0); PG8_MMA(0, 1, At, B1); PG8_BAR; PG8_SCHED;
            PG8_LDA(At, 1, 1); PG8_STG(PG8_SB(1, 0), b3, RB, lb2); PG8_STG(PG8_SB(1, 1), b3 + (size_t)HALF * lb2, RB, lb2); PG8_STG(PG8_SA(1, 0), a3, RA, la2);
            PG8_WAIT_V(8); PG8_WAIT_L(0); PG8_BAR; PG8_MMA(1, 0, At, B0); PG8_MMA(1, 1, At, B1); PG8_BAR; PG8_SCHED;
            } else {
            PG8_LDB(B0, 0, 0); PG8_SCHED; PG8_LDA(At, 0, 0); PG8_STG(PG8_SA(1, 1), a1 + (size_t)HALF * cla, RA, cla);
            PG8_WAIT_L(8); PG8_BAR; PG8_WAIT_L(0); PG8_MMA(0, 0, At, B0); PG8_BAR; PG8_SCHED;
            PG8_LDB(B1, 0, 1); PG8_STG(PG8_SB(0, 0), b2, RB, lb2);
            PG8_BAR; PG8_WAIT_L(0); PG8_MMA(0, 1, At, B1); PG8_BAR;
            PG8_LDA(At, 0, 1); PG8_STG(PG8_SA(0, 0), a2, RA, la2);
            PG8_BAR; PG8_WAIT_L(0); PG8_MMA(1, 0, At, B0); PG8_BAR; PG8_SCHED;
            PG8_STG(PG8_SB(0, 1), b2 + (size_t)HALF * lb2, RB, lb2);
            PG8_WAIT_V(6); PG8_BAR; PG8_MMA(1, 1, At, B1); PG8_BAR;
            PG8_LDB(B0, 1, 0); PG8_SCHED; PG8_LDA(At, 1, 0); PG8_STG(PG8_SA(0, 1), a2 + (size_t)HALF * la2, RA, la2);
            PG8_WAIT_L(8); PG8_BAR; PG8_WAIT_L(0); PG8_MMA(0, 0, At, B0); PG8_BAR; PG8_SCHED;
            PG8_LDB(B1, 1, 1); PG8_STG(PG8_SB(1, 0), b3, RB, lb2);
            PG8_BAR; PG8_WAIT_L(0); PG8_MMA(0, 1, At, B1); PG8_BAR;
            PG8_LDA(At, 1, 1); PG8_STG(PG8_SA(1, 0), a3, RA, la2);
            PG8_BAR; PG8_WAIT_L(0); PG8_MMA(1, 0, At, B0); PG8_BAR; PG8_SCHED;
            PG8_STG(PG8_SB(1, 1), b3 + (size_t)HALF * lb2, RB, lb2);
            PG8_WAIT_V(6); PG8_BAR; PG8_MMA(1, 1, At, B1); PG8_BAR;
            }
        }
        if constexpr (ALIGN_EPI) { if (wr == 0) PG8_BAR; }
        const bool done = E.after(acc, cur, wr, wc, fr, fq);
        if (!has_next) break;
        if (done) {
#pragma unroll
            for (int a = 0; a < 2; ++a)
#pragma unroll
                for (int b = 0; b < 2; ++b)
#pragma unroll
                    for (int m = 0; m < 4; ++m)
#pragma unroll
                        for (int n = 0; n < 2; ++n) acc[a][b][m][n] = (f32x4){0.f, 0.f, 0.f, 0.f};
        }
        cur = nxt; cA = nA; cB = nB; ++si;
        if constexpr (ALIGN_EPI) { if (wr == 1) PG8_BAR; }
    }
    PG8_WAIT_V(0);
    if constexpr (!ALIGN_EPI) { if (wr == 0) PG8_BAR; }
    PG8_BAR;
#undef PG8_SA
#undef PG8_SB
#undef PG8_STG
#undef PG8_LDA
#undef PG8_LDB
#undef PG8_MMA
#undef PG8_WAIT_V
#undef PG8_WAIT_L
#undef PG8_BAR
#undef PG8_SCHED
}
}

__device__ __forceinline__ void phase0(const P& p, LAS unsigned char* lds) {
    float* mod = (float*)(p.ws + WS_MOD);
    LAS float* sc = (LAS float*)lds;
    LAS float* red = sc + 4096;
    const int tid = opaque_tid();
    for (int i = tid; i < 4096; i += NTHREADS) { const float v = p.c[i]; sc[i] = v / (1.0f + __expf(-v)); }
    __syncthreads();
    const int cl = tid & 63, kg = tid >> 6;
    for (int item = blockIdx.x; item < DEPTH * 96; item += gridDim.x) {
        const int l = item / 96, j = (item % 96) * 64 + cl;
        const float* w = p.w_mod + (size_t)l * 1024 * 6144 + j;
        float a0 = 0.f, a1 = 0.f, a2 = 0.f, a3 = 0.f;
#pragma unroll 8
        for (int k = kg * 128; k < kg * 128 + 128; ++k) { const float wv = w[(size_t)k * 6144]; a0 += sc[k] * wv; a1 += sc[1024 + k] * wv; a2 += sc[2048 + k] * wv; a3 += sc[3072 + k] * wv; }
        red[(kg * 64 + cl) * 4 + 0] = a0; red[(kg * 64 + cl) * 4 + 1] = a1; red[(kg * 64 + cl) * 4 + 2] = a2; red[(kg * 64 + cl) * 4 + 3] = a3;
        __syncthreads();
        if (tid < 256) { const int b = tid >> 6, c2 = tid & 63; float s = 0.f;
#pragma unroll
            for (int g = 0; g < 8; ++g) s += red[(g * 64 + c2) * 4 + b];
            const int jj = (item % 96) * 64 + c2; mod[(size_t)(l * 4 + b) * 6144 + jj] = s + p.b_mod[l * 6144 + jj]; }
        __syncthreads();
    }
    float* biasA = (float*)(p.ws + WS_BIASA); float* biasC = (float*)(p.ws + WS_BIASC);
    for (int i = blockIdx.x * NTHREADS + tid; i < 8 * 8192; i += gridDim.x * NTHREADS) { const int h = i >> 13, d = i & 8191; biasC[i] = p.rel_bias[t5_bucket(d) * 16 + 8 + h]; }
    for (int i = blockIdx.x * NTHREADS + tid; i < 8 * 128; i += gridDim.x * NTHREADS) { const int h = i >> 7, d = i & 127; biasA[i] = p.rel_bias[t5_bucket(d) * 16 + h]; }
}

__device__ __forceinline__ void phase_norm(const float* xsrc, const float* gain, const float* mod_l, int shift_off, int scale_off, int b0, bf16_t* H, unsigned char* H8) {
    const int tid = opaque_tid(), wid = tid >> 6, lane = tid & 63;
    constexpr int RPW = TC / (256 * 8);
    const int wglob = blockIdx.x * 8 + wid, nw = gridDim.x * 8;
    for (int r0 = wglob * 4; r0 < TC; r0 += nw * 4) {
        f32x4 v[4][4]; float ss[4];
#pragma unroll
        for (int q = 0; q < 4; ++q) { const f32x4* xr = (const f32x4*)(xsrc + (size_t)(r0 + q) * DM);
#pragma unroll
            for (int i = 0; i < 4; ++i) v[q][i] = xr[lane + 64 * i]; }
#pragma unroll
        for (int q = 0; q < 4; ++q) { float a = 0.f;
#pragma unroll
            for (int i = 0; i < 4; ++i) a += v[q][i][0] * v[q][i][0] + v[q][i][1] * v[q][i][1] + v[q][i][2] * v[q][i][2] + v[q][i][3] * v[q][i][3];
            ss[q] = a; }
#pragma unroll
        for (int off = 32; off >= 1; off >>= 1) {
#pragma unroll
            for (int q = 0; q < 4; ++q) ss[q] += __shfl_xor(ss[q], off); }
        const float* mb = mod_l + (size_t)(b0 + r0 / SEQ) * 6144;
#pragma unroll
        for (int i = 0; i < 4; ++i) { const int col = (lane + 64 * i) * 4;
            const f32x4 g = *(const f32x4*)(gain + col), sc = *(const f32x4*)(mb + scale_off + col), sh = *(const f32x4*)(mb + shift_off + col);
#pragma unroll
            for (int q = 0; q < 4; ++q) { const float rinv = rsqrtf(ss[q] * (1.0f / 1024.0f) + RMS_EPS);
                float h[4];
#pragma unroll
                for (int e = 0; e < 4; ++e) h[e] = (v[q][i][e] * rinv * g[e]) * (1.0f + sc[e]) + sh[e];
                u32x2 pk; pk[0] = cvt_pk_bf16(h[0], h[1]); pk[1] = cvt_pk_bf16(h[2], h[3]);
                *(u32x2*)(H + (size_t)(r0 + q) * DM + col) = pk;
                if (H8) { unsigned p8 = 0u; p8 = __builtin_amdgcn_cvt_pk_fp8_f32(h[0], h[1], p8, false); p8 = __builtin_amdgcn_cvt_pk_fp8_f32(h[2], h[3], p8, true);
                    *(unsigned*)(H8 + (size_t)(r0 + q) * DM + col) = p8; } } }
    }
    (void)RPW;
}

__device__ __forceinline__ void phase_convert(const P& p, int l, LAS unsigned char* lds) {
    LAS float* t = (LAS float*)lds;
    constexpr int NJ = 8;
    const float* srcs[NJ] = { p.w_in + (size_t)l * 1024 * DIN, p.w_branch + (size_t)l * 2048 * 1024, p.w_out + (size_t)l * 1024 * 1024, p.w_up + (size_t)l * 1024 * DFF2,
        p.w_down + (size_t)l * DFF * 1024, p.ga_w + (size_t)l * 1024 * 64, p.gx_w + (size_t)l * 1024 * 64, p.w_in + (size_t)l * 1024 * DIN + C_G };
    const int Ks[NJ] = { 1024, 2048, 1024, 1024, DFF, 1024, 1024, 1024 };
    const int Ns[NJ] = { C_G, 1024, 1024, DFF2, 1024, 64, 64, 3072 };
    const int Ls[NJ] = { DIN, 1024, 1024, DFF2, 1024, 64, 64, DIN };
    const size_t dsts[NJ] = { WS_WIN, WS_WB, WS_WOUT, WS_WUP, WS_WDOWN, WS_GT, WS_GT + (size_t)64 * 1024 * 2, WS_WG8 };
    const int tid = opaque_tid();
    const int r = tid >> 4, c4 = (tid & 15) * 4, n = tid >> 3, kk = (tid & 7) * 8;
    int base = 0;
#pragma unroll
    for (int j = 0; j < NJ; ++j) {
        const int tn = Ns[j] / 64, ntile = (Ks[j] / 64) * tn;
        const float* src = srcs[j]; const int ldn = Ls[j], ldk = Ks[j]; bf16_t* dst = (bf16_t*)(p.ws + dsts[j]);
        int ti = (int)blockIdx.x - (base % (int)gridDim.x); if (ti < 0) ti += gridDim.x;
        f32x4 v0 = (f32x4){0.f, 0.f, 0.f, 0.f}, v1 = v0;
        if (ti < ntile) { const int kt = ti / tn, nn = ti - kt * tn; const float* sp = src + (size_t)(kt * 64 + r) * ldn + nn * 64 + c4; v0 = *(const f32x4*)sp; v1 = *(const f32x4*)(sp + (size_t)32 * ldn); }
        for (; ti < ntile; ti += gridDim.x) {
            const int kt = ti / tn, nn = ti - kt * tn;
            t[r * 65 + c4 + 0] = v0[0]; t[r * 65 + c4 + 1] = v0[1]; t[r * 65 + c4 + 2] = v0[2]; t[r * 65 + c4 + 3] = v0[3];
            t[(r + 32) * 65 + c4 + 0] = v1[0]; t[(r + 32) * 65 + c4 + 1] = v1[1]; t[(r + 32) * 65 + c4 + 2] = v1[2]; t[(r + 32) * 65 + c4 + 3] = v1[3];
            __syncthreads();
            const int tnx = ti + (int)gridDim.x;
            if (tnx < ntile) { const int kt2 = tnx / tn, nn2 = tnx - kt2 * tn; const float* sp = src + (size_t)(kt2 * 64 + r) * ldn + nn2 * 64 + c4; v0 = *(const f32x4*)sp; v1 = *(const f32x4*)(sp + (size_t)32 * ldn); }
            if (j == 7) { u32x2 p8; p8[0] = 0u; p8[1] = 0u;
#pragma unroll
                for (int q = 0; q < 2; ++q) { p8[q] = __builtin_amdgcn_cvt_pk_fp8_f32(t[(kk + 4 * q) * 65 + n] * 64.0f, t[(kk + 4 * q + 1) * 65 + n] * 64.0f, p8[q], false);
                    p8[q] = __builtin_amdgcn_cvt_pk_fp8_f32(t[(kk + 4 * q + 2) * 65 + n] * 64.0f, t[(kk + 4 * q + 3) * 65 + n] * 64.0f, p8[q], true); }
                *(u32x2*)((unsigned char*)dst + (size_t)(nn * 64 + n) * ldk + kt * 64 + kk) = p8; }
            else { u32x4 pk;
#pragma unroll
                for (int q = 0; q < 4; ++q) pk[q] = cvt_pk_bf16(t[(kk + 2 * q) * 65 + n], t[(kk + 2 * q + 1) * 65 + n]);
                *(u32x4*)(dst + (size_t)(nn * 64 + n) * ldk + kt * 64 + kk) = pk; }
            __syncthreads();
        }
        base += ntile;
    }
}

__device__ __forceinline__ void phase_qknorm(const P& p, int l, bf16_t* z) {
    const int tid = opaque_tid(), wid = tid >> 6, lane = tid & 63, g8 = lane & 7;
    float gqa[8], gka[8], gqc[8];
#pragma unroll
    for (int j = 0; j < 8; ++j) { gqa[j] = p.qnorm_a[l * 64 + g8 * 8 + j]; gka[j] = p.knorm_a[l * 64 + g8 * 8 + j]; gqc[j] = p.qnorm_c[l * 64 + g8 * 8 + j]; }
    for (int r0 = (blockIdx.x * 8 + wid) * 4; r0 < TC; r0 += gridDim.x * 8 * 4) {
        u32x4 raw[4][3];
#pragma unroll
        for (int q = 0; q < 4; ++q) { const bf16_t* rowp = z + (size_t)(r0 + q) * DIN;
            raw[q][0] = *(const u32x4*)(rowp + C_QA + lane * 8); raw[q][1] = *(const u32x4*)(rowp + C_KA + (lane & 15) * 8); raw[q][2] = *(const u32x4*)(rowp + C_QC + lane * 8); }
#pragma unroll
        for (int q = 0; q < 4; ++q) { bf16_t* rowp = z + (size_t)(r0 + q) * DIN;
#pragma unroll
            for (int it = 0; it < 3; ++it) {
                const int col = (it == 0) ? C_QA + lane * 8 : (it == 1) ? C_KA + (lane & 15) * 8 : C_QC + lane * 8;
                float f[8]; unpack8(raw[q][it], f);
                float ss = 0.f;
#pragma unroll
                for (int j = 0; j < 8; ++j) ss += f[j] * f[j];
                ss += __shfl_xor(ss, 1); ss += __shfl_xor(ss, 2); ss += __shfl_xor(ss, 4);
                const float rinv = rsqrtf(ss * (1.0f / 64.0f) + RMS_EPS);
                u32x4 pk;
#pragma unroll
                for (int j = 0; j < 4; ++j) { const float g0 = (it == 0) ? gqa[2 * j] : (it == 1) ? gka[2 * j] : gqc[2 * j], g1 = (it == 0) ? gqa[2 * j + 1] : (it == 1) ? gka[2 * j + 1] : gqc[2 * j + 1];
                    pk[j] = cvt_pk_bf16(f[2 * j] * rinv * g0, f[2 * j + 1] * rinv * g1); }
                if (it != 1 || lane < 16) *(u32x4*)(rowp + col) = pk;
            } }
    }
}
__device__ __forceinline__ void phase_kcnorm(const P& p, int l, bf16_t* z, LAS unsigned char* lds) {
    LAS float* red = (LAS float*)lds;
    LAS bf16_t* sT = (LAS bf16_t*)(lds + 16384);
    float* kmean = (float*)(p.ws + WS_KMEAN);
    const int tid = opaque_tid(), g8 = tid & 7, tg = tid >> 3;
    float gk[8];
#pragma unroll
    for (int j = 0; j < 8; ++j) gk[j] = p.knorm_c[l * 64 + g8 * 8 + j];
    for (int item = blockIdx.x; item < BPC * 8 * 32; item += gridDim.x) {
        const int m = item & 31, h = (item >> 5) & 7, bl = item >> 8;
        bf16_t* kbase = z + ((size_t)bl * SEQ + m * 256 + tg) * DIN + C_KC + h * 64 + g8 * 8;
        u32x4 kraw[4], vraw[4];
#pragma unroll
        for (int ps = 0; ps < 4; ++ps) kraw[ps] = *(const u32x4*)(kbase + (size_t)ps * 64 * DIN);
#pragma unroll
        for (int k = 0; k < 4; ++k) { const int i = tid + k * NTHREADS, kj = i >> 3, c8 = (i & 7) * 8;
            vraw[k] = *(const u32x4*)(z + ((size_t)bl * SEQ + m * 256 + kj) * DIN + C_VC + h * 64 + c8); }
        float ms[8];
#pragma unroll
        for (int j = 0; j < 8; ++j) ms[j] = 0.f;
#pragma unroll
        for (int ps = 0; ps < 4; ++ps) {
            float f[8]; unpack8(kraw[ps], f);
            float ss = 0.f;
#pragma unroll
            for (int j = 0; j < 8; ++j) ss += f[j] * f[j];
            ss += __shfl_xor(ss, 1); ss += __shfl_xor(ss, 2); ss += __shfl_xor(ss, 4);
            const float rinv = rsqrtf(ss * (1.0f / 64.0f) + RMS_EPS);
            float y[8];
#pragma unroll
            for (int j = 0; j < 8; ++j) { y[j] = f[j] * rinv * gk[j]; ms[j] += y[j]; }
            u32x4 pk;
#pragma unroll
            for (int j = 0; j < 4; ++j) pk[j] = cvt_pk_bf16(y[2 * j], y[2 * j + 1]);
            *(u32x4*)(kbase + (size_t)ps * 64 * DIN) = pk;
        }
#pragma unroll
        for (int j = 0; j < 8; ++j) red[tg * 64 + g8 * 8 + j] = ms[j];
#pragma unroll
        for (int k = 0; k < 4; ++k) { const int i = tid + k * NTHREADS, kj = i >> 3, c8 = (i & 7) * 8; *(LAS u32x4*)(sT + kj * 72 + c8) = vraw[k]; }
        __syncthreads();
        if (tid < 64) { float sm = 0.f; for (int g = 0; g < 64; ++g) sm += red[g * 64 + tid]; kmean[((size_t)(bl * 8 + h) * 32 + m) * 64 + tid] = sm * (1.0f / 256.0f); }
        {
            bf16_t* Vtg = (bf16_t*)(p.ws + WS_VTC) + (size_t)(bl * 8 + h) * 64 * SEQ;
            const int d = tid >> 3, tgp = tid & 7;
#pragma unroll
            for (int g = 0; g < 4; ++g) { const int t8 = tgp * 32 + g * 8; u32x4 pk;
#pragma unroll
                for (int j = 0; j < 4; ++j) pk[j] = (unsigned)sT[(t8 + 2 * j) * 72 + d] | ((unsigned)sT[(t8 + 2 * j + 1) * 72 + d] << 16);
                *(u32x4*)(Vtg + (size_t)d * SEQ + m * 256 + t8) = pk; }
        }
        __syncthreads();
    }
}

__device__ __forceinline__ void phase_rnn0(const P& p, int l, LAS unsigned char* lds, const bf16_t* z) {
    LAS float* sX = (LAS float*)lds;
    LAS float* sA = sX + 131 * 64 + 64;
    LAS float* sU = sA + 128 * 64;
    LAS float* sS = sU + 128 * 64;
    LAS bf16_t* sXb = (LAS bf16_t*)(sS + 8 * 64 * 2);
    LAS bf16_t* sGt = sXb + 128 * 72;
    float* rsum = (float*)(p.ws + WS_RSUM);
    const bf16_t* Gt = (const bf16_t*)(p.ws + WS_GT);
    bf16_t* OM = (bf16_t*)(p.ws + WS_ACT); bf16_t* UU = OM + (size_t)TC * 1024;
    const int tid = opaque_tid(), wid = tid >> 6, lane = tid & 63, fr = lane & 15, fq = lane >> 4;
    const int nbg = (int)gridDim.x >> 4;
    const int nb = blockIdx.x & 15, first = (int)blockIdx.x >> 4;
    if (first >= nbg) return;
    for (int i = tid; i < 2 * 64 * 8; i += NTHREADS) { const int g = i >> 9, d = (i >> 3) & 63, c8 = (i & 7) * 8;
        *(LAS u32x4*)(sGt + (g * 64 + d) * 72 + c8) = *(const u32x4*)(Gt + (size_t)g * 64 * 1024 + (size_t)d * 1024 + nb * 64 + c8); }
    const int ch = nb * 64 + lane;
    const float w0 = p.rnn_conv_w[(size_t)(l * 4 + 0) * 1024 + ch], w1 = p.rnn_conv_w[(size_t)(l * 4 + 1) * 1024 + ch], w2 = p.rnn_conv_w[(size_t)(l * 4 + 2) * 1024 + ch],
                w3 = p.rnn_conv_w[(size_t)(l * 4 + 3) * 1024 + ch], cb = p.rnn_conv_b[l * 1024 + ch];
    float bra[4], bix[4], spv[4];
#pragma unroll
    for (int nt = 0; nt < 4; ++nt) { const int chd = nb * 64 + nt * 16 + fr; bra[nt] = p.ga_b[l * 1024 + chd]; bix[nt] = p.gx_b[l * 1024 + chd];
        const float lamv = p.lam[l * 1024 + chd]; spv[nt] = (lamv > 15.f) ? __expf(-lamv) : log1p_small(__expf(-lamv)); }
    u32x4 xr[3];
#define RNN_PREFETCH(idx_) do { const int bl_ = (idx_) >> 6, t0_ = ((idx_) & 63) * 128; _Pragma("unroll") for (int k_ = 0; k_ < 3; ++k_) { const int i_ = tid + k_ * NTHREADS; const int rr_ = i_ >> 3, c8_ = (i_ & 7) * 8, t_ = t0_ - 3 + rr_; \
        xr[k_] = (u32x4){0u, 0u, 0u, 0u}; if (i_ < 131 * 8 && t_ >= 0) xr[k_] = *(const u32x4*)(z + ((size_t)bl_ * SEQ + t_) * DIN + C_XR + nb * 64 + c8_); } } while (0)
    RNN_PREFETCH(first);
    for (int idx = first; idx < BPC * 64; idx += nbg) {
        const int bl = idx >> 6, seg = idx & 63, t0 = seg * 128;
#pragma unroll
        for (int k = 0; k < 3; ++k) { const int i = tid + k * NTHREADS; if (i < 131 * 8) { const int rr = i >> 3, c8 = (i & 7) * 8; float f[8]; unpack8(xr[k], f);
            *(LAS f32x4*)(sX + rr * 64 + c8) = (f32x4){f[0], f[1], f[2], f[3]}; *(LAS f32x4*)(sX + rr * 64 + c8 + 4) = (f32x4){f[4], f[5], f[6], f[7]}; } }
        __syncthreads();
        if (idx + nbg < BPC * 64) RNN_PREFETCH(idx + nbg);
#pragma unroll
        for (int i = 0; i < 16; ++i) { const int tt = wid * 16 + i;
            const float xc = cb + w0 * sX[(tt + 0) * 64 + lane] + w1 * sX[(tt + 1) * 64 + lane] + w2 * sX[(tt + 2) * 64 + lane] + w3 * sX[(tt + 3) * 64 + lane];
            sXb[tt * 72 + lane] = f2bf(xc); }
        __syncthreads();
        { bf16x8 a[2];
#pragma unroll
          for (int ks = 0; ks < 2; ++ks) a[ks] = *(const LAS bf16x8*)(sXb + (16 * wid + fr) * 72 + ks * 32 + fq * 8);
#pragma unroll
          for (int nt = 0; nt < 4; ++nt) {
              f32x4 ar = (f32x4){0.f, 0.f, 0.f, 0.f}, ai = (f32x4){0.f, 0.f, 0.f, 0.f};
#pragma unroll
              for (int ks = 0; ks < 2; ++ks) {
                  const bf16x8 br = *(const LAS bf16x8*)(sGt + (nt * 16 + fr) * 72 + ks * 32 + fq * 8);
                  const bf16x8 bi = *(const LAS bf16x8*)(sGt + (64 + nt * 16 + fr) * 72 + ks * 32 + fq * 8);
                  ar = mfma16(a[ks], br, ar); ai = mfma16(a[ks], bi, ai); }
              const int d = nt * 16 + fr;
#pragma unroll
              for (int j = 0; j < 4; ++j) { const int tok = 16 * wid + 4 * fq + j;
                  const float r = __builtin_amdgcn_rcpf(1.0f + __expf(-(ar[j] + bra[nt]))), ig = __builtin_amdgcn_rcpf(1.0f + __expf(-(ai[j] + bix[nt])));
                  const float log_a = -8.0f * r * spv[nt]; const float av = __expf(log_a);
                  const float x2 = 2.0f * log_a;
                  const float om2 = (x2 > -0.25f) ? -x2 * (1.0f + x2 * (0.5f + x2 * (0.16666667f + x2 * (0.041666668f + x2 * (0.0083333338f + x2 * 0.0013888889f))))) : 1.0f - av * av;
                  float mult = __builtin_amdgcn_sqrtf(fmaxf(om2, 0.f));
                  if (t0 + tok == 0) mult = 1.0f;
                  sA[tok * 64 + d] = av; sU[tok * 64 + d] = mult * (ig * bf2f((unsigned)sXb[tok * 72 + d])); }
          } }
        __syncthreads();
        { float hl = 0.f, Pp = 1.f;
          const unsigned go0 = (unsigned)((bl * SEQ + t0 + wid * 16) * 1024 + ch);
#pragma unroll 4
          for (int i = 0; i < 16; ++i) { const int tt = wid * 16 + i;
              const bf16_t omb = f2bf(1.0f - sA[tt * 64 + lane]), ub = f2bf(sU[tt * 64 + lane]);
              const float av = 1.0f - bf2f((unsigned)omb), uv = bf2f((unsigned)ub);
              OM[go0 + (unsigned)i * 1024u] = omb; UU[go0 + (unsigned)i * 1024u] = ub;
              hl = av * hl + uv; Pp *= av; }
          sS[(wid * 64 + lane) * 2] = Pp; sS[(wid * 64 + lane) * 2 + 1] = hl; }
        __syncthreads();
        if (wid == 0) { float Pt = 1.f, Ht = 0.f;
#pragma unroll
            for (int w = 0; w < 8; ++w) { const float Pw = sS[(w * 64 + lane) * 2], Hw = sS[(w * 64 + lane) * 2 + 1]; Ht = Pw * Ht + Hw; Pt *= Pw; }
            float* o = rsum + ((size_t)(bl * 64 + seg) * 1024 + ch) * 2; o[0] = Pt; o[1] = Ht; }
    }
#undef RNN_PREFETCH
    __syncthreads();
}

__device__ __forceinline__ void phase_rnn_apply(const P& p, LAS unsigned char* lds, bf16_t* z) {
    LAS float* sS = (LAS float*)lds;
    LAS float* sC = sS + 8 * 64 * 2;
    const float* rsum = (const float*)(p.ws + WS_RSUM);
    const bf16_t* OM = (const bf16_t*)(p.ws + WS_ACT); const bf16_t* UU = OM + (size_t)TC * 1024;
    const int tid = opaque_tid(), wid = tid >> 6, lane = tid & 63;
    constexpr int N_RNN = BPC * 16 * 64;
    unsigned short ra[16], ru[16], ry[16]; float pp[8], hh[8];
#define RNN1_PREFETCH(j_) do { const int seg_ = (j_) & 63, nb_ = ((j_) >> 6) & 15, bl_ = (j_) >> 10; const int ch_ = nb_ * 64 + lane; const unsigned r_ = (unsigned)(bl_ * SEQ + seg_ * 128 + wid * 16); \
        _Pragma("unroll") for (int i_ = 0; i_ < 16; ++i_) { ra[i_] = OM[(r_ + i_) * 1024u + ch_]; ru[i_] = UU[(r_ + i_) * 1024u + ch_]; ry[i_] = z[(size_t)(r_ + i_) * DIN + C_YR + ch_]; } \
        _Pragma("unroll") for (int k_ = 0; k_ < 8; ++k_) { const int s2_ = wid * 8 + k_; pp[k_] = 1.f; hh[k_] = 0.f; \
            if (s2_ < seg_) { const float2 o_ = *(const float2*)(rsum + ((size_t)(bl_ * 64 + s2_) * 1024 + ch_) * 2); pp[k_] = o_.x; hh[k_] = o_.y; } } } while (0)
    int j = blockIdx.x;
    if (j < N_RNN) RNN1_PREFETCH(j);
    for (; j < N_RNN; j += gridDim.x) {
        const int seg = j & 63, nb = (j >> 6) & 15, bl = j >> 10; const int ch = nb * 64 + lane; const unsigned r0 = (unsigned)(bl * SEQ + seg * 128 + wid * 16);
        float a16[16], u16[16], y16[16];
#pragma unroll
        for (int i = 0; i < 16; ++i) { a16[i] = 1.0f - bf2f((unsigned)ra[i]); u16[i] = bf2f((unsigned)ru[i]); y16[i] = bf2f((unsigned)ry[i]); }
        { float Pw = 1.f, Hw = 0.f;
#pragma unroll
          for (int k = 0; k < 8; ++k) { Hw = pp[k] * Hw + hh[k]; Pw *= pp[k]; }
          sC[(wid * 64 + lane) * 2] = Pw; sC[(wid * 64 + lane) * 2 + 1] = Hw; }
        if (j + (int)gridDim.x < N_RNN) RNN1_PREFETCH(j + (int)gridDim.x);
        { float hl = 0.f, Pp = 1.f;
#pragma unroll
          for (int i = 0; i < 16; ++i) { hl = a16[i] * hl + u16[i]; Pp *= a16[i]; }
          sS[(wid * 64 + lane) * 2] = Pp; sS[(wid * 64 + lane) * 2 + 1] = hl; }
        __syncthreads();
        float h = 0.f;
#pragma unroll
        for (int w = 0; w < 8; ++w) h = sC[(w * 64 + lane) * 2] * h + sC[(w * 64 + lane) * 2 + 1];
        for (int w = 0; w < wid; ++w) h = sS[(w * 64 + lane) * 2] * h + sS[(w * 64 + lane) * 2 + 1];
#pragma unroll 4
        for (int i = 0; i < 16; ++i) { h = a16[i] * h + u16[i];
            z[(size_t)(r0 + i) * DIN + C_YR + ch] = f2bf(h * gelu_tanh(y16[i])); }
        __syncthreads();
    }
#undef RNN1_PREFETCH
}

__device__ __forceinline__ void swa_item(const P& p, int l, LAS unsigned char* lds, bf16_t* z, int bl, int kvh, int qb, float Mb) {
    LAS bf16_t* sK = (LAS bf16_t*)lds;
    LAS bf16_t* sVt = sK + 256 * 72;
    LAS float* sBA = (LAS float*)(lds + 70656);
    const float* biasA = (const float*)(p.ws + WS_BIASA);
    const int tid = opaque_tid(), wid = tid >> 6, lane = tid & 63, fr = lane & 15, fq = lane >> 4;
    const size_t rq0 = (size_t)bl * SEQ + (size_t)qb * 128;
    bf16x8 q[2][4];
#pragma unroll
    for (int i = 0; i < 2; ++i) { const int tile = wid + 8 * i, g = tile >> 2, q0 = (tile & 3) * 32;
        const bf16_t* qp = z + (rq0 + q0 + fr) * DIN + C_QA + (kvh * 4 + g) * 64 + fq * 8;
        q[i][0] = *(const bf16x8*)qp; q[i][1] = *(const bf16x8*)(qp + 32); q[i][2] = *(const bf16x8*)(qp + (size_t)16 * DIN); q[i][3] = *(const bf16x8*)(qp + (size_t)16 * DIN + 32); }
    for (int i = tid; i < 256 * 8; i += NTHREADS) { const int sj = i >> 3, c8 = (i & 7) * 8; const int tk = (qb - 1) * 128 + sj;
        u32x4 kv = (u32x4){0u, 0u, 0u, 0u}, vv = (u32x4){0u, 0u, 0u, 0u};
        if (tk >= 0) { const bf16_t* rowp = z + ((size_t)bl * SEQ + tk) * DIN; kv = *(const u32x4*)(rowp + C_KA + kvh * 64 + c8); vv = *(const u32x4*)(rowp + C_VA + kvh * 64 + c8); }
        *(LAS u32x4*)(sK + sj * 72 + c8) = kv;
#pragma unroll
        for (int j = 0; j < 4; ++j) { sVt[(c8 + 2 * j) * 264 + sj] = (bf16_t)(vv[j] & 0xffffu); sVt[(c8 + 2 * j + 1) * 264 + sj] = (bf16_t)(vv[j] >> 16); } }
    for (int i = tid; i < 4 * 384; i += NTHREADS) { const int g = i / 384, diff = i - g * 384 - 128; const int hq = kvh * 4 + g;
        const float Mh = fmaxf(Mb, p.sinks[l * 8 + hq]);
        sBA[i] = (diff >= 0 && diff < 128) ? (biasA[hq * 128 + diff] - Mh) * 1.4426950408889634f : -1.0e30f; }
    __syncthreads();
#pragma unroll
    for (int i = 0; i < 2; ++i) { const int tile = wid + 8 * i, g = tile >> 2, q0 = (tile & 3) * 32; const int hq = kvh * 4 + g;
        const LAS float* pbA = sBA + g * 384 + 128 + (q0 + fr + 128 - 4 * fq - 255); const LAS float* pbB = pbA + 16;
        float lsA = 0.f, lsB = 0.f;
        f32x4 oA[4], oB[4];
#pragma unroll
        for (int nd = 0; nd < 4; ++nd) { oA[nd] = (f32x4){0.f, 0.f, 0.f, 0.f}; oB[nd] = (f32x4){0.f, 0.f, 0.f, 0.f}; }
        int kq0 = (q0 + 1) >> 6; const int kq1 = ((q0 + 159) >> 6) + 1;
        if (qb == 0 && kq0 < 2) kq0 = 2;
        for (int kq = kq0; kq < kq1; ++kq) {
            unsigned pkA[4][2], pkB[4][2];
            const LAS float* pa = pbA - kq * 64; const LAS float* pb = pbB - kq * 64;
#pragma unroll
            for (int nt = 0; nt < 4; ++nt) {
                const LAS bf16_t* kp = sK + (kq * 64 + nt * 16 + fr) * 72 + fq * 8;
                const bf16x8 k0 = *(const LAS bf16x8*)kp, k1 = *(const LAS bf16x8*)(kp + 32);
                f32x4 aA = (f32x4){0.f, 0.f, 0.f, 0.f}, aB = (f32x4){0.f, 0.f, 0.f, 0.f};
                aA = mfma16(k0, q[i][0], aA); aB = mfma16(k0, q[i][2], aB); aA = mfma16(k1, q[i][1], aA); aB = mfma16(k1, q[i][3], aB);
                float pjA[4], pjB[4];
#pragma unroll
                for (int j = 0; j < 4; ++j) {
                    const float pvA = __builtin_amdgcn_exp2f(aA[j] * 0.18033688011112042f + pa[255 - nt * 16 - j]), pvB = __builtin_amdgcn_exp2f(aB[j] * 0.18033688011112042f + pb[255 - nt * 16 - j]);
                    lsA += pvA; lsB += pvB; pjA[j] = pvA; pjB[j] = pvB; }
                pkA[nt][0] = cvt_pk_bf16(pjA[0], pjA[1]); pkA[nt][1] = cvt_pk_bf16(pjA[2], pjA[3]);
                pkB[nt][0] = cvt_pk_bf16(pjB[0], pjB[1]); pkB[nt][1] = cvt_pk_bf16(pjB[2], pjB[3]); }
#pragma unroll
            for (int tt = 0; tt < 2; ++tt) {
                u32x4 bwA, bwB; bwA[0] = pkA[2 * tt][0]; bwA[1] = pkA[2 * tt][1]; bwA[2] = pkA[2 * tt + 1][0]; bwA[3] = pkA[2 * tt + 1][1];
                bwB[0] = pkB[2 * tt][0]; bwB[1] = pkB[2 * tt][1]; bwB[2] = pkB[2 * tt + 1][0]; bwB[3] = pkB[2 * tt + 1][1];
                const bf16x8 bfA = __builtin_bit_cast(bf16x8, bwA), bfB = __builtin_bit_cast(bf16x8, bwB);
#pragma unroll
                for (int nd = 0; nd < 4; ++nd) { const LAS bf16_t* vp = sVt + (nd * 16 + fr) * 264 + kq * 64 + 32 * tt + 4 * fq;
                    const u32x2 lo = *(const LAS u32x2*)vp, hi = *(const LAS u32x2*)(vp + 16);
                    u32x4 aw; aw[0] = lo[0]; aw[1] = lo[1]; aw[2] = hi[0]; aw[3] = hi[1];
                    const bf16x8 vf = __builtin_bit_cast(bf16x8, aw);
                    oA[nd] = mfma16(vf, bfA, oA[nd]); oB[nd] = mfma16(vf, bfB, oB[nd]); } }
        }
        lsA += __shfl_xor(lsA, 16); lsA += __shfl_xor(lsA, 32); lsB += __shfl_xor(lsB, 16); lsB += __shfl_xor(lsB, 32);
        const float sinkv = p.sinks[l * 8 + hq]; const float es = __expf(sinkv - fmaxf(Mb, sinkv));
        const float invA = 1.0f / (lsA + es), invB = 1.0f / (lsB + es);
        bf16_t* opA = z + (rq0 + q0 + fr) * DIN + C_QA + hq * 64 + 4 * fq; bf16_t* opB = opA + (size_t)16 * DIN;
#pragma unroll
        for (int nd = 0; nd < 4; ++nd) { u32x2 pa2, pb2; pa2[0] = cvt_pk_bf16(oA[nd][0] * invA, oA[nd][1] * invA); pa2[1] = cvt_pk_bf16(oA[nd][2] * invA, oA[nd][3] * invA);
            pb2[0] = cvt_pk_bf16(oB[nd][0] * invB, oB[nd][1] * invB); pb2[1] = cvt_pk_bf16(oB[nd][2] * invB, oB[nd][3] * invB);
            *(u32x2*)(opA + nd * 16) = pa2; *(u32x2*)(opB + nd * 16) = pb2; }
    }
    __syncthreads();
}

constexpr int N_MSUB = 52;
__device__ const unsigned short MOBA_SUB[N_MSUB] = {269, 270, 271, 517, 549, 272, 518, 550, 770, 802, 834, 273, 519, 551, 1024, 1056, 1088, 1120, 274, 771, 803, 835, 520, 552, 275, 1025, 1057, 1089, 1121, 521, 553, 276, 772, 804, 836, 522, 554, 277, 523, 555, 278, 524, 556, 279, 280, 281, 282, 283, 284, 285, 286, 287};
__device__ __forceinline__ void moba_gate_item(const P& p, LAS unsigned char* lds, const bf16_t* z, int bl, int h, int n) {
    LAS float* sKm = (LAS float*)lds;
    LAS int* sCnt = (LAS int*)(lds + 8192);
    int* CNT = (int*)(p.ws + WS_MCNT) + (bl * 8 + h) * 32;
    unsigned* LIST = (unsigned*)(p.ws + WS_MLIST) + (size_t)(bl * 8 + h) * 32 * LCAP;
    const float* kmean = (const float*)(p.ws + WS_KMEAN) + (size_t)(bl * 8 + h) * 32 * 64;
    const int tid = opaque_tid();
    if (tid < 64) sCnt[tid] = 0;
    for (int i = tid; i < n * 64; i += NTHREADS) sKm[i] = kmean[i];
    __syncthreads();
    int s0 = -1, s1 = -1, s2 = -1, p0 = 0, p1 = 0, p2 = 0;
    if (tid < 256) {
        float qv[64];
        const bf16_t* qp = z + ((size_t)bl * SEQ + (size_t)n * 256 + tid) * DIN + C_QC + h * 64;
#pragma unroll
        for (int c = 0; c < 8; ++c) { const u32x4 raw = *(const u32x4*)(qp + c * 8); unpack8(raw, qv + c * 8); }
        float v0 = -3.0e38f, v1 = -3.0e38f, v2 = -3.0e38f;
        for (int m = 0; m < n; ++m) { float g = 0.f;
#pragma unroll
            for (int d = 0; d < 64; ++d) g += qv[d] * sKm[m * 64 + d];
            if (g > v0) { v2 = v1; s2 = s1; v1 = v0; s1 = s0; v0 = g; s0 = m; }
            else if (g > v1) { v2 = v1; s2 = s1; v1 = g; s1 = m; }
            else if (g > v2) { v2 = g; s2 = m; } }
        if (s0 >= 0) p0 = atomicAdd((int*)(sCnt + s0), 1);
        if (s1 >= 0) p1 = atomicAdd((int*)(sCnt + s1), 1);
        if (s2 >= 0) p2 = atomicAdd((int*)(sCnt + s2), 1);
    }
    __syncthreads();
    if (tid < n) { const int c = sCnt[tid]; sCnt[32 + tid] = (c > 0) ? atomicAdd(CNT + tid, c) : 0; }
    __syncthreads();
    if (tid < 256) { const unsigned qpos = (unsigned)(n * 256 + tid);
        if (s0 >= 0) LIST[(size_t)s0 * LCAP + sCnt[32 + s0] + p0] = qpos;
        if (s1 >= 0) LIST[(size_t)s1 * LCAP + sCnt[32 + s1] + p1] = qpos | (1u << 16);
        if (s2 >= 0) LIST[(size_t)s2 * LCAP + sCnt[32 + s2] + p2] = qpos | (2u << 16); }
    __syncthreads();
}

template <bool OWN>
__device__ __forceinline__ void moba_tile(unsigned ecA, unsigned ecB, bool vA, bool vB, bf16x8 qA0, bf16x8 qA1, bf16x8 qB0, bf16x8 qB1, int kqn, int m, int bl, int h, float cb,
                                          const LAS bf16_t* sK, const LAS bf16_t* sVt, const LAS float* sB2, bf16_t* PART, float* LSUM, int fr, int fq) {
    const int qposA = (int)(ecA & 0xffffu), slotA = (int)(ecA >> 16), qposB = (int)(ecB & 0xffffu), slotB = (int)(ecB >> 16);
    const int dqfA = qposA - m * 256 - 4 * fq, dqfB = qposB - m * 256 - 4 * fq;
    const bool farb = !OWN && (__all(dqfA + 4 * fq - 255 >= 1513 && dqfB + 4 * fq - 255 >= 1513) != 0);
    const LAS float* pbA = sB2 + (272 + dqfA - 255); const LAS float* pbB = sB2 + (272 + dqfB - 255);
    float lsA = 0.f, lsB = 0.f;
    f32x4 oA[4], oB[4];
#pragma unroll
    for (int nd = 0; nd < 4; ++nd) { oA[nd] = (f32x4){0.f, 0.f, 0.f, 0.f}; oB[nd] = (f32x4){0.f, 0.f, 0.f, 0.f}; }
    for (int kq = 0; kq < kqn; ++kq) {
        unsigned pkA[4][2], pkB[4][2];
        const LAS float* pa = pbA - kq * 64; const LAS float* pb = pbB - kq * 64;
#pragma unroll
        for (int nt = 0; nt < 4; ++nt) {
            const LAS bf16_t* kp = sK + (kq * 64 + nt * 16 + fr) * 72 + fq * 8;
            const bf16x8 k0 = *(const LAS bf16x8*)kp, k1 = *(const LAS bf16x8*)(kp + 32);
            f32x4 aA = (f32x4){0.f, 0.f, 0.f, 0.f}, aB = (f32x4){0.f, 0.f, 0.f, 0.f};
            aA = mfma16(k0, qA0, aA); aB = mfma16(k0, qB0, aB); aA = mfma16(k1, qA1, aA); aB = mfma16(k1, qB1, aB);
            float pjA[4], pjB[4];
#pragma unroll
            for (int j = 0; j < 4; ++j) {
                const float b2A = farb ? cb : pa[255 - nt * 16 - j], b2B = farb ? cb : pb[255 - nt * 16 - j];
                float pvA = __builtin_amdgcn_exp2f(aA[j] * 0.18033688011112042f + b2A), pvB = __builtin_amdgcn_exp2f(aB[j] * 0.18033688011112042f + b2B);
                if (OWN) { if (dqfA - (kq * 64 + nt * 16 + j) < 0) pvA = 0.f; if (dqfB - (kq * 64 + nt * 16 + j) < 0) pvB = 0.f; }
                lsA += pvA; lsB += pvB; pjA[j] = pvA; pjB[j] = pvB; }
            pkA[nt][0] = cvt_pk_bf16(pjA[0], pjA[1]); pkA[nt][1] = cvt_pk_bf16(pjA[2], pjA[3]);
            pkB[nt][0] = cvt_pk_bf16(pjB[0], pjB[1]); pkB[nt][1] = cvt_pk_bf16(pjB[2], pjB[3]); }
#pragma unroll
        for (int tt = 0; tt < 2; ++tt) {
            u32x4 bwA, bwB; bwA[0] = pkA[2 * tt][0]; bwA[1] = pkA[2 * tt][1]; bwA[2] = pkA[2 * tt + 1][0]; bwA[3] = pkA[2 * tt + 1][1];
            bwB[0] = pkB[2 * tt][0]; bwB[1] = pkB[2 * tt][1]; bwB[2] = pkB[2 * tt + 1][0]; bwB[3] = pkB[2 * tt + 1][1];
            const bf16x8 bfA = __builtin_bit_cast(bf16x8, bwA), bfB = __builtin_bit_cast(bf16x8, bwB);
#pragma unroll
            for (int nd = 0; nd < 4; ++nd) { const LAS bf16_t* vp = sVt + (nd * 16 + fr) * 264 + kq * 64 + 32 * tt + 4 * fq;
                const u32x2 lo = *(const LAS u32x2*)vp, hi = *(const LAS u32x2*)(vp + 16);
                u32x4 aw; aw[0] = lo[0]; aw[1] = lo[1]; aw[2] = hi[0]; aw[3] = hi[1];
                const bf16x8 vf = __builtin_bit_cast(bf16x8, aw);
                oA[nd] = mfma16(vf, bfA, oA[nd]); oB[nd] = mfma16(vf, bfB, oB[nd]); } }
    }
    lsA += __shfl_xor(lsA, 16); lsA += __shfl_xor(lsA, 32); lsB += __shfl_xor(lsB, 16); lsB += __shfl_xor(lsB, 32);
    if (vA) { const size_t pi = (((size_t)bl * SEQ + qposA) * 8 + h) * 4 + slotA;
        if (fq == 0) LSUM[pi] = lsA;
#pragma unroll
        for (int nd = 0; nd < 4; ++nd) { u32x2 pk2; pk2[0] = cvt_pk_bf16(oA[nd][0], oA[nd][1]); pk2[1] = cvt_pk_bf16(oA[nd][2], oA[nd][3]);
            *(u32x2*)(PART + pi * 64 + nd * 16 + 4 * fq) = pk2; } }
    if (vB) { const size_t pi = (((size_t)bl * SEQ + qposB) * 8 + h) * 4 + slotB;
        if (fq == 0) LSUM[pi] = lsB;
#pragma unroll
        for (int nd = 0; nd < 4; ++nd) { u32x2 pk2; pk2[0] = cvt_pk_bf16(oB[nd][0], oB[nd][1]); pk2[1] = cvt_pk_bf16(oB[nd][2], oB[nd][3]);
            *(u32x2*)(PART + pi * 64 + nd * 16 + 4 * fq) = pk2; } }
}
__device__ __forceinline__ void moba_attn_item(const P& p, LAS unsigned char* lds, const bf16_t* z, int bl, int h, int m, int part, int parts, float M) {
    LAS bf16_t* sK = (LAS bf16_t*)lds;
    LAS bf16_t* sVt = sK + 256 * 72;
    LAS float* sB2 = (LAS float*)(lds + 70656);
    const int tid = opaque_tid(), wid = tid >> 6, lane = tid & 63, fr = lane & 15, fq = lane >> 4;
    const bf16_t* Vtg = (const bf16_t*)(p.ws + WS_VTC) + (size_t)(bl * 8 + h) * 64 * SEQ;
    const float* biasC = (const float*)(p.ws + WS_BIASC) + h * 8192;
    const unsigned* LIST = (const unsigned*)(p.ws + WS_MLIST) + ((size_t)(bl * 8 + h) * 32 + m) * LCAP;
    bf16_t* PART = (bf16_t*)(p.ws + WS_MPART); float* LSUM = (float*)(p.ws + WS_MLSUM);
    const int cnt = ((const int*)(p.ws + WS_MCNT))[(bl * 8 + h) * 32 + m];
    const int ntl = (cnt + 31) >> 5, ntot = ntl + 8;
    const int tlo = (part * ntot) / parts, thi = ((part + 1) * ntot) / parts;
#define MOBA_ENTRY1(ix_, e, v) do { v = (ix_) < cnt; e = LIST[(ix_) < cnt ? (ix_) : (cnt > 0 ? cnt - 1 : 0)]; } while (0)
#define MOBA_ENTRY(t, ea, va, eb, vb) do { if ((t) < ntl) { MOBA_ENTRY1((t) * 32 + fr, ea, va); MOBA_ENTRY1((t) * 32 + 16 + fr, eb, vb); } \
        else { va = vb = (t) < thi; ea = (unsigned)(m * 256 + (((t) - ntl) & 7) * 32 + fr) | (3u << 16); eb = ea + 16u; } } while (0)
#define MOBA_QGATHER(e, a0, a1) do { const bf16_t* qp_ = z + ((size_t)bl * SEQ + ((e) & 0xffffu)) * DIN + C_QC + h * 64 + fq * 8; a0 = *(const bf16x8*)qp_; a1 = *(const bf16x8*)(qp_ + 32); } while (0)
#define MOBA_KQN(t) ((((((t) - ntl) & 7) * 32 + 31) >> 6) + 1)
    int t = tlo + wid;
    unsigned e0a = 0u, e0b = 0u, e1a = 0u, e1b = 0u, e2a = 0u, e2b = 0u; bool v0a = false, v0b = false, v1a = false, v1b = false, v2a = false, v2b = false;
    bf16x8 qa0, qa1, qa2, qa3, qb0, qb1, qb2, qb3, qc0, qc1, qc2, qc3;
    MOBA_ENTRY(t, e0a, v0a, e0b, v0b); MOBA_ENTRY(t + 8, e1a, v1a, e1b, v1b); MOBA_ENTRY(t + 16, e2a, v2a, e2b, v2b);
    MOBA_QGATHER(e0a, qa0, qa1); MOBA_QGATHER(e0b, qa2, qa3); MOBA_QGATHER(e1a, qb0, qb1); MOBA_QGATHER(e1b, qb2, qb3);
    qc0 = qa0; qc1 = qa1; qc2 = qa2; qc3 = qa3;
#pragma unroll
    for (int k = 0; k < 4; ++k) { const int i = tid + k * NTHREADS;
        const u32x4 kv = *(const u32x4*)(z + ((size_t)bl * SEQ + (size_t)m * 256 + (i >> 3)) * DIN + C_KC + h * 64 + (i & 7) * 8);
        const u32x4 vv = *(const u32x4*)(Vtg + (size_t)(i >> 5) * SEQ + m * 256 + (i & 31) * 8);
        *(LAS u32x4*)(sK + (i >> 3) * 72 + (i & 7) * 8) = kv; *(LAS u32x4*)(sVt + (i >> 5) * 264 + (i & 31) * 8) = vv;
    }
    for (int i = tid; i < 8192 + 272; i += NTHREADS) { const int dist = i - 272; sB2[i] = (biasC[dist < 0 ? 0 : dist] - M) * 1.4426950408889634f; }
    __syncthreads();
    const float cb = sB2[272 + 8191];
#define MOBA_RUN(ea, eb, va, vb, q0, q1, q2, q3) do { if (t >= ntl) moba_tile<true>(ea, eb, (va) && t < thi, (vb) && t < thi, q0, q1, q2, q3, MOBA_KQN(t), m, bl, h, cb, sK, sVt, sB2, PART, LSUM, fr, fq); \
        else moba_tile<false>(ea, eb, (va) && t < thi, (vb) && t < thi, q0, q1, q2, q3, 4, m, bl, h, cb, sK, sVt, sB2, PART, LSUM, fr, fq); } while (0)
    for (;;) {
        if (t >= thi) break;
        { const unsigned ca = e0a, cbb = e0b; const bool wa = v0a, wb = v0b; MOBA_QGATHER(e2a, qc0, qc1); MOBA_QGATHER(e2b, qc2, qc3); MOBA_ENTRY(t + 24, e0a, v0a, e0b, v0b);
          MOBA_RUN(ca, cbb, wa, wb, qa0, qa1, qa2, qa3); t += 8; }
        if (t >= thi) break;
        { const unsigned ca = e1a, cbb = e1b; const bool wa = v1a, wb = v1b; MOBA_QGATHER(e0a, qa0, qa1); MOBA_QGATHER(e0b, qa2, qa3); MOBA_ENTRY(t + 24, e1a, v1a, e1b, v1b);
          MOBA_RUN(ca, cbb, wa, wb, qb0, qb1, qb2, qb3); t += 8; }
        if (t >= thi) break;
        { const unsigned ca = e2a, cbb = e2b; const bool wa = v2a, wb = v2b; MOBA_QGATHER(e1a, qb0, qb1); MOBA_QGATHER(e1b, qb2, qb3); MOBA_ENTRY(t + 24, e2a, v2a, e2b, v2b);
          MOBA_RUN(ca, cbb, wa, wb, qc0, qc1, qc2, qc3); t += 8; }
    }
#undef MOBA_ENTRY1
#undef MOBA_ENTRY
#undef MOBA_QGATHER
#undef MOBA_KQN
#undef MOBA_RUN
    __syncthreads();
}

__device__ __forceinline__ void phase_moba_combine(const P& p, bf16_t* z) {
    const bf16_t* PART = (const bf16_t*)(p.ws + WS_MPART); const float* LSUM = (const float*)(p.ws + WS_MLSUM);
    const int tid = opaque_tid(), wid = tid >> 6, lane = tid & 63, h = lane >> 3, d8 = (lane & 7) * 8;
    for (int r0 = (blockIdx.x * 8 + wid) * 2; r0 < TC; r0 += gridDim.x * 8 * 2) {
#pragma unroll
        for (int q = 0; q < 2; ++q) { const int r = r0 + q; const int n = (r % SEQ) >> 8; const int nsel = n < 3 ? n : 3;
            const size_t pi = ((size_t)r * 8 + h) * 4;
            float acc[8], lt = LSUM[pi + 3];
            unpack8(*(const u32x4*)(PART + (pi + 3) * 64 + d8), acc);
#pragma unroll
            for (int k = 0; k < 3; ++k) if (k < nsel) { float f[8]; unpack8(*(const u32x4*)(PART + (pi + k) * 64 + d8), f); lt += LSUM[pi + k];
#pragma unroll
                for (int j = 0; j < 8; ++j) acc[j] += f[j]; }
            const float inv = 1.0f / lt; u32x4 pk;
#pragma unroll
            for (int j = 0; j < 4; ++j) pk[j] = cvt_pk_bf16(acc[2 * j] * inv, acc[2 * j + 1] * inv);
            *(u32x4*)(z + (size_t)r * DIN + C_QC + h * 64 + d8) = pk; }
    }
}

__device__ __forceinline__ void phase_act(const P& p, int l, const bf16_t* u, bf16_t* act) {
    const int tid = opaque_tid();
    if (tid >= DFF / 8) return;
    const int c0 = tid * 8;
    float wg[3][8], wv[3][8], bg[8], bv[8];
#pragma unroll
    for (int k = 0; k < 3; ++k)
#pragma unroll
        for (int j = 0; j < 8; ++j) { wg[k][j] = p.ffn_conv_w[(size_t)(l * 3 + k) * DFF2 + c0 + j]; wv[k][j] = p.ffn_conv_w[(size_t)(l * 3 + k) * DFF2 + DFF + c0 + j]; }
#pragma unroll
    for (int j = 0; j < 8; ++j) { bg[j] = p.ffn_conv_b[(size_t)l * DFF2 + c0 + j]; bv[j] = p.ffn_conv_b[(size_t)l * DFF2 + DFF + c0 + j]; }
    for (int item = blockIdx.x; item < TC / 64; item += gridDim.x) {
        const int r0 = item * 64;
        float g1[8], g2[8], v1[8], v2[8];
        if ((r0 % SEQ) == 0) {
#pragma unroll
            for (int j = 0; j < 8; ++j) { g1[j] = 0.f; g2[j] = 0.f; v1[j] = 0.f; v2[j] = 0.f; }
        } else {
            unpack8(*(const u32x4*)(u + (size_t)(r0 - 1) * DFF2 + c0), g1); unpack8(*(const u32x4*)(u + (size_t)(r0 - 2) * DFF2 + c0), g2);
            unpack8(*(const u32x4*)(u + (size_t)(r0 - 1) * DFF2 + DFF + c0), v1); unpack8(*(const u32x4*)(u + (size_t)(r0 - 2) * DFF2 + DFF + c0), v2);
        }
        for (int i0 = 0; i0 < 64; i0 += 8) {
            u32x4 rg[8], rv[8];
#pragma unroll
            for (int i = 0; i < 8; ++i) { const size_t r = (size_t)(r0 + i0 + i); rg[i] = *(const u32x4*)(u + r * DFF2 + c0); rv[i] = *(const u32x4*)(u + r * DFF2 + DFF + c0); }
#pragma unroll
            for (int i = 0; i < 8; ++i) { const size_t r = (size_t)(r0 + i0 + i);
                float g0[8], v0[8]; unpack8(rg[i], g0); unpack8(rv[i], v0);
                float o[8];
#pragma unroll
                for (int j = 0; j < 8; ++j) { const float cgv = bg[j] + wg[0][j] * g2[j] + wg[1][j] * g1[j] + wg[2][j] * g0[j]; const float cvv = bv[j] + wv[0][j] * v2[j] + wv[1][j] * v1[j] + wv[2][j] * v0[j];
                    o[j] = (cgv * __builtin_amdgcn_rcpf(1.0f + __expf(-cgv))) * cvv; g2[j] = g1[j]; g1[j] = g0[j]; v2[j] = v1[j]; v1[j] = v0[j]; }
                u32x4 pk;
#pragma unroll
                for (int j = 0; j < 4; ++j) pk[j] = pack2(o[2 * j], o[2 * j + 1]);
                *(u32x4*)(act + r * DFF + c0) = pk; }
        }
    }
}

#ifndef PHASE_MASK
#define PHASE_MASK 0xFFFFF
#endif
#define PH(k) ((PHASE_MASK >> (k)) & 1)
#ifndef REP_GRP
#define REP_GRP 0
#endif
#ifndef REP_P2
#define REP_P2 0
#endif
#ifndef REP_P8
#define REP_P8 0
#endif
#ifndef REP_MISC
#define REP_MISC 0
#endif
#ifndef DRY_MOBA
#define DRY_MOBA 0
#endif
#ifndef DRY_SWA
#define DRY_SWA 0
#endif
#ifndef DRY_RNN
#define DRY_RNN 0
#endif

#define XB_TMO      128
#define XB_XCNT(j)  (256  + 64 * (j))
#define XB_XSUB(j)  (1280 + 64 * (j))
#define XB_XGEN(j)  (2304 + 64 * (j))
#define XB_TOP      3328
#define XB_TOPGEN   3392
#define XCD_BAR_WORDS 3456
#define XB_SPIN_CAP (1u << 18)
__device__ __forceinline__ unsigned xb_ld(unsigned* p)              { return __hip_atomic_load(p, __ATOMIC_RELAXED, __HIP_MEMORY_SCOPE_AGENT); }
__device__ __forceinline__ unsigned xb_add(unsigned* p, unsigned v) { return __hip_atomic_fetch_add(p, v, __ATOMIC_RELAXED, __HIP_MEMORY_SCOPE_AGENT); }
__device__ __forceinline__ unsigned xb_xcc_id() { return (unsigned)__builtin_amdgcn_s_getreg((3 << 11) | 20) & 0xFu; }
#define XB_SPIN(cond, bar) do { unsigned _sp = 0; while (cond) { __builtin_amdgcn_s_sleep(1); \
    if ((++_sp & 255u) == 0u) { if (xb_ld(&(bar)[XB_TMO])) break; if (_sp > XB_SPIN_CAP) { atomicAdd(&(bar)[XB_TMO], 1u); break; } } } } while (0)
struct XcdBarrier { unsigned* bar; unsigned x; volatile LAS unsigned* st; };
__device__ __forceinline__ XcdBarrier xcd_barrier_post(unsigned* bar, volatile LAS unsigned* st) {
    XcdBarrier b; b.bar = bar; b.x = xb_xcc_id(); b.st = st;
    if (threadIdx.x == 0) (void)xb_add(&bar[XB_XCNT(b.x)], 1u);
    return b;
}
__device__ __forceinline__ void xcd_barrier_complete(unsigned* bar, unsigned x, unsigned& nloc, unsigned& nx) {
    const unsigned G = gridDim.x * gridDim.y * gridDim.z;
    unsigned sum, cnt, mine, sp = 0u;
    for (;;) {
        sum = 0u; cnt = 0u; mine = 0u;
#pragma unroll
        for (unsigned j = 0; j < 16; ++j) { const unsigned c = xb_ld(&bar[XB_XCNT(j)]); sum += c; cnt += (c > 0u) ? 1u : 0u; mine = (j == x) ? c : mine; }
        if (sum == G) break;
        __builtin_amdgcn_s_sleep(1);
        if ((++sp & 255u) == 0u) { if (xb_ld(&bar[XB_TMO])) break; if (sp > XB_SPIN_CAP) { atomicAdd(&bar[XB_TMO], 1u); break; } }
    }
    nloc = mine > 0u ? mine : 1u; nx = cnt > 0u ? cnt : 1u;
}
__device__ __forceinline__ void xcd_barrier(const XcdBarrier& b) {
    asm volatile("s_waitcnt vmcnt(0)" ::: "memory");
    __syncthreads();
    if (opaque_tid() == 0) {
        unsigned* bar = b.bar;
        __builtin_amdgcn_s_waitcnt(0);
        unsigned nloc = b.st[0], nx = b.st[1];
        if (nloc == 0u) { xcd_barrier_complete(bar, b.x, nloc, nx); b.st[0] = nloc; b.st[1] = nx; }
        const unsigned old = xb_add(&bar[XB_XSUB(b.x)], 1u);
        const unsigned gen = old / nloc;
        if (old + 1u == (gen + 1u) * nloc) {
            __builtin_amdgcn_fence(__ATOMIC_RELEASE, "agent");
            asm volatile("s_waitcnt vmcnt(0)" ::: "memory");
            const unsigned og = xb_add(&bar[XB_TOP], 1u);
            const unsigned tg = og / nx;
            if (og + 1u == (tg + 1u) * nx) xb_add(&bar[XB_TOPGEN], 1u);
            else XB_SPIN(xb_ld(&bar[XB_TOPGEN]) == tg, bar);
            __builtin_amdgcn_fence(__ATOMIC_ACQUIRE, "agent");
            xb_add(&bar[XB_XGEN(b.x)], 1u);
            asm volatile("s_waitcnt vmcnt(0)" ::: "memory");
        } else {
            XB_SPIN(xb_ld(&bar[XB_XGEN(b.x)]) == gen, bar);
            __builtin_amdgcn_fence(__ATOMIC_ACQUIRE, "agent");
            asm volatile("s_waitcnt vmcnt(0)" ::: "memory");
        }
    }
    __syncthreads();
}
#ifndef REP_SYNC
#define REP_SYNC 0
#endif
#define GSYNC() do { for (int _r = 0; _r < 1 + REP_SYNC; ++_r) xcd_barrier(xbar); } while (0)
__global__ void __launch_bounds__(NTHREADS, 2) fwd_megakernel(P p_arg) {
    extern __shared__ __attribute__((aligned(16))) unsigned char lds_raw[];
    LAS unsigned char* lds = (LAS unsigned char*)lds_raw;
    cg::grid_group grid = cg::this_grid();
    const int G = gridDim.x, bx = blockIdx.x;
#define RELOAD const P p = load_params(); const float* mod_l = (const float*)(p.ws + WS_MOD) + (size_t)l * NB * 6144; bf16_t* Hb = (bf16_t*)(p.ws + WS_H); bf16_t* Zb = (bf16_t*)(p.ws + WS_Z); bf16_t* ACTb = (bf16_t*)(p.ws + WS_ACT); \
    const float* xin = ((l == 0) ? p.x : p.out) + (size_t)ch * TC * DM; float* xout = p.out + (size_t)ch * TC * DM; (void)mod_l; (void)Hb; (void)Zb; (void)ACTb; (void)xin; (void)xout;

    { LAS unsigned* st = (LAS unsigned*)(lds + LDS_BYTES - 16); if (threadIdx.x == 0) { st[0] = 0u; st[1] = 0u; } __syncthreads(); }
    const XcdBarrier xbar = xcd_barrier_post((unsigned*)(p_arg.ws + WS_BAR), (volatile LAS unsigned*)(lds + LDS_BYTES - 16));
    if (PH(0)) { const P p = load_params(); phase0(p, lds); }
    grid.sync();

    for (int l = 0; l < DEPTH; ++l) {
        for (int ch = 0; ch < NCHUNK; ++ch) {
            const int b0 = ch * BPC;
            for (int rep3 = 0; rep3 < 1 + REP_MISC; ++rep3) { RELOAD
            if (PH(1)) if (ch == 0) phase_convert(p, l, lds);
            if (PH(2)) phase_norm(xin, p.norm_mix + l * DM, mod_l, 0, 1024, b0, Hb, p.ws + WS_H8); }
            GSYNC();
            for (int rep = 0; rep < 1 + REP_GRP; ++rep) {
            for (int rep2 = 0; rep2 < 1 + REP_P2; ++rep2) {
            if (PH(3)) { RELOAD
              { pg8::SchedPlain S{(const char*)Hb, (const char*)(p.ws + WS_WIN), DM * 2, DM * 2, DM / 64, TC / 256, C_G / 256, G, bx};
                pg8::EpiStoreBf16 E{Zb, DIN, 1 << 30, 1.0f};
                pg8::gemm_phase(lds, S, E); }
              {
                pg8::SchedPlain S{(const char*)(p.ws + WS_H8), (const char*)(p.ws + WS_WG8), DM, DM, DM / 128, TC / 256, (DIN - C_G) / 256, G, bx};
                pg8::EpiStoreBf16 E{Zb + C_G, DIN, 0, 1.0f / 64.0f};
                pg8::gemm_phase<pg8::SchedPlain, pg8::EpiStoreBf16, true>(lds, S, E); } }
            GSYNC();
            }
            { RELOAD
            if (PH(4)) phase_qknorm(p, l, Zb);
            if (PH(5)) phase_kcnorm(p, l, Zb, lds);
            if (bx == 0) { const int t_ = opaque_tid(); if (t_ < BPC * 8 * 32) ((int*)(p.ws + WS_MCNT))[t_] = 0; if (t_ == 0) *((int*)(p.ws + WS_MQ)) = 0; }
            if (PH(6)) phase_rnn0(p, l, lds, Zb); }
            GSYNC();
            { RELOAD
              for (int it = bx; it < BPC * 8 * 31; it += G) { const int n = 31 - it / (BPC * 8), h = it & 7, bl = (it >> 3) & 1; moba_gate_item(p, lds, Zb, bl, h, n); } }
            GSYNC();
            { RELOAD constexpr int N_MOBA = BPC * 8 * 32, N_SWA = BPC * 8 * 64, N_RNN = BPC * 16 * 64;
              float biasmax = 0.f, ga = 0.f, gc = 0.f;
              for (int i = 0; i < 32 * 16; ++i) biasmax = fmaxf(biasmax, fabsf(p.rel_bias[i]));
              for (int d = 0; d < 64; ++d) { ga = fmaxf(ga, fabsf(p.qnorm_a[l * 64 + d] * p.knorm_a[l * 64 + d])); gc = fmaxf(gc, fabsf(p.qnorm_c[l * 64 + d] * p.knorm_c[l * 64 + d])); }
              const float Mb_a = 8.0f * 1.03f * ga + biasmax, Mb_c = 8.0f * 1.03f * gc + biasmax;
              for (int j = bx; j < BPC * 2 * 64; j += G) { if (PH(8)) { const int qb = j & 63, kvh = (j >> 6) & 1, bl = j >> 7; swa_item(p, l, lds, Zb, bl, kvh, qb, Mb_a); } }
              if (PH(9)) phase_rnn_apply(p, lds, Zb);
              if (PH(7)) {
                  int* qhead = (int*)(p.ws + WS_MQ); LAS int* sQ = (LAS int*)(lds + LDS_BYTES - 32);
                  for (;;) {
                      if (opaque_tid() == 0) *sQ = __hip_atomic_fetch_add(qhead, 1, __ATOMIC_RELAXED, __HIP_MEMORY_SCOPE_AGENT);
                      __syncthreads();
                      const int i = *sQ;
                      __syncthreads();
                      if (i >= N_MSUB * BPC * 8) break;
                      const unsigned sv = MOBA_SUB[i >> 4]; const int h = i & 7, bl = (i >> 3) & 1;
                      moba_attn_item(p, lds, Zb, bl, h, (int)(sv & 31u), (int)((sv >> 5) & 7u), (int)(sv >> 8), Mb_c); } } }
            GSYNC();
            { RELOAD phase_moba_combine(p, Zb); }
            GSYNC();
            }
            if (PH(10)) { RELOAD pg8::SchedMerge S{(const char*)Zb, (const char*)(p.ws + WS_WB), DIN * 2, 2048 * 2, TC / 256, DM / 256, G, bx};
              pg8::EpiMerge E{Zb, Hb};
              pg8::gemm_phase(lds, S, E); }
            GSYNC();
            if (PH(11)) { RELOAD pg8::SchedPlain S{(const char*)Hb, (const char*)(p.ws + WS_WOUT), DM * 2, DM * 2, DM / 64, TC / 256, DM / 256, G, bx};
              pg8::EpiResid E{xin, xout, mod_l + 2048, b0};
              pg8::gemm_phase(lds, S, E); }
            GSYNC();
            for (int rep3 = 0; rep3 < 1 + REP_MISC; ++rep3) if (PH(12)) { RELOAD phase_norm(xout, p.norm_ffn + l * DM, mod_l, 3072, 4096, b0, Hb, nullptr); }
            GSYNC();
            for (int rep2 = 0; rep2 < 1 + REP_P8; ++rep2) {
            if (PH(13)) { RELOAD pg8::SchedPlain S{(const char*)Hb, (const char*)(p.ws + WS_WUP), DM * 2, DM * 2, DM / 64, TC / 256, DFF2 / 256, G, bx};
              pg8::EpiStoreBf16 E{Zb, DFF2, 1 << 30, 1.0f};
              pg8::gemm_phase(lds, S, E); }
            GSYNC();
            }
            for (int rep3 = 0; rep3 < 1 + REP_MISC; ++rep3) if (PH(14)) { RELOAD phase_act(p, l, Zb, ACTb); }
            GSYNC();
            if (PH(15)) { RELOAD pg8::SchedPlain S{(const char*)ACTb, (const char*)(p.ws + WS_WDOWN), DFF * 2, DFF * 2, DFF / 64, TC / 256, DM / 256, G, bx};
              pg8::EpiResid E{xout, xout, mod_l + 5120, b0};
              pg8::gemm_phase(lds, S, E); }
            GSYNC();
        }
    }
}

extern "C" void kernel_launch(void* const* d_in, const int* in_sizes, int n_in, void* d_out, int out_size, void* d_ws, size_t ws_size, hipStream_t stream) {
    static int grid = 0;
    if (grid == 0) {
        if (n_in != 26 || ws_size < WS_END) { fprintf(stderr, "kernel_launch: need 26 inputs and >= %zu bytes of workspace (got %d, %zu)\n", (size_t)WS_END, n_in, ws_size); grid = -1; return; }
        int dev = 0, cus = 0, per_cu = 0;
        (void)hipGetDevice(&dev);
        (void)hipDeviceGetAttribute(&cus, hipDeviceAttributeMultiprocessorCount, dev);
        if (hipFuncSetAttribute((const void*)fwd_megakernel, hipFuncAttributeMaxDynamicSharedMemorySize, LDS_BYTES) != hipSuccess) { fprintf(stderr, "kernel_launch: hipFuncSetAttribute failed\n"); grid = -1; return; }
        if (hipOccupancyMaxActiveBlocksPerMultiprocessor(&per_cu, (const void*)fwd_megakernel, NTHREADS, LDS_BYTES) != hipSuccess || per_cu < 1) { fprintf(stderr, "kernel_launch: occupancy query gives %d\n", per_cu); per_cu = 1; (void)hipGetLastError(); }
        grid = cus * per_cu;
        fprintf(stderr, "kernel_launch: grid %d (cus %d x %d)\n", grid, cus, per_cu);
    }
    if (grid < 0) return;
    P prm{};
    const float** pp = (const float**)&prm;
    for (int i = 0; i < 26; ++i) pp[i] = (const float*)d_in[i];
    prm.out = (float*)d_out; prm.ws = (unsigned char*)d_ws;
    if (hipMemsetAsync((char*)d_ws + WS_BAR, 0, 3456 * 4, stream) != hipSuccess) { fprintf(stderr, "kernel_launch: memset of barrier words failed\n"); return; }
    void* args[] = {&prm};
    hipError_t e = hipLaunchCooperativeKernel((const void*)fwd_megakernel, dim3(grid), dim3(NTHREADS), args, LDS_BYTES, stream);
    if (e != hipSuccess) fprintf(stderr, "kernel_launch: cooperative launch failed: %s (grid %d)\n", hipGetErrorString(e), grid);
}
```

```cpp
#include <hip/hip_runtime.h>
#include <hip/hip_cooperative_groups.h>
#include <cstdio>
#include <cstdint>
namespace cg = cooperative_groups;

#define LAS __attribute__((address_space(3)))
typedef unsigned short bf16_t;
typedef short bf16x8 __attribute__((ext_vector_type(8)));
typedef float f32x4 __attribute__((ext_vector_type(4)));
typedef unsigned u32x4 __attribute__((ext_vector_type(4)));
typedef unsigned u32x2 __attribute__((ext_vector_type(2)));
typedef int i32x8 __attribute__((ext_vector_type(8)));
typedef unsigned u32x8 __attribute__((ext_vector_type(8)));

constexpr int NB = 4, SEQ = 8192, DM = 1024, NTOK = NB * SEQ, DEPTH = 4;
constexpr int DIN = 7424, DFF = 2816, DFF2 = 5632;
constexpr int C_QA = 0, C_KA = 512, C_VA = 640, C_XR = 768, C_YR = 1792, C_QC = 2816, C_KC = 3328, C_VC = 3840, C_G = 4352;
constexpr int NCHUNK = 2, TC = NTOK / NCHUNK, BPC = NB / NCHUNK;
constexpr int NTHREADS = 512;
constexpr int LDS_BYTES = 160 * 1024;
constexpr float RMS_EPS = 1e-6f;

constexpr size_t alup(size_t x) { return (x + 255) & ~(size_t)255; }
constexpr size_t WS_MOD = 0;
constexpr size_t WS_BIASA = alup(WS_MOD + (size_t)DEPTH * NB * 6144 * 4);
constexpr size_t WS_BIASC = alup(WS_BIASA + 8 * 128 * 4);
constexpr size_t WS_KMEAN = alup(WS_BIASC + 8 * 8192 * 4);
constexpr size_t WS_RSUM = alup(WS_KMEAN + (size_t)BPC * 8 * 32 * 64 * 4);
constexpr size_t WS_WIN = alup(WS_RSUM + (size_t)BPC * 64 * 1024 * 2 * 4);
constexpr size_t WS_WB = alup(WS_WIN + (size_t)DIN * 1024 * 2);
constexpr size_t WS_WOUT = alup(WS_WB + (size_t)1024 * 2048 * 2);
constexpr size_t WS_WUP = alup(WS_WOUT + (size_t)1024 * 1024 * 2);
constexpr size_t WS_WDOWN = alup(WS_WUP + (size_t)DFF2 * 1024 * 2);
constexpr size_t WS_GT = alup(WS_WDOWN + (size_t)1024 * DFF * 2);
constexpr size_t WS_H = alup(WS_GT + (size_t)2 * 64 * 1024 * 2);
constexpr size_t WS_Z = alup(WS_H + (size_t)TC * 1024 * 2);
constexpr size_t WS_ACT = alup(WS_Z + (size_t)TC * DIN * 2);
constexpr size_t WS_VTC = alup(WS_ACT + (size_t)TC * DFF * 2);
constexpr size_t WS_BAR = alup(WS_VTC + (size_t)BPC * 8 * 64 * SEQ * 2);
constexpr int LCAP = 8192;
constexpr size_t WS_MCNT = alup(WS_BAR + 3456 * 4);
constexpr size_t WS_MQ = alup(WS_MCNT + (size_t)BPC * 8 * 32 * 4);
constexpr size_t WS_MLIST = alup(WS_MQ + 256);
constexpr size_t WS_MPART = alup(WS_MLIST + (size_t)BPC * 8 * 32 * LCAP * 4);
constexpr size_t WS_MLSUM = alup(WS_MPART + (size_t)TC * 8 * 4 * 64 * 2);
constexpr size_t WS_H8 = alup(WS_MLSUM + (size_t)TC * 8 * 4 * 4);
constexpr size_t WS_WG8 = alup(WS_H8 + (size_t)TC * 1024);
constexpr size_t WS_END = alup(WS_WG8 + (size_t)3072 * 1024);

struct P {
    const float *x, *c, *w_mod, *b_mod, *norm_mix, *norm_ffn, *w_in, *qnorm_a, *knorm_a, *sinks, *rnn_conv_w, *rnn_conv_b, *ga_w, *ga_b, *gx_w, *gx_b, *lam,
        *qnorm_c, *knorm_c, *rel_bias, *w_branch, *w_out, *w_up, *ffn_conv_w, *ffn_conv_b, *w_down;
    float* out; unsigned char* ws;
};

__device__ __forceinline__ P load_params() {
#if defined(__HIP_DEVICE_COMPILE__)
    unsigned long long v = (unsigned long long)__builtin_amdgcn_kernarg_segment_ptr(); asm volatile("" : "+s"(v));
    const P __attribute__((address_space(4)))* kp = (const P __attribute__((address_space(4)))*)v;
    return *kp;
#else
    return P{};
#endif
}
__device__ __forceinline__ int opaque_tid() { int t = threadIdx.x; asm volatile("" : "+v"(t)); return t; }
__device__ __forceinline__ float bf2f(unsigned v) { return __uint_as_float(v << 16); }
__device__ __forceinline__ unsigned cvt_pk_bf16(float lo, float hi) { unsigned r; asm volatile("v_cvt_pk_bf16_f32 %0, %1, %2" : "=v"(r) : "v"(lo), "v"(hi)); return r; }
__device__ __forceinline__ bf16_t f2bf(float f) { return (bf16_t)(cvt_pk_bf16(f, 0.0f) & 0xffffu); }
__device__ __forceinline__ unsigned pack2(float lo, float hi) { return cvt_pk_bf16(lo, hi); }
__device__ __forceinline__ void unpack8(const u32x4 v, float* f) {
    f[0] = bf2f(v[0] & 0xffffu); f[1] = bf2f(v[0] >> 16); f[2] = bf2f(v[1] & 0xffffu); f[3] = bf2f(v[1] >> 16);
    f[4] = bf2f(v[2] & 0xffffu); f[5] = bf2f(v[2] >> 16); f[6] = bf2f(v[3] & 0xffffu); f[7] = bf2f(v[3] >> 16);
}
__device__ __forceinline__ f32x4 mfma16(bf16x8 a, bf16x8 b, f32x4 c) { return __builtin_amdgcn_mfma_f32_16x16x32_bf16(a, b, c, 0, 0, 0); }
__device__ __forceinline__ int t5_bucket(int d) {
    if (d < 16) return d;
    const float lr = logf((float)d / 16.0f) / 4.852030263919617f;
    int large = 16 + (int)(lr * 16.0f);
    return large < 31 ? large : 31;
}
__device__ __forceinline__ float gelu_tanh(float y) { const float t = 0.7978845608028654f * (y + 0.044715f * y * y * y);
    return y * __builtin_amdgcn_rcpf(1.0f + __expf(-2.0f * t)); }
__device__ __forceinline__ float log1p_small(float x) { return (x < 0.125f) ? x * (1.0f + x * (-0.5f + x * (0.33333334f + x * (-0.25f + x * (0.2f + x * (-0.16666667f + x * 0.14285715f)))))) : __logf(1.0f + x); }
__device__ __forceinline__ float sigmoidf_(float v) { return 1.0f / (1.0f + __expf(-v)); }

namespace pg8 {
constexpr int BM = 256, BK = 64, HALF = 128, HTB = HALF * BK * 2, STAGE_BYTES = 8 * HTB, NXCD = 8, WGM = 8;
__device__ __forceinline__ int lds_byte(int r, int c) { const int st = (r >> 4) * 2 + (c >> 5), rr = r & 15, cc = c & 31, ob = rr * 64 + cc * 2; return st * 1024 + (ob ^ (((ob >> 9) & 1) << 5)); }
__device__ __forceinline__ void stage_rc(int b, int& R, int& C) { const int st = b / 1024, sb = b % 1024, swz = sb ^ (((sb >> 9) & 1) << 5); R = (st >> 1) * 16 + swz / 64; C = (st & 1) * 32 + (swz % 64) / 2; }
__device__ __forceinline__ int perm32(int rho) { const int n = rho >> 4, i = rho & 15; return 8 * (i >> 2) + 4 * n + (i & 3); }

struct Seg { const char* A; const char* B; int nt, pm, pn, pass; };

__device__ __forceinline__ bool unit_of(int i, int G, int c, int nM, int nN, int& pm, int& pn) {
    const int nwg = nM * nN; const long L = (long)i * G + c; if (L >= nwg) return false;
    int wgid = (int)L; { const int q = nwg / NXCD, r = nwg % NXCD, xcd = wgid % NXCD, off = wgid / NXCD; wgid = (xcd < r ? xcd * (q + 1) : r * (q + 1) + (xcd - r) * q) + off; }
    const int nig = WGM * nN, gid = wgid / nig, fm = gid * WGM, gsz = (nM - fm) < WGM ? (nM - fm) : WGM;
    pm = fm + ((wgid % nig) % gsz); pn = (wgid % nig) / gsz; return true;
}
struct SchedPlain {
    const char* A; const char* B; unsigned lda2, ldb2; int nt, nM, nN, G, c;
    __device__ __forceinline__ bool get(int i, Seg& s) const {
        int pm, pn; if (!unit_of(i, G, c, nM, nN, pm, pn)) return false;
        s.A = A + (size_t)pm * 256 * lda2; s.B = B + (size_t)pn * 256 * ldb2; s.nt = nt; s.pm = pm; s.pn = pn; s.pass = 0; return true;
    }
};
struct SchedMerge {
    const char* z; const char* wb; unsigned lda2, ldb2; int nM, nN, G, c;
    __device__ __forceinline__ bool get(int i, Seg& s) const {
        const int u = i / 3, ps = i - 3 * u; int pm, pn; if (!unit_of(u, G, c, nM, nN, pm, pn)) return false;
        const char* zr = z + (size_t)pm * 256 * (DIN * 2); const char* br = wb + (size_t)pn * 256 * 4096;
        s.pm = pm; s.pn = pn; s.pass = ps;
        if (ps == 0) { s.A = zr + C_QA * 2; s.B = br; s.nt = 8; }
        else if (ps == 1) { s.A = zr + C_YR * 2; s.B = br + 512 * 2; s.nt = 16; }
        else { s.A = zr + C_QC * 2; s.B = br + 1536 * 2; s.nt = 8; }
        return true;
    }
};

struct EpiStoreBf16 {
    static constexpr bool PERM = true;
    bf16_t* O; int ldc; int sig_from; float mul;
    __device__ __forceinline__ bool after(f32x4 (&acc)[2][2][4][2], const Seg& u, int wr, int wc, int fr, int fq) const {
        if (u.pn >= sig_from) {
#pragma unroll
            for (int ai = 0; ai < 2; ++ai)
#pragma unroll
                for (int bj = 0; bj < 2; ++bj)
#pragma unroll
                    for (int m = 0; m < 4; ++m)
#pragma unroll
                        for (int n = 0; n < 2; ++n)
#pragma unroll
                            for (int e = 0; e < 4; ++e) acc[ai][bj][m][n][e] = 1.0f + __builtin_amdgcn_exp2f(-1.4426950408889634f * fmaxf(acc[ai][bj][m][n][e] * mul, -60.0f));
        }
        const unsigned loff = (unsigned)((wr * 64 + fr) * ldc + wc * 32 + 8 * fq) * 2u;
        char* ub = (char*)O + ((size_t)u.pm * BM * ldc + (size_t)u.pn * BM) * 2;
#pragma unroll
        for (int ai = 0; ai < 2; ++ai)
#pragma unroll
            for (int m = 0; m < 4; ++m) { char* rb = ub + (size_t)(ai * HALF + m * 16) * ldc * 2;
#pragma unroll
                for (int bj = 0; bj < 2; ++bj) { const f32x4 v0 = acc[ai][bj][m][0], v1 = acc[ai][bj][m][1];
                    u32x4 pk; pk[0] = cvt_pk_bf16(v0[0], v0[1]); pk[1] = cvt_pk_bf16(v0[2], v0[3]); pk[2] = cvt_pk_bf16(v1[0], v1[1]); pk[3] = cvt_pk_bf16(v1[2], v1[3]);
                    { const unsigned vo = loff + (unsigned)(bj * HALF * 2); asm volatile("global_store_dwordx4 %0, %1, %2 sc1\n\ts_nop 1" :: "v"(vo), "v"(pk), "s"(rb) : "memory"); } } }
        return true;
    }
};
struct EpiResid {
    static constexpr bool PERM = false;
    const float* xin; float* xout; const float* gate; int b0;
    __device__ __forceinline__ bool after(f32x4 (&acc)[2][2][4][2], const Seg& u, int wr, int wc, int fr, int fq) const {
        const unsigned loff = (unsigned)((wr * 64 + fr) * DM + wc * 32 + 4 * fq) * 4u;
        const size_t uo = ((size_t)u.pm * BM * DM + (size_t)u.pn * BM) * 4;
        const char* ib = (const char*)xin + uo; char* ob = (char*)xout + uo;
        const char* gp = (const char*)(gate + (size_t)(b0 + (u.pm * BM) / SEQ) * 6144 + u.pn * BM);
        const unsigned goff = (unsigned)(wc * 32 + 4 * fq) * 4u;
        f32x4 gv[2][2];
#pragma unroll
        for (int bj = 0; bj < 2; ++bj)
#pragma unroll
            for (int n = 0; n < 2; ++n) gv[bj][n] = *(const f32x4*)(gp + goff + (bj * HALF + n * 16) * 4);
#pragma unroll
        for (int ai = 0; ai < 2; ++ai)
#pragma unroll
          for (int mh = 0; mh < 2; ++mh) {
            f32x4 xv[2][2][2];
#pragma unroll
            for (int m2 = 0; m2 < 2; ++m2) { const char* irb = ib + (size_t)(ai * HALF + (mh * 2 + m2) * 16) * DM * 4;
#pragma unroll
                for (int bj = 0; bj < 2; ++bj)
#pragma unroll
                    for (int n = 0; n < 2; ++n) xv[m2][bj][n] = *(const f32x4*)(irb + loff + (bj * HALF + n * 16) * 4); }
            __builtin_amdgcn_sched_barrier(0);
#pragma unroll
            for (int m2 = 0; m2 < 2; ++m2) { char* orb = ob + (size_t)(ai * HALF + (mh * 2 + m2) * 16) * DM * 4;
#pragma unroll
                for (int bj = 0; bj < 2; ++bj)
#pragma unroll
                    for (int n = 0; n < 2; ++n) *(f32x4*)(orb + loff + (bj * HALF + n * 16) * 4) = xv[m2][bj][n] + gv[bj][n] * acc[ai][bj][mh * 2 + m2][n]; }
            __builtin_amdgcn_sched_barrier(0); }
        return true;
    }
};
struct EpiMerge {
    static constexpr bool PERM = true;
    const bf16_t* z; bf16_t* O;
    __device__ __forceinline__ bool after(f32x4 (&acc)[2][2][4][2], const Seg& u, int wr, int wc, int fr, int fq) const {
        const int ps = u.pass;
        const int gA = (ps == 2) ? 2 : ps, gB = (ps == 2) ? 2 : ps + 1;
        const unsigned zoff = (unsigned)((wr * 64 + fr) * DIN + wc * 32 + 8 * fq) * 2u, ooff = (unsigned)((wr * 64 + fr) * DM + wc * 32 + 8 * fq) * 2u;
        const char* zb = (const char*)z + ((size_t)u.pm * BM * DIN + C_G + (size_t)u.pn * BM) * 2;
        const char* zA = zb + (size_t)gA * 2048; const char* zB = zb + (size_t)gB * 2048;
        char* ob = (char*)O + ((size_t)u.pm * BM * DM + (size_t)u.pn * BM) * 2;
#pragma unroll
        for (int ai = 0; ai < 2; ++ai)
#pragma unroll
          for (int mh = 0; mh < 2; ++mh) {
            u32x4 la[2][2], lb[2][2];
#pragma unroll
            for (int m2 = 0; m2 < 2; ++m2) { const size_t rz = (size_t)(ai * HALF + (mh * 2 + m2) * 16) * DIN * 2;
#pragma unroll
                for (int bj = 0; bj < 2; ++bj) { la[m2][bj] = *(const u32x4*)(zA + rz + zoff + bj * HALF * 2); lb[m2][bj] = *(const u32x4*)(zB + rz + zoff + bj * HALF * 2); } }
            __builtin_amdgcn_sched_barrier(0);
#pragma unroll
            for (int m2 = 0; m2 < 2; ++m2) { const int m = mh * 2 + m2; const size_t rO = (size_t)(ai * HALF + m * 16) * DM * 2;
#pragma unroll
                for (int bj = 0; bj < 2; ++bj) {
                    float fa[8], fb[8]; unpack8(la[m2][bj], fa); unpack8(lb[m2][bj], fb);
                    float sc[8];
#pragma unroll
                    for (int e = 0; e < 8; ++e) sc[e] = ((ps == 2) ? 1.0f : fb[e]) * __builtin_amdgcn_rcpf(fa[e]);
                    f32x4 v0 = acc[ai][bj][m][0], v1 = acc[ai][bj][m][1];
                    v0[0] *= sc[0]; v0[1] *= sc[1]; v0[2] *= sc[2]; v0[3] *= sc[3]; v1[0] *= sc[4]; v1[1] *= sc[5]; v1[2] *= sc[6]; v1[3] *= sc[7];
                    acc[ai][bj][m][0] = v0; acc[ai][bj][m][1] = v1;
                    if (ps == 2) { u32x4 pk; pk[0] = cvt_pk_bf16(v0[0], v0[1]); pk[1] = cvt_pk_bf16(v0[2], v0[3]); pk[2] = cvt_pk_bf16(v1[0], v1[1]); pk[3] = cvt_pk_bf16(v1[2], v1[3]);
                        *(u32x4*)(ob + rO + ooff + bj * HALF * 2) = pk; } } }
            __builtin_amdgcn_sched_barrier(0); }
        return ps == 2;
    }
};

template <class Sched, class Epi, bool FP8 = false, bool ALIGN_EPI = true, bool SP2 = true>
__device__ __forceinline__ void gemm_phase(LAS unsigned char* lds, const Sched& S, const Epi& E) {
    const int tid = opaque_tid(), wid = __builtin_amdgcn_readfirstlane(tid >> 6), lane = tid & 63, wr = wid >> 2, wc = wid & 3, fr = lane & 15, fq = lane >> 4;
    const unsigned cla = S.lda2, clb = S.ldb2;
    unsigned RA[2], RB[2];
#pragma unroll
    for (int i = 0; i < 2; ++i) { int R, C; stage_rc(tid * 16 + i * 8192, R, C); const int Rb = Epi::PERM ? ((R & ~31) + perm32(R & 31)) : R;
        RA[i] = (unsigned)R * cla + (unsigned)C * 2u; RB[i] = (unsigned)Rb * clb + (unsigned)C * 2u; }
    const size_t kstep = (size_t)(BK * 2);
    const unsigned ldsw = (unsigned)wid * 1024u;
    unsigned ofs_slot = (unsigned)tid * 16u;
    if constexpr (FP8) { u32x4 o4; o4[0] = RA[0]; o4[1] = RA[1]; o4[2] = RB[0]; o4[3] = RB[1]; *(LAS u32x4*)(lds + STAGE_BYTES + ofs_slot) = o4; asm volatile("" : "+v"(ofs_slot)); }
    const int aoff = lds_byte(wr * 64 + fr, fq * 8), boff = lds_byte(wc * 32 + fr, fq * 8);
#define PG8_SA(b, h) (((b) * 2 + (h)) * HTB)
#define PG8_SB(b, h) ((4 + (b) * 2 + (h)) * HTB)
#define PG8_STG(bufoff, gbase, RR, ld2) do { if constexpr (FP8) {   \
            const u32x4 _o4 = *(const LAS u32x4*)(lds + STAGE_BYTES + ofs_slot); const bool _isB = (&(RR)[0] == &RB[0]); \
            _Pragma("unroll") for (int _i = 0; _i < 2; ++_i) \
            __builtin_amdgcn_global_load_lds((const unsigned*)((const char*)(gbase) + (_isB ? _o4[2 + _i] : _o4[_i])), (LAS unsigned*)(lds + (bufoff) + ldsw + _i * 8192), 16, 0, 0); } \
        else { _Pragma("unroll") for (int _i = 0; _i < 2; ++_i) \
        __builtin_amdgcn_global_load_lds((const unsigned*)((const char*)(gbase) + (RR)[_i]), (LAS unsigned*)(lds + (bufoff) + ldsw + _i * 8192), 16, 0, 0); } } while (0)
#define PG8_LDA(dst, b, h) do { if constexpr (FP8) { _Pragma("unroll") for (int m = 0; m < 4; ++m) { \
            const u32x4 _lo = *(const LAS u32x4*)(lds + PG8_SA(b, h) + aoff + m * 2048), _hi = *(const LAS u32x4*)(lds + PG8_SA(b, h) + aoff + m * 2048 + 1024); \
            dst##_8[m] = __builtin_shufflevector(_lo, _hi, 0, 1, 2, 3, 4, 5, 6, 7); } } \
        else { _Pragma("unroll") for (int m = 0; m < 4; ++m) _Pragma("unroll") for (int k = 0; k < 2; ++k) dst[m][k] = *(const LAS bf16x8*)(lds + PG8_SA(b, h) + aoff + m * 2048 + k * 1024); } } while (0)
#define PG8_LDB(dst, b, h) do { if constexpr (FP8) { _Pragma("unroll") for (int n = 0; n < 2; ++n) { \
            const u32x4 _lo = *(const LAS u32x4*)(lds + PG8_SB(b, h) + boff + n * 2048), _hi = *(const LAS u32x4*)(lds + PG8_SB(b, h) + boff + n * 2048 + 1024); \
            dst##_8[n] = __builtin_shufflevector(_lo, _hi, 0, 1, 2, 3, 4, 5, 6, 7); } } \
        else { _Pragma("unroll") for (int n = 0; n < 2; ++n) _Pragma("unroll") for (int k = 0; k < 2; ++k) dst[n][k] = *(const LAS bf16x8*)(lds + PG8_SB(b, h) + boff + n * 2048 + k * 1024); } } while (0)
#define PG8_MMA(ai, bj, At, Bt) do { __builtin_amdgcn_s_setprio(1); \
        if constexpr (FP8) { _Pragma("unroll") for (int m = 0; m < 4; ++m) _Pragma("unroll") for (int n = 0; n < 2; ++n) \
            acc[ai][bj][m][n] = __builtin_amdgcn_mfma_scale_f32_16x16x128_f8f6f4(__builtin_bit_cast(i32x8, Bt##_8[n]), __builtin_bit_cast(i32x8, At##_8[m]), acc[ai][bj][m][n], 0, 0, 0, 0x7f7f7f7f, 0, 0x7f7f7f7f); } \
        else { _Pragma("unroll") for (int m = 0; m < 4; ++m) _Pragma("unroll") for (int n = 0; n < 2; ++n) _Pragma("unroll") for (int k = 0; k < 2; ++k) \
            acc[ai][bj][m][n] = __builtin_amdgcn_mfma_f32_16x16x32_bf16(Bt[n][k], At[m][k], acc[ai][bj][m][n], 0, 0, 0); } \
        __builtin_amdgcn_s_setprio(0); } while (0)
#define PG8_WAIT_V(n) asm volatile("s_waitcnt vmcnt(" #n ")" ::: "memory")
#define PG8_WAIT_L(n) asm volatile("s_waitcnt lgkmcnt(" #n ")" ::: "memory")
#define PG8_BAR __builtin_amdgcn_s_barrier()
#define PG8_SCHED __builtin_amdgcn_sched_barrier(0)
    Seg cur, nxt; int si = 0;
    if (!S.get(0, cur)) return;
    f32x4 acc[2][2][4][2];
#pragma unroll
    for (int a = 0; a < 2; ++a)
#pragma unroll
        for (int b = 0; b < 2; ++b)
#pragma unroll
            for (int m = 0; m < 4; ++m)
#pragma unroll
                for (int n = 0; n < 2; ++n) acc[a][b][m][n] = (f32x4){0.f, 0.f, 0.f, 0.f};
    bf16x8 At[4][2], B0[2][2], B1[2][2];
    u32x8 At_8[4], B0_8[2], B1_8[2];
    const char* cA = cur.A; const char* cB = cur.B;
    if constexpr (SP2) {
        PG8_STG(PG8_SB(0, 0), cB, RB, clb); PG8_STG(PG8_SB(0, 1), cB + (size_t)HALF * clb, RB, clb); PG8_STG(PG8_SA(0, 0), cA, RA, cla); PG8_STG(PG8_SA(0, 1), cA + (size_t)HALF * cla, RA, cla);
        if (wr == 1) PG8_BAR;
        PG8_WAIT_V(2); PG8_BAR;
        PG8_STG(PG8_SB(1, 0), cB + kstep, RB, clb); PG8_STG(PG8_SA(1, 0), cA + kstep, RA, cla); PG8_STG(PG8_SB(1, 1), cB + (size_t)HALF * clb + kstep, RB, clb);
        PG8_WAIT_V(6); PG8_BAR;
    } else {
    PG8_STG(PG8_SB(0, 0), cB, RB, clb); PG8_STG(PG8_SA(0, 0), cA, RA, cla); PG8_STG(PG8_SB(0, 1), cB + (size_t)HALF * clb, RB, clb); PG8_STG(PG8_SA(0, 1), cA + (size_t)HALF * cla, RA, cla);
    if (wr == 1) PG8_BAR;
    PG8_WAIT_V(4); PG8_BAR;
    PG8_STG(PG8_SB(1, 0), cB + kstep, RB, clb); PG8_STG(PG8_SA(1, 0), cA + kstep, RA, cla); PG8_STG(PG8_SB(1, 1), cB + (size_t)HALF * clb + kstep, RB, clb);
    PG8_WAIT_V(6); PG8_BAR;
    }
    for (;;) {
        const bool has_next = S.get(si + 1, nxt);
        const char* nA = has_next ? nxt.A : cA; const char* nB = has_next ? nxt.B : cB;
        const int nt = cur.nt;
        for (int t = 0; t < nt; t += 2) {
            const bool last = (t == nt - 2);
            const char* a1 = cA + (size_t)(t + 1) * kstep;
            const char* a2 = last ? nA : cA + (size_t)(t + 2) * kstep; const char* b2 = last ? nB : cB + (size_t)(t + 2) * kstep;
            const unsigned la2 = cla, lb2 = clb;
            const char* a3 = a2 + kstep; const char* b3 = b2 + kstep;
            if constexpr (SP2) {
            PG8_LDB(B0, 0, 0); PG8_LDB(B1, 0, 1); PG8_SCHED; PG8_LDA(At, 0, 0); PG8_STG(PG8_SA(1, 1), a1 + (size_t)HALF * cla, RA, cla);
            PG8_WAIT_V(8); PG8_WAIT_L(0); PG8_BAR; PG8_MMA(0, 0, At, B0); PG8_MMA(0, 1, At, B1); PG8_BAR; PG8_SCHED;
            PG8_LDA(At, 0, 1); PG8_STG(PG8_SB(0, 0), b2, RB, lb2); PG8_STG(PG8_SB(0, 1), b2 + (size_t)HALF * lb2, RB, lb2); PG8_STG(PG8_SA(0, 0), a2, RA, la2);
            PG8_WAIT_V(8); PG8_WAIT_L(0); PG8_BAR; PG8_MMA(1, 0, At, B0); PG8_MMA(1, 1, At, B1); PG8_BAR; PG8_SCHED;
            PG8_LDB(B0, 1, 0); PG8_LDB(B1, 1, 1); PG8_SCHED; PG8_LDA(At, 1, 0); PG8_STG(PG8_SA(0, 1), a2 + (size_t)HALF * la2, RA, la2);
            PG8_WAIT_V(8); PG8_WAIT_L(0); PG8_BAR; PG8_MMA(0, 0, At, B0); PG8_MMA(0, 1, At, B1); PG8_BAR; PG8_SCHED;
            PG8_LDA(At, 1, 1); PG8_STG(PG8_SB(1, 0), b3, RB, lb2); PG8_STG(PG8_SB(1, 1), b3 + (size_t)HALF * lb2, RB, lb2); PG8_STG(PG8_SA(1, 0), a3, RA, la2);
            PG8_WAIT_V(8); PG8_WAIT_L(0); PG8_BAR; PG8_MMA(1, 0, At, B0); PG8_MMA(1, 1, At, B1); PG8_BAR; PG8_SCHED;
            } else {
            PG8_LDB(B0, 0, 0); PG8_SCHED; PG8_LDA(At, 0, 0); PG8_STG(PG8_SA(1, 1), a1 + (size_t)HALF * cla, RA, cla);
            PG8_WAIT_L(8); PG8_BAR; PG8_WAIT_L(0); PG8_MMA(0, 0, At, B0); PG8_BAR; PG8_SCHED;
            PG8_LDB(B1, 0, 1); PG8_STG(PG8_SB(0, 0), b2, RB, lb2);
            PG8_BAR; PG8_WAIT_L(0); PG8_MMA(0, 1, At, B1); PG8_BAR;
            PG8_LDA(At, 0, 1); PG8_STG(PG8_SA(0, 0), a2, RA, la2);
            PG8_BAR; PG8_WAIT_L(0); PG8_MMA(1, 0, At, B0); PG8_BAR; PG8_SCHED;
            PG8_STG(PG8_SB(0, 1), b2 + (size_t)HALF * lb2, RB, lb2);
            PG8_WAIT_V(6); PG8_BAR; PG8_MMA(1, 1, At, B1); PG8_BAR;
            PG8_LDB(B0, 1, 0); PG8_SCHED; PG8_LDA(At, 1, 0); PG8_STG(PG8_SA(0, 1), a2 + (size_t)HALF * la2, RA, la2);
            PG8_WAIT_L(8); PG8_BAR; PG8_WAIT_L(0); PG8_MMA(0, 0, At, B0); PG8_BAR; PG8_SCHED;
            PG8_LDB(B1, 1, 1); PG8_STG(PG8_SB(1, 0), b3, RB, lb2);
            PG8_BAR; PG8_WAIT_L(0); PG8_MMA(0, 1, At, B1); PG8_BAR;
            PG8_LDA(At, 1, 1); PG8_STG(PG8_SA(1, 0), a3, RA, la2);
            PG8_BAR; PG8_WAIT_L(0); PG8_MMA(1, 0, At, B0); PG8_BAR; PG8_SCHED;
            PG8_STG(PG8_SB(1, 1), b3 + (size_t)HALF * lb2, RB, lb2);
            PG8_WAIT_V(6); PG8_BAR; PG8_MMA(1, 1, At, B1); PG8_BAR;
            }
        }
        if constexpr (ALIGN_EPI) { if (wr == 0) PG8_BAR; }
        const bool done = E.after(acc, cur, wr, wc, fr, fq);
        if (!has_next) break;
        if (done) {
#pragma unroll
            for (int a = 0; a < 2; ++a)
#pragma unroll
                for (int b = 0; b < 2; ++b)
#pragma unroll
                    for (int m = 0; m < 4; ++m)
#pragma unroll
                        for (int n = 0; n < 2; ++n) acc[a][b][m][n] = (f32x4){0.f, 0.f, 0.f, 0.f};
        }
        cur = nxt; cA = nA; cB = nB; ++si;
        if constexpr (ALIGN_EPI) { if (wr == 1) PG8_BAR; }
    }
    PG8_WAIT_V(0);
    if constexpr (!ALIGN_EPI) { if (wr == 0) PG8_BAR; }
    PG8_BAR;
#undef PG8_SA
#undef PG8_SB
#undef PG8_STG
#undef PG8_LDA
#undef PG8_LDB
#undef PG8_MMA
#undef PG8_WAIT_V
#undef PG8_WAIT_L
#undef PG8_BAR
#undef PG8_SCHED
}
}

__device__ __forceinline__ void phase0(const P& p, LAS unsigned char* lds) {
    float* mod = (float*)(p.ws + WS_MOD);
    LAS float* sc = (LAS float*)lds;
    LAS float* red = sc + 4096;
    const int tid = opaque_tid();
    for (int i = tid; i < 4096; i += NTHREADS) { const float v = p.c[i]; sc[i] = v / (1.0f + __expf(-v)); }
    __syncthreads();
    const int cl = tid & 63, kg = tid >> 6;
    for (int item = blockIdx.x; item < DEPTH * 96; item += gridDim.x) {
        const int l = item / 96, j = (item % 96) * 64 + cl;
        const float* w = p.w_mod + (size_t)l * 1024 * 6144 + j;
        float a0 = 0.f, a1 = 0.f, a2 = 0.f, a3 = 0.f;
#pragma unroll 8
        for (int k = kg * 128; k < kg * 128 + 128; ++k) { const float wv = w[(size_t)k * 6144]; a0 += sc[k] * wv; a1 += sc[1024 + k] * wv; a2 += sc[2048 + k] * wv; a3 += sc[3072 + k] * wv; }
        red[(kg * 64 + cl) * 4 + 0] = a0; red[(kg * 64 + cl) * 4 + 1] = a1; red[(kg * 64 + cl) * 4 + 2] = a2; red[(kg * 64 + cl) * 4 + 3] = a3;
        __syncthreads();
        if (tid < 256) { const int b = tid >> 6, c2 = tid & 63; float s = 0.f;
#pragma unroll
            for (int g = 0; g < 8; ++g) s += red[(g * 64 + c2) * 4 + b];
            const int jj = (item % 96) * 64 + c2; mod[(size_t)(l * 4 + b) * 6144 + jj] = s + p.b_mod[l * 6144 + jj]; }
        __syncthreads();
    }
    float* biasA = (float*)(p.ws + WS_BIASA); float* biasC = (float*)(p.ws + WS_BIASC);
    for (int i = blockIdx.x * NTHREADS + tid; i < 8 * 8192; i += gridDim.x * NTHREADS) { const int h = i >> 13, d = i & 8191; biasC[i] = p.rel_bias[t5_bucket(d) * 16 + 8 + h]; }
    for (int i = blockIdx.x * NTHREADS + tid; i < 8 * 128; i += gridDim.x * NTHREADS) { const int h = i >> 7, d = i & 127; biasA[i] = p.rel_bias[t5_bucket(d) * 16 + h]; }
}

__device__ __forceinline__ void phase_norm(const float* xsrc, const float* gain, const float* mod_l, int shift_off, int scale_off, int b0, bf16_t* H, unsigned char* H8) {
    const int tid = opaque_tid(), wid = tid >> 6, lane = tid & 63;
    constexpr int RPW = TC / (256 * 8);
    const int wglob = blockIdx.x * 8 + wid, nw = gridDim.x * 8;
    for (int r0 = wglob * 4; r0 < TC; r0 += nw * 4) {
        f32x4 v[4][4]; float ss[4];
#pragma unroll
        for (int q = 0; q < 4; ++q) { const f32x4* xr = (const f32x4*)(xsrc + (size_t)(r0 + q) * DM);
#pragma unroll
            for (int i = 0; i < 4; ++i) v[q][i] = xr[lane + 64 * i]; }
#pragma unroll
        for (int q = 0; q < 4; ++q) { float a = 0.f;
#pragma unroll
            for (int i = 0; i < 4; ++i) a += v[q][i][0] * v[q][i][0] + v[q][i][1] * v[q][i][1] + v[q][i][2] * v[q][i][2] + v[q][i][3] * v[q][i][3];
            ss[q] = a; }
#pragma unroll
        for (int off = 32; off >= 1; off >>= 1) {
#pragma unroll
            for (int q = 0; q < 4; ++q) ss[q] += __shfl_xor(ss[q], off); }
        const float* mb = mod_l + (size_t)(b0 + r0 / SEQ) * 6144;
#pragma unroll
        for (int i = 0; i < 4; ++i) { const int col = (lane + 64 * i) * 4;
            const f32x4 g = *(const f32x4*)(gain + col), sc = *(const f32x4*)(mb + scale_off + col), sh = *(const f32x4*)(mb + shift_off + col);
#pragma unroll
            for (int q = 0; q < 4; ++q) { const float rinv = rsqrtf(ss[q] * (1.0f / 1024.0f) + RMS_EPS);
                float h[4];
#pragma unroll
                for (int e = 0; e < 4; ++e) h[e] = (v[q][i][e] * rinv * g[e]) * (1.0f + sc[e]) + sh[e];
                u32x2 pk; pk[0] = cvt_pk_bf16(h[0], h[1]); pk[1] = cvt_pk_bf16(h[2], h[3]);
                *(u32x2*)(H + (size_t)(r0 + q) * DM + col) = pk;
                if (H8) { unsigned p8 = 0u; p8 = __builtin_amdgcn_cvt_pk_fp8_f32(h[0], h[1], p8, false); p8 = __builtin_amdgcn_cvt_pk_fp8_f32(h[2], h[3], p8, true);
                    *(unsigned*)(H8 + (size_t)(r0 + q) * DM + col) = p8; } } }
    }
    (void)RPW;
}

__device__ __forceinline__ void phase_convert(const P& p, int l, LAS unsigned char* lds) {
    LAS float* t = (LAS float*)lds;
    constexpr int NJ = 8;
    const float* srcs[NJ] = { p.w_in + (size_t)l * 1024 * DIN, p.w_branch + (size_t)l * 2048 * 1024, p.w_out + (size_t)l * 1024 * 1024, p.w_up + (size_t)l * 1024 * DFF2,
        p.w_down + (size_t)l * DFF * 1024, p.ga_w + (size_t)l * 1024 * 64, p.gx_w + (size_t)l * 1024 * 64, p.w_in + (size_t)l * 1024 * DIN + C_G };
    const int Ks[NJ] = { 1024, 2048, 1024, 1024, DFF, 1024, 1024, 1024 };
    const int Ns[NJ] = { C_G, 1024, 1024, DFF2, 1024, 64, 64, 3072 };
    const int Ls[NJ] = { DIN, 1024, 1024, DFF2, 1024, 64, 64, DIN };
    const size_t dsts[NJ] = { WS_WIN, WS_WB, WS_WOUT, WS_WUP, WS_WDOWN, WS_GT, WS_GT + (size_t)64 * 1024 * 2, WS_WG8 };
    const int tid = opaque_tid();
    const int r = tid >> 4, c4 = (tid & 15) * 4, n = tid >> 3, kk = (tid & 7) * 8;
    int base = 0;
#pragma unroll
    for (int j = 0; j < NJ; ++j) {
        const int tn = Ns[j] / 64, ntile = (Ks[j] / 64) * tn;
        const float* src = srcs[j]; const int ldn = Ls[j], ldk = Ks[j]; bf16_t* dst = (bf16_t*)(p.ws + dsts[j]);
        int ti = (int)blockIdx.x - (base % (int)gridDim.x); if (ti < 0) ti += gridDim.x;
        f32x4 v0 = (f32x4){0.f, 0.f, 0.f, 0.f}, v1 = v0;
        if (ti < ntile) { const int kt = ti / tn, nn = ti - kt * tn; const float* sp = src + (size_t)(kt * 64 + r) * ldn + nn * 64 + c4; v0 = *(const f32x4*)sp; v1 = *(const f32x4*)(sp + (size_t)32 * ldn); }
        for (; ti < ntile; ti += gridDim.x) {
            const int kt = ti / tn, nn = ti - kt * tn;
            t[r * 65 + c4 + 0] = v0[0]; t[r * 65 + c4 + 1] = v0[1]; t[r * 65 + c4 + 2] = v0[2]; t[r * 65 + c4 + 3] = v0[3];
            t[(r + 32) * 65 + c4 + 0] = v1[0]; t[(r + 32) * 65 + c4 + 1] = v1[1]; t[(r + 32) * 65 + c4 + 2] = v1[2]; t[(r + 32) * 65 + c4 + 3] = v1[3];
            __syncthreads();
            const int tnx = ti + (int)gridDim.x;
            if (tnx < ntile) { const int kt2 = tnx / tn, nn2 = tnx - kt2 * tn; const float* sp = src + (size_t)(kt2 * 64 + r) * ldn + nn2 * 64 + c4; v0 = *(const f32x4*)sp; v1 = *(const f32x4*)(sp + (size_t)32 * ldn); }
            if (j == 7) { u32x2 p8; p8[0] = 0u; p8[1] = 0u;
#pragma unroll
                for (int q = 0; q < 2; ++q) { p8[q] = __builtin_amdgcn_cvt_pk_fp8_f32(t[(kk + 4 * q) * 65 + n] * 64.0f, t[(kk + 4 * q + 1) * 65 + n] * 64.0f, p8[q], false);
                    p8[q] = __builtin_amdgcn_cvt_pk_fp8_f32(t[(kk + 4 * q + 2) * 65 + n] * 64.0f, t[(kk + 4 * q + 3) * 65 + n] * 64.0f, p8[q], true); }
                *(u32x2*)((unsigned char*)dst + (size_t)(nn * 64 + n) * ldk + kt * 64 + kk) = p8; }
            else { u32x4 pk;
#pragma unroll
                for (int q = 0; q < 4; ++q) pk[q] = cvt_pk_bf16(t[(kk + 2 * q) * 65 + n], t[(kk + 2 * q + 1) * 65 + n]);
                *(u32x4*)(dst + (size_t)(nn * 64 + n) * ldk + kt * 64 + kk) = pk; }
            __syncthreads();
        }
        base += ntile;
    }
}

__device__ __forceinline__ void phase_qknorm(const P& p, int l, bf16_t* z) {
    const int tid = opaque_tid(), wid = tid >> 6, lane = tid & 63, g8 = lane & 7;
    float gqa[8], gka[8], gqc[8];
#pragma unroll
    for (int j = 0; j < 8; ++j) { gqa[j] = p.qnorm_a[l * 64 + g8 * 8 + j]; gka[j] = p.knorm_a[l * 64 + g8 * 8 + j]; gqc[j] = p.qnorm_c[l * 64 + g8 * 8 + j]; }
    for (int r0 = (blockIdx.x * 8 + wid) * 4; r0 < TC; r0 += gridDim.x * 8 * 4) {
        u32x4 raw[4][3];
#pragma unroll
        for (int q = 0; q < 4; ++q) { const bf16_t* rowp = z + (size_t)(r0 + q) * DIN;
            raw[q][0] = *(const u32x4*)(rowp + C_QA + lane * 8); raw[q][1] = *(const u32x4*)(rowp + C_KA + (lane & 15) * 8); raw[q][2] = *(const u32x4*)(rowp + C_QC + lane * 8); }
#pragma unroll
        for (int q = 0; q < 4; ++q) { bf16_t* rowp = z + (size_t)(r0 + q) * DIN;
#pragma unroll
            for (int it = 0; it < 3; ++it) {
                const int col = (it == 0) ? C_QA + lane * 8 : (it == 1) ? C_KA + (lane & 15) * 8 : C_QC + lane * 8;
                float f[8]; unpack8(raw[q][it], f);
                float ss = 0.f;
#pragma unroll
                for (int j = 0; j < 8; ++j) ss += f[j] * f[j];
                ss += __shfl_xor(ss, 1); ss += __shfl_xor(ss, 2); ss += __shfl_xor(ss, 4);
                const float rinv = rsqrtf(ss * (1.0f / 64.0f) + RMS_EPS);
                u32x4 pk;
#pragma unroll
                for (int j = 0; j < 4; ++j) { const float g0 = (it == 0) ? gqa[2 * j] : (it == 1) ? gka[2 * j] : gqc[2 * j], g1 = (it == 0) ? gqa[2 * j + 1] : (it == 1) ? gka[2 * j + 1] : gqc[2 * j + 1];
                    pk[j] = cvt_pk_bf16(f[2 * j] * rinv * g0, f[2 * j + 1] * rinv * g1); }
                if (it != 1 || lane < 16) *(u32x4*)(rowp + col) = pk;
            } }
    }
}
__device__ __forceinline__ void phase_kcnorm(const P& p, int l, bf16_t* z, LAS unsigned char* lds) {
    LAS float* red = (LAS float*)lds;
    LAS bf16_t* sT = (LAS bf16_t*)(lds + 16384);
    float* kmean = (float*)(p.ws + WS_KMEAN);
    const int tid = opaque_tid(), g8 = tid & 7, tg = tid >> 3;
    float gk[8];
#pragma unroll
    for (int j = 0; j < 8; ++j) gk[j] = p.knorm_c[l * 64 + g8 * 8 + j];
    for (int item = blockIdx.x; item < BPC * 8 * 32; item += gridDim.x) {
        const int m = item & 31, h = (item >> 5) & 7, bl = item >> 8;
        bf16_t* kbase = z + ((size_t)bl * SEQ + m * 256 + tg) * DIN + C_KC + h * 64 + g8 * 8;
        u32x4 kraw[4], vraw[4];
#pragma unroll
        for (int ps = 0; ps < 4; ++ps) kraw[ps] = *(const u32x4*)(kbase + (size_t)ps * 64 * DIN);
#pragma unroll
        for (int k = 0; k < 4; ++k) { const int i = tid + k * NTHREADS, kj = i >> 3, c8 = (i & 7) * 8;
            vraw[k] = *(const u32x4*)(z + ((size_t)bl * SEQ + m * 256 + kj) * DIN + C_VC + h * 64 + c8); }
        float ms[8];
#pragma unroll
        for (int j = 0; j < 8; ++j) ms[j] = 0.f;
#pragma unroll
        for (int ps = 0; ps < 4; ++ps) {
            float f[8]; unpack8(kraw[ps], f);
            float ss = 0.f;
#pragma unroll
            for (int j = 0; j < 8; ++j) ss += f[j] * f[j];
            ss += __shfl_xor(ss, 1); ss += __shfl_xor(ss, 2); ss += __shfl_xor(ss, 4);
            const float rinv = rsqrtf(ss * (1.0f / 64.0f) + RMS_EPS);
            float y[8];
#pragma unroll
            for (int j = 0; j < 8; ++j) { y[j] = f[j] * rinv * gk[j]; ms[j] += y[j]; }
            u32x4 pk;
#pragma unroll
            for (int j = 0; j < 4; ++j) pk[j] = cvt_pk_bf16(y[2 * j], y[2 * j + 1]);
            *(u32x4*)(kbase + (size_t)ps * 64 * DIN) = pk;
        }
#pragma unroll
        for (int j = 0; j < 8; ++j) red[tg * 64 + g8 * 8 + j] = ms[j];
#pragma unroll
        for (int k = 0; k < 4; ++k) { const int i = tid + k * NTHREADS, kj = i >> 3, c8 = (i & 7) * 8; *(LAS u32x4*)(sT + kj * 72 + c8) = vraw[k]; }
        __syncthreads();
        if (tid < 64) { float sm = 0.f; for (int g = 0; g < 64; ++g) sm += red[g * 64 + tid]; kmean[((size_t)(bl * 8 + h) * 32 + m) * 64 + tid] = sm * (1.0f / 256.0f); }
        {
            bf16_t* Vtg = (bf16_t*)(p.ws + WS_VTC) + (size_t)(bl * 8 + h) * 64 * SEQ;
            const int d = tid >> 3, tgp = tid & 7;
#pragma unroll
            for (int g = 0; g < 4; ++g) { const int t8 = tgp * 32 + g * 8; u32x4 pk;
#pragma unroll
                for (int j = 0; j < 4; ++j) pk[j] = (unsigned)sT[(t8 + 2 * j) * 72 + d] | ((unsigned)sT[(t8 + 2 * j + 1) * 72 + d] << 16);
                *(u32x4*)(Vtg + (size_t)d * SEQ + m * 256 + t8) = pk; }
        }
        __syncthreads();
    }
}

__device__ __forceinline__ void phase_rnn0(const P& p, int l, LAS unsigned char* lds, const bf16_t* z) {
    LAS float* sX = (LAS float*)lds;
    LAS float* sA = sX + 131 * 64 + 64;
    LAS float* sU = sA + 128 * 64;
    LAS float* sS = sU + 128 * 64;
    LAS bf16_t* sXb = (LAS bf16_t*)(sS + 8 * 64 * 2);
    LAS bf16_t* sGt = sXb + 128 * 72;
    float* rsum = (float*)(p.ws + WS_RSUM);
    const bf16_t* Gt = (const bf16_t*)(p.ws + WS_GT);
    bf16_t* OM = (bf16_t*)(p.ws + WS_ACT); bf16_t* UU = OM + (size_t)TC * 1024;
    const int tid = opaque_tid(), wid = tid >> 6, lane = tid & 63, fr = lane & 15, fq = lane >> 4;
    const int nbg = (int)gridDim.x >> 4;
    const int nb = blockIdx.x & 15, first = (int)blockIdx.x >> 4;
    if (first >= nbg) return;
    for (int i = tid; i < 2 * 64 * 8; i += NTHREADS) { const int g = i >> 9, d = (i >> 3) & 63, c8 = (i & 7) * 8;
        *(LAS u32x4*)(sGt + (g * 64 + d) * 72 + c8) = *(const u32x4*)(Gt + (size_t)g * 64 * 1024 + (size_t)d * 1024 + nb * 64 + c8); }
    const int ch = nb * 64 + lane;
    const float w0 = p.rnn_conv_w[(size_t)(l * 4 + 0) * 1024 + ch], w1 = p.rnn_conv_w[(size_t)(l * 4 + 1) * 1024 + ch], w2 = p.rnn_conv_w[(size_t)(l * 4 + 2) * 1024 + ch],
                w3 = p.rnn_conv_w[(size_t)(l * 4 + 3) * 1024 + ch], cb = p.rnn_conv_b[l * 1024 + ch];
    float bra[4], bix[4], spv[4];
#pragma unroll
    for (int nt = 0; nt < 4; ++nt) { const int chd = nb * 64 + nt * 16 + fr; bra[nt] = p.ga_b[l * 1024 + chd]; bix[nt] = p.gx_b[l * 1024 + chd];
        const float lamv = p.lam[l * 1024 + chd]; spv[nt] = (lamv > 15.f) ? __expf(-lamv) : log1p_small(__expf(-lamv)); }
    u32x4 xr[3];
#define RNN_PREFETCH(idx_) do { const int bl_ = (idx_) >> 6, t0_ = ((idx_) & 63) * 128; _Pragma("unroll") for (int k_ = 0; k_ < 3; ++k_) { const int i_ = tid + k_ * NTHREADS; const int rr_ = i_ >> 3, c8_ = (i_ & 7) * 8, t_ = t0_ - 3 + rr_; \
        xr[k_] = (u32x4){0u, 0u, 0u, 0u}; if (i_ < 131 * 8 && t_ >= 0) xr[k_] = *(const u32x4*)(z + ((size_t)bl_ * SEQ + t_) * DIN + C_XR + nb * 64 + c8_); } } while (0)
    RNN_PREFETCH(first);
    for (int idx = first; idx < BPC * 64; idx += nbg) {
        const int bl = idx >> 6, seg = idx & 63, t0 = seg * 128;
#pragma unroll
        for (int k = 0; k < 3; ++k) { const int i = tid + k * NTHREADS; if (i < 131 * 8) { const int rr = i >> 3, c8 = (i & 7) * 8; float f[8]; unpack8(xr[k], f);
            *(LAS f32x4*)(sX + rr * 64 + c8) = (f32x4){f[0], f[1], f[2], f[3]}; *(LAS f32x4*)(sX + rr * 64 + c8 + 4) = (f32x4){f[4], f[5], f[6], f[7]}; } }
        __syncthreads();
        if (idx + nbg < BPC * 64) RNN_PREFETCH(idx + nbg);
#pragma unroll
        for (int i = 0; i < 16; ++i) { const int tt = wid * 16 + i;
            const float xc = cb + w0 * sX[(tt + 0) * 64 + lane] + w1 * sX[(tt + 1) * 64 + lane] + w2 * sX[(tt + 2) * 64 + lane] + w3 * sX[(tt + 3) * 64 + lane];
            sXb[tt * 72 + lane] = f2bf(xc); }
        __syncthreads();
        { bf16x8 a[2];
#pragma unroll
          for (int ks = 0; ks < 2; ++ks) a[ks] = *(const LAS bf16x8*)(sXb + (16 * wid + fr) * 72 + ks * 32 + fq * 8);
#pragma unroll
          for (int nt = 0; nt < 4; ++nt) {
              f32x4 ar = (f32x4){0.f, 0.f, 0.f, 0.f}, ai = (f32x4){0.f, 0.f, 0.f, 0.f};
#pragma unroll
              for (int ks = 0; ks < 2; ++ks) {
                  const bf16x8 br = *(const LAS bf16x8*)(sGt + (nt * 16 + fr) * 72 + ks * 32 + fq * 8);
                  const bf16x8 bi = *(const LAS bf16x8*)(sGt + (64 + nt * 16 + fr) * 72 + ks * 32 + fq * 8);
                  ar = mfma16(a[ks], br, ar); ai = mfma16(a[ks], bi, ai); }
              const int d = nt * 16 + fr;
#pragma unroll
              for (int j = 0; j < 4; ++j) { const int tok = 16 * wid + 4 * fq + j;
                  const float r = __builtin_amdgcn_rcpf(1.0f + __expf(-(ar[j] + bra[nt]))), ig = __builtin_amdgcn_rcpf(1.0f + __expf(-(ai[j] + bix[nt])));
                  const float log_a = -8.0f * r * spv[nt]; const float av = __expf(log_a);
                  const float x2 = 2.0f * log_a;
                  const float om2 = (x2 > -0.25f) ? -x2 * (1.0f + x2 * (0.5f + x2 * (0.16666667f + x2 * (0.041666668f + x2 * (0.0083333338f + x2 * 0.0013888889f))))) : 1.0f - av * av;
                  float mult = __builtin_amdgcn_sqrtf(fmaxf(om2, 0.f));
                  if (t0 + tok == 0) mult = 1.0f;
                  sA[tok * 64 + d] = av; sU[tok * 64 + d] = mult * (ig * bf2f((unsigned)sXb[tok * 72 + d])); }
          } }
        __syncthreads();
        { float hl = 0.f, Pp = 1.f;
          const unsigned go0 = (unsigned)((bl * SEQ + t0 + wid * 16) * 1024 + ch);
#pragma unroll 4
          for (int i = 0; i < 16; ++i) { const int tt = wid * 16 + i;
              const bf16_t omb = f2bf(1.0f - sA[tt * 64 + lane]), ub = f2bf(sU[tt * 64 + lane]);
              const float av = 1.0f - bf2f((unsigned)omb), uv = bf2f((unsigned)ub);
              OM[go0 + (unsigned)i * 1024u] = omb; UU[go0 + (unsigned)i * 1024u] = ub;
              hl = av * hl + uv; Pp *= av; }
          sS[(wid * 64 + lane) * 2] = Pp; sS[(wid * 64 + lane) * 2 + 1] = hl; }
        __syncthreads();
        if (wid == 0) { float Pt = 1.f, Ht = 0.f;
#pragma unroll
            for (int w = 0; w < 8; ++w) { const float Pw = sS[(w * 64 + lane) * 2], Hw = sS[(w * 64 + lane) * 2 + 1]; Ht = Pw * Ht + Hw; Pt *= Pw; }
            float* o = rsum + ((size_t)(bl * 64 + seg) * 1024 + ch) * 2; o[0] = Pt; o[1] = Ht; }
    }
#undef RNN_PREFETCH
    __syncthreads();
}

__device__ __forceinline__ void phase_rnn_apply(const P& p, LAS unsigned char* lds, bf16_t* z) {
    LAS float* sS = (LAS float*)lds;
    LAS float* sC = sS + 8 * 64 * 2;
    const float* rsum = (const float*)(p.ws + WS_RSUM);
    const bf16_t* OM = (const bf16_t*)(p.ws + WS_ACT); const bf16_t* UU = OM + (size_t)TC * 1024;
    const int tid = opaque_tid(), wid = tid >> 6, lane = tid & 63;
    constexpr int N_RNN = BPC * 16 * 64;
    unsigned short ra[16], ru[16], ry[16]; float pp[8], hh[8];
#define RNN1_PREFETCH(j_) do { const int seg_ = (j_) & 63, nb_ = ((j_) >> 6) & 15, bl_ = (j_) >> 10; const int ch_ = nb_ * 64 + lane; const unsigned r_ = (unsigned)(bl_ * SEQ + seg_ * 128 + wid * 16); \
        _Pragma("unroll") for (int i_ = 0; i_ < 16; ++i_) { ra[i_] = OM[(r_ + i_) * 1024u + ch_]; ru[i_] = UU[(r_ + i_) * 1024u + ch_]; ry[i_] = z[(size_t)(r_ + i_) * DIN + C_YR + ch_]; } \
        _Pragma("unroll") for (int k_ = 0; k_ < 8; ++k_) { const int s2_ = wid * 8 + k_; pp[k_] = 1.f; hh[k_] = 0.f; \
            if (s2_ < seg_) { const float2 o_ = *(const float2*)(rsum + ((size_t)(bl_ * 64 + s2_) * 1024 + ch_) * 2); pp[k_] = o_.x; hh[k_] = o_.y; } } } while (0)
    int j = blockIdx.x;
    if (j < N_RNN) RNN1_PREFETCH(j);
    for (; j < N_RNN; j += gridDim.x) {
        const int seg = j & 63, nb = (j >> 6) & 15, bl = j >> 10; const int ch = nb * 64 + lane; const unsigned r0 = (unsigned)(bl * SEQ + seg * 128 + wid * 16);
        float a16[16], u16[16], y16[16];
#pragma unroll
        for (int i = 0; i < 16; ++i) { a16[i] = 1.0f - bf2f((unsigned)ra[i]); u16[i] = bf2f((unsigned)ru[i]); y16[i] = bf2f((unsigned)ry[i]); }
        { float Pw = 1.f, Hw = 0.f;
#pragma unroll
          for (int k = 0; k < 8; ++k) { Hw = pp[k] * Hw + hh[k]; Pw *= pp[k]; }
          sC[(wid * 64 + lane) * 2] = Pw; sC[(wid * 64 + lane) * 2 + 1] = Hw; }
        if (j + (int)gridDim.x < N_RNN) RNN1_PREFETCH(j + (int)gridDim.x);
        { float hl = 0.f, Pp = 1.f;
#pragma unroll
          for (int i = 0; i < 16; ++i) { hl = a16[i] * hl + u16[i]; Pp *= a16[i]; }
          sS[(wid * 64 + lane) * 2] = Pp; sS[(wid * 64 + lane) * 2 + 1] = hl; }
        __syncthreads();
        float h = 0.f;
#pragma unroll
        for (int w = 0; w < 8; ++w) h = sC[(w * 64 + lane) * 2] * h + sC[(w * 64 + lane) * 2 + 1];
        for (int w = 0; w < wid; ++w) h = sS[(w * 64 + lane) * 2] * h + sS[(w * 64 + lane) * 2 + 1];
#pragma unroll 4
        for (int i = 0; i < 16; ++i) { h = a16[i] * h + u16[i];
            z[(size_t)(r0 + i) * DIN + C_YR + ch] = f2bf(h * gelu_tanh(y16[i])); }
        __syncthreads();
    }
#undef RNN1_PREFETCH
}

__device__ __forceinline__ void swa_item(const P& p, int l, LAS unsigned char* lds, bf16_t* z, int bl, int kvh, int qb, float Mb) {
    LAS bf16_t* sK = (LAS bf16_t*)lds;
    LAS bf16_t* sVt = sK + 256 * 72;
    LAS float* sBA = (LAS float*)(lds + 70656);
    const float* biasA = (const float*)(p.ws + WS_BIASA);
    const int tid = opaque_tid(), wid = tid >> 6, lane = tid & 63, fr = lane & 15, fq = lane >> 4;
    const size_t rq0 = (size_t)bl * SEQ + (size_t)qb * 128;
    bf16x8 q[2][4];
#pragma unroll
    for (int i = 0; i < 2; ++i) { const int tile = wid + 8 * i, g = tile >> 2, q0 = (tile & 3) * 32;
        const bf16_t* qp = z + (rq0 + q0 + fr) * DIN + C_QA + (kvh * 4 + g) * 64 + fq * 8;
        q[i][0] = *(const bf16x8*)qp; q[i][1] = *(const bf16x8*)(qp + 32); q[i][2] = *(const bf16x8*)(qp + (size_t)16 * DIN); q[i][3] = *(const bf16x8*)(qp + (size_t)16 * DIN + 32); }
    for (int i = tid; i < 256 * 8; i += NTHREADS) { const int sj = i >> 3, c8 = (i & 7) * 8; const int tk = (qb - 1) * 128 + sj;
        u32x4 kv = (u32x4){0u, 0u, 0u, 0u}, vv = (u32x4){0u, 0u, 0u, 0u};
        if (tk >= 0) { const bf16_t* rowp = z + ((size_t)bl * SEQ + tk) * DIN; kv = *(const u32x4*)(rowp + C_KA + kvh * 64 + c8); vv = *(const u32x4*)(rowp + C_VA + kvh * 64 + c8); }
        *(LAS u32x4*)(sK + sj * 72 + c8) = kv;
#pragma unroll
        for (int j = 0; j < 4; ++j) { sVt[(c8 + 2 * j) * 264 + sj] = (bf16_t)(vv[j] & 0xffffu); sVt[(c8 + 2 * j + 1) * 264 + sj] = (bf16_t)(vv[j] >> 16); } }
    for (int i = tid; i < 4 * 384; i += NTHREADS) { const int g = i / 384, diff = i - g * 384 - 128; const int hq = kvh * 4 + g;
        const float Mh = fmaxf(Mb, p.sinks[l * 8 + hq]);
        sBA[i] = (diff >= 0 && diff < 128) ? (biasA[hq * 128 + diff] - Mh) * 1.4426950408889634f : -1.0e30f; }
    __syncthreads();
#pragma unroll
    for (int i = 0; i < 2; ++i) { const int tile = wid + 8 * i, g = tile >> 2, q0 = (tile & 3) * 32; const int hq = kvh * 4 + g;
        const LAS float* pbA = sBA + g * 384 + 128 + (q0 + fr + 128 - 4 * fq - 255); const LAS float* pbB = pbA + 16;
        float lsA = 0.f, lsB = 0.f;
        f32x4 oA[4], oB[4];
#pragma unroll
        for (int nd = 0; nd < 4; ++nd) { oA[nd] = (f32x4){0.f, 0.f, 0.f, 0.f}; oB[nd] = (f32x4){0.f, 0.f, 0.f, 0.f}; }
        int kq0 = (q0 + 1) >> 6; const int kq1 = ((q0 + 159) >> 6) + 1;
        if (qb == 0 && kq0 < 2) kq0 = 2;
        for (int kq = kq0; kq < kq1; ++kq) {
            unsigned pkA[4][2], pkB[4][2];
            const LAS float* pa = pbA - kq * 64; const LAS float* pb = pbB - kq * 64;
#pragma unroll
            for (int nt = 0; nt < 4; ++nt) {
                const LAS bf16_t* kp = sK + (kq * 64 + nt * 16 + fr) * 72 + fq * 8;
                const bf16x8 k0 = *(const LAS bf16x8*)kp, k1 = *(const LAS bf16x8*)(kp + 32);
                f32x4 aA = (f32x4){0.f, 0.f, 0.f, 0.f}, aB = (f32x4){0.f, 0.f, 0.f, 0.f};
                aA = mfma16(k0, q[i][0], aA); aB = mfma16(k0, q[i][2], aB); aA = mfma16(k1, q[i][1], aA); aB = mfma16(k1, q[i][3], aB);
                float pjA[4], pjB[4];
#pragma unroll
                for (int j = 0; j < 4; ++j) {
                    const float pvA = __builtin_amdgcn_exp2f(aA[j] * 0.18033688011112042f + pa[255 - nt * 16 - j]), pvB = __builtin_amdgcn_exp2f(aB[j] * 0.18033688011112042f + pb[255 - nt * 16 - j]);
                    lsA += pvA; lsB += pvB; pjA[j] = pvA; pjB[j] = pvB; }
                pkA[nt][0] = cvt_pk_bf16(pjA[0], pjA[1]); pkA[nt][1] = cvt_pk_bf16(pjA[2], pjA[3]);
                pkB[nt][0] = cvt_pk_bf16(pjB[0], pjB[1]); pkB[nt][1] = cvt_pk_bf16(pjB[2], pjB[3]); }
#pragma unroll
            for (int tt = 0; tt < 2; ++tt) {
                u32x4 bwA, bwB; bwA[0] = pkA[2 * tt][0]; bwA[1] = pkA[2 * tt][1]; bwA[2] = pkA[2 * tt + 1][0]; bwA[3] = pkA[2 * tt + 1][1];
                bwB[0] = pkB[2 * tt][0]; bwB[1] = pkB[2 * tt][1]; bwB[2] = pkB[2 * tt + 1][0]; bwB[3] = pkB[2 * tt + 1][1];
                const bf16x8 bfA = __builtin_bit_cast(bf16x8, bwA), bfB = __builtin_bit_cast(bf16x8, bwB);
#pragma unroll
                for (int nd = 0; nd < 4; ++nd) { const LAS bf16_t* vp = sVt + (nd * 16 + fr) * 264 + kq * 64 + 32 * tt + 4 * fq;
                    const u32x2 lo = *(const LAS u32x2*)vp, hi = *(const LAS u32x2*)(vp + 16);
                    u32x4 aw; aw[0] = lo[0]; aw[1] = lo[1]; aw[2] = hi[0]; aw[3] = hi[1];
                    const bf16x8 vf = __builtin_bit_cast(bf16x8, aw);
                    oA[nd] = mfma16(vf, bfA, oA[nd]); oB[nd] = mfma16(vf, bfB, oB[nd]); } }
        }
        lsA += __shfl_xor(lsA, 16); lsA += __shfl_xor(lsA, 32); lsB += __shfl_xor(lsB, 16); lsB += __shfl_xor(lsB, 32);
        const float sinkv = p.sinks[l * 8 + hq]; const float es = __expf(sinkv - fmaxf(Mb, sinkv));
        const float invA = 1.0f / (lsA + es), invB = 1.0f / (lsB + es);
        bf16_t* opA = z + (rq0 + q0 + fr) * DIN + C_QA + hq * 64 + 4 * fq; bf16_t* opB = opA + (size_t)16 * DIN;
#pragma unroll
        for (int nd = 0; nd < 4; ++nd) { u32x2 pa2, pb2; pa2[0] = cvt_pk_bf16(oA[nd][0] * invA, oA[nd][1] * invA); pa2[1] = cvt_pk_bf16(oA[nd][2] * invA, oA[nd][3] * invA);
            pb2[0] = cvt_pk_bf16(oB[nd][0] * invB, oB[nd][1] * invB); pb2[1] = cvt_pk_bf16(oB[nd][2] * invB, oB[nd][3] * invB);
            *(u32x2*)(opA + nd * 16) = pa2; *(u32x2*)(opB + nd * 16) = pb2; }
    }
    __syncthreads();
}

constexpr int N_MSUB = 52;
__device__ const unsigned short MOBA_SUB[N_MSUB] = {269, 270, 271, 517, 549, 272, 518, 550, 770, 802, 834, 273, 519, 551, 1024, 1056, 1088, 1120, 274, 771, 803, 835, 520, 552, 275, 1025, 1057, 1089, 1121, 521, 553, 276, 772, 804, 836, 522, 554, 277, 523, 555, 278, 524, 556, 279, 280, 281, 282, 283, 284, 285, 286, 287};
__device__ __forceinline__ void moba_gate_item(const P& p, LAS unsigned char* lds, const bf16_t* z, int bl, int h, int n) {
    LAS float* sKm = (LAS float*)lds;
    LAS int* sCnt = (LAS int*)(lds + 8192);
    int* CNT = (int*)(p.ws + WS_MCNT) + (bl * 8 + h) * 32;
    unsigned* LIST = (unsigned*)(p.ws + WS_MLIST) + (size_t)(bl * 8 + h) * 32 * LCAP;
    const float* kmean = (const float*)(p.ws + WS_KMEAN) + (size_t)(bl * 8 + h) * 32 * 64;
    const int tid = opaque_tid();
    if (tid < 64) sCnt[tid] = 0;
    for (int i = tid; i < n * 64; i += NTHREADS) sKm[i] = kmean[i];
    __syncthreads();
    int s0 = -1, s1 = -1, s2 = -1, p0 = 0, p1 = 0, p2 = 0;
    if (tid < 256) {
        float qv[64];
        const bf16_t* qp = z + ((size_t)bl * SEQ + (size_t)n * 256 + tid) * DIN + C_QC + h * 64;
#pragma unroll
        for (int c = 0; c < 8; ++c) { const u32x4 raw = *(const u32x4*)(qp + c * 8); unpack8(raw, qv + c * 8); }
        float v0 = -3.0e38f, v1 = -3.0e38f, v2 = -3.0e38f;
        for (int m = 0; m < n; ++m) { float g = 0.f;
#pragma unroll
            for (int d = 0; d < 64; ++d) g += qv[d] * sKm[m * 64 + d];
            if (g > v0) { v2 = v1; s2 = s1; v1 = v0; s1 = s0; v0 = g; s0 = m; }
            else if (g > v1) { v2 = v1; s2 = s1; v1 = g; s1 = m; }
            else if (g > v2) { v2 = g; s2 = m; } }
        if (s0 >= 0) p0 = atomicAdd((int*)(sCnt + s0), 1);
        if (s1 >= 0) p1 = atomicAdd((int*)(sCnt + s1), 1);
        if (s2 >= 0) p2 = atomicAdd((int*)(sCnt + s2), 1);
    }
    __syncthreads();
    if (tid < n) { const int c = sCnt[tid]; sCnt[32 + tid] = (c > 0) ? atomicAdd(CNT + tid, c) : 0; }
    __syncthreads();
    if (tid < 256) { const unsigned qpos = (unsigned)(n * 256 + tid);
        if (s0 >= 0) LIST[(size_t)s0 * LCAP + sCnt[32 + s0] + p0] = qpos;
        if (s1 >= 0) LIST[(size_t)s1 * LCAP + sCnt[32 + s1] + p1] = qpos | (1u << 16);
        if (s2 >= 0) LIST[(size_t)s2 * LCAP + sCnt[32 + s2] + p2] = qpos | (2u << 16); }
    __syncthreads();
}

template <bool OWN>
__device__ __forceinline__ void moba_tile(unsigned ecA, unsigned ecB, bool vA, bool vB, bf16x8 qA0, bf16x8 qA1, bf16x8 qB0, bf16x8 qB1, int kqn, int m, int bl, int h, float cb,
                                          const LAS bf16_t* sK, const LAS bf16_t* sVt, const LAS float* sB2, bf16_t* PART, float* LSUM, int fr, int fq) {
    const int qposA = (int)(ecA & 0xffffu), slotA = (int)(ecA >> 16), qposB = (int)(ecB & 0xffffu), slotB = (int)(ecB >> 16);
    const int dqfA = qposA - m * 256 - 4 * fq, dqfB = qposB - m * 256 - 4 * fq;
    const bool farb = !OWN && (__all(dqfA + 4 * fq - 255 >= 1513 && dqfB + 4 * fq - 255 >= 1513) != 0);
    const LAS float* pbA = sB2 + (272 + dqfA - 255); const LAS float* pbB = sB2 + (272 + dqfB - 255);
    float lsA = 0.f, lsB = 0.f;
    f32x4 oA[4], oB[4];
#pragma unroll
    for (int nd = 0; nd < 4; ++nd) { oA[nd] = (f32x4){0.f, 0.f, 0.f, 0.f}; oB[nd] = (f32x4){0.f, 0.f, 0.f, 0.f}; }
    for (int kq = 0; kq < kqn; ++kq) {
        unsigned pkA[4][2], pkB[4][2];
        const LAS float* pa = pbA - kq * 64; const LAS float* pb = pbB - kq * 64;
#pragma unroll
        for (int nt = 0; nt < 4; ++nt) {
            const LAS bf16_t* kp = sK + (kq * 64 + nt * 16 + fr) * 72 + fq * 8;
            const bf16x8 k0 = *(const LAS bf16x8*)kp, k1 = *(const LAS bf16x8*)(kp + 32);
            f32x4 aA = (f32x4){0.f, 0.f, 0.f, 0.f}, aB = (f32x4){0.f, 0.f, 0.f, 0.f};
            aA = mfma16(k0, qA0, aA); aB = mfma16(k0, qB0, aB); aA = mfma16(k1, qA1, aA); aB = mfma16(k1, qB1, aB);
            float pjA[4], pjB[4];
#pragma unroll
            for (int j = 0; j < 4; ++j) {
                const float b2A = farb ? cb : pa[255 - nt * 16 - j], b2B = farb ? cb : pb[255 - nt * 16 - j];
                float pvA = __builtin_amdgcn_exp2f(aA[j] * 0.18033688011112042f + b2A), pvB = __builtin_amdgcn_exp2f(aB[j] * 0.18033688011112042f + b2B);
                if (OWN) { if (dqfA - (kq * 64 + nt * 16 + j) < 0) pvA = 0.f; if (dqfB - (kq * 64 + nt * 16 + j) < 0) pvB = 0.f; }
                lsA += pvA; lsB += pvB; pjA[j] = pvA; pjB[j] = pvB; }
            pkA[nt][0] = cvt_pk_bf16(pjA[0], pjA[1]); pkA[nt][1] = cvt_pk_bf16(pjA[2], pjA[3]);
            pkB[nt][0] = cvt_pk_bf16(pjB[0], pjB[1]); pkB[nt][1] = cvt_pk_bf16(pjB[2], pjB[3]); }
#pragma unroll
        for (int tt = 0; tt < 2; ++tt) {
            u32x4 bwA, bwB; bwA[0] = pkA[2 * tt][0]; bwA[1] = pkA[2 * tt][1]; bwA[2] = pkA[2 * tt + 1][0]; bwA[3] = pkA[2 * tt + 1][1];
            bwB[0] = pkB[2 * tt][0]; bwB[1] = pkB[2 * tt][1]; bwB[2] = pkB[2 * tt + 1][0]; bwB[3] = pkB[2 * tt + 1][1];
            const bf16x8 bfA = __builtin_bit_cast(bf16x8, bwA), bfB = __builtin_bit_cast(bf16x8, bwB);
#pragma unroll
            for (int nd = 0; nd < 4; ++nd) { const LAS bf16_t* vp = sVt + (nd * 16 + fr) * 264 + kq * 64 + 32 * tt + 4 * fq;
                const u32x2 lo = *(const LAS u32x2*)vp, hi = *(const LAS u32x2*)(vp + 16);
                u32x4 aw; aw[0] = lo[0]; aw[1] = lo[1]; aw[2] = hi[0]; aw[3] = hi[1];
                const bf16x8 vf = __builtin_bit_cast(bf16x8, aw);
                oA[nd] = mfma16(vf, bfA, oA[nd]); oB[nd] = mfma16(vf, bfB, oB[nd]); } }
    }
    lsA += __shfl_xor(lsA, 16); lsA += __shfl_xor(lsA, 32); lsB += __shfl_xor(lsB, 16); lsB += __shfl_xor(lsB, 32);
    if (vA) { const size_t pi = (((size_t)bl * SEQ + qposA) * 8 + h) * 4 + slotA;
        if (fq == 0) LSUM[pi] = lsA;
#pragma unroll
        for (int nd = 0; nd < 4; ++nd) { u32x2 pk2; pk2[0] = cvt_pk_bf16(oA[nd][0], oA[nd][1]); pk2[1] = cvt_pk_bf16(oA[nd][2], oA[nd][3]);
            *(u32x2*)(PART + pi * 64 + nd * 16 + 4 * fq) = pk2; } }
    if (vB) { const size_t pi = (((size_t)bl * SEQ + qposB) * 8 + h) * 4 + slotB;
        if (fq == 0) LSUM[pi] = lsB;
#pragma unroll
        for (int nd = 0; nd < 4; ++nd) { u32x2 pk2; pk2[0] = cvt_pk_bf16(oB[nd][0], oB[nd][1]); pk2[1] = cvt_pk_bf16(oB[nd][2], oB[nd][3]);
            *(u32x2*)(PART + pi * 64 + nd * 16 + 4 * fq) = pk2; } }
}
__device__ __forceinline__ void moba_attn_item(const P& p, LAS unsigned char* lds, const bf16_t* z, int bl, int h, int m, int part, int parts, float M) {
    LAS bf16_t* sK = (LAS bf16_t*)lds;
    LAS bf16_t* sVt = sK + 256 * 72;
    LAS float* sB2 = (LAS float*)(lds + 70656);
    const int tid = opaque_tid(), wid = tid >> 6, lane = tid & 63, fr = lane & 15, fq = lane >> 4;
    const bf16_t* Vtg = (const bf16_t*)(p.ws + WS_VTC) + (size_t)(bl * 8 + h) * 64 * SEQ;
    const float* biasC = (const float*)(p.ws + WS_BIASC) + h * 8192;
    const unsigned* LIST = (const unsigned*)(p.ws + WS_MLIST) + ((size_t)(bl * 8 + h) * 32 + m) * LCAP;
    bf16_t* PART = (bf16_t*)(p.ws + WS_MPART); float* LSUM = (float*)(p.ws + WS_MLSUM);
    const int cnt = ((const int*)(p.ws + WS_MCNT))[(bl * 8 + h) * 32 + m];
    const int ntl = (cnt + 31) >> 5, ntot = ntl + 8;
    const int tlo = (part * ntot) / parts, thi = ((part + 1) * ntot) / parts;
#define MOBA_ENTRY1(ix_, e, v) do { v = (ix_) < cnt; e = LIST[(ix_) < cnt ? (ix_) : (cnt > 0 ? cnt - 1 : 0)]; } while (0)
#define MOBA_ENTRY(t, ea, va, eb, vb) do { if ((t) < ntl) { MOBA_ENTRY1((t) * 32 + fr, ea, va); MOBA_ENTRY1((t) * 32 + 16 + fr, eb, vb); } \
        else { va = vb = (t) < thi; ea = (unsigned)(m * 256 + (((t) - ntl) & 7) * 32 + fr) | (3u << 16); eb = ea + 16u; } } while (0)
#define MOBA_QGATHER(e, a0, a1) do { const bf16_t* qp_ = z + ((size_t)bl * SEQ + ((e) & 0xffffu)) * DIN + C_QC + h * 64 + fq * 8; a0 = *(const bf16x8*)qp_; a1 = *(const bf16x8*)(qp_ + 32); } while (0)
#define MOBA_KQN(t) ((((((t) - ntl) & 7) * 32 + 31) >> 6) + 1)
    int t = tlo + wid;
    unsigned e0a = 0u, e0b = 0u, e1a = 0u, e1b = 0u, e2a = 0u, e2b = 0u; bool v0a = false, v0b = false, v1a = false, v1b = false, v2a = false, v2b = false;
    bf16x8 qa0, qa1, qa2, qa3, qb0, qb1, qb2, qb3, qc0, qc1, qc2, qc3;
    MOBA_ENTRY(t, e0a, v0a, e0b, v0b); MOBA_ENTRY(t + 8, e1a, v1a, e1b, v1b); MOBA_ENTRY(t + 16, e2a, v2a, e2b, v2b);
    MOBA_QGATHER(e0a, qa0, qa1); MOBA_QGATHER(e0b, qa2, qa3); MOBA_QGATHER(e1a, qb0, qb1); MOBA_QGATHER(e1b, qb2, qb3);
    qc0 = qa0; qc1 = qa1; qc2 = qa2; qc3 = qa3;
#pragma unroll
    for (int k = 0; k < 4; ++k) { const int i = tid + k * NTHREADS;
        const u32x4 kv = *(const u32x4*)(z + ((size_t)bl * SEQ + (size_t)m * 256 + (i >> 3)) * DIN + C_KC + h * 64 + (i & 7) * 8);
        const u32x4 vv = *(const u32x4*)(Vtg + (size_t)(i >> 5) * SEQ + m * 256 + (i & 31) * 8);
        *(LAS u32x4*)(sK + (i >> 3) * 72 + (i & 7) * 8) = kv; *(LAS u32x4*)(sVt + (i >> 5) * 264 + (i & 31) * 8) = vv;
    }
    for (int i = tid; i < 8192 + 272; i += NTHREADS) { const int dist = i - 272; sB2[i] = (biasC[dist < 0 ? 0 : dist] - M) * 1.4426950408889634f; }
    __syncthreads();
    const float cb = sB2[272 + 8191];
#define MOBA_RUN(ea, eb, va, vb, q0, q1, q2, q3) do { if (t >= ntl) moba_tile<true>(ea, eb, (va) && t < thi, (vb) && t < thi, q0, q1, q2, q3, MOBA_KQN(t), m, bl, h, cb, sK, sVt, sB2, PART, LSUM, fr, fq); \
        else moba_tile<false>(ea, eb, (va) && t < thi, (vb) && t < thi, q0, q1, q2, q3, 4, m, bl, h, cb, sK, sVt, sB2, PART, LSUM, fr, fq); } while (0)
    for (;;) {
        if (t >= thi) break;
        { const unsigned ca = e0a, cbb = e0b; const bool wa = v0a, wb = v0b; MOBA_QGATHER(e2a, qc0, qc1); MOBA_QGATHER(e2b, qc2, qc3); MOBA_ENTRY(t + 24, e0a, v0a, e0b, v0b);
          MOBA_RUN(ca, cbb, wa, wb, qa0, qa1, qa2, qa3); t += 8; }
        if (t >= thi) break;
        { const unsigned ca = e1a, cbb = e1b; const bool wa = v1a, wb = v1b; MOBA_QGATHER(e0a, qa0, qa1); MOBA_QGATHER(e0b, qa2, qa3); MOBA_ENTRY(t + 24, e1a, v1a, e1b, v1b);
          MOBA_RUN(ca, cbb, wa, wb, qb0, qb1, qb2, qb3); t += 8; }
        if (t >= thi) break;
        { const unsigned ca = e2a, cbb = e2b; const bool wa = v2a, wb = v2b; MOBA_QGATHER(e1a, qb0, qb1); MOBA_QGATHER(e1b, qb2, qb3); MOBA_ENTRY(t + 24, e2a, v2a, e2b, v2b);
          MOBA_RUN(ca, cbb, wa, wb, qc0, qc1, qc2, qc3); t += 8; }
    }
#undef MOBA_ENTRY1
#undef MOBA_ENTRY
#undef MOBA_QGATHER
#undef MOBA_KQN
#undef MOBA_RUN
    __syncthreads();
}

__device__ __forceinline__ void phase_moba_combine(const P& p, bf16_t* z) {
    const bf16_t* PART = (const bf16_t*)(p.ws + WS_MPART); const float* LSUM = (const float*)(p.ws + WS_MLSUM);
    const int tid = opaque_tid(), wid = tid >> 6, lane = tid & 63, h = lane >> 3, d8 = (lane & 7) * 8;
    for (int r0 = (blockIdx.x * 8 + wid) * 2; r0 < TC; r0 += gridDim.x * 8 * 2) {
#pragma unroll
        for (int q = 0; q < 2; ++q) { const int r = r0 + q; const int n = (r % SEQ) >> 8; const int nsel = n < 3 ? n : 3;
            const size_t pi = ((size_t)r * 8 + h) * 4;
            float acc[8], lt = LSUM[pi + 3];
            unpack8(*(const u32x4*)(PART + (pi + 3) * 64 + d8), acc);
#pragma unroll
            for (int k = 0; k < 3; ++k) if (k < nsel) { float f[8]; unpack8(*(const u32x4*)(PART + (pi + k) * 64 + d8), f); lt += LSUM[pi + k];
#pragma unroll
                for (int j = 0; j < 8; ++j) acc[j] += f[j]; }
            const float inv = 1.0f / lt; u32x4 pk;
#pragma unroll
            for (int j = 0; j < 4; ++j) pk[j] = cvt_pk_bf16(acc[2 * j] * inv, acc[2 * j + 1] * inv);
            *(u32x4*)(z + (size_t)r * DIN + C_QC + h * 64 + d8) = pk; }
    }
}

__device__ __forceinline__ void phase_act(const P& p, int l, const bf16_t* u, bf16_t* act) {
    const int tid = opaque_tid();
    if (tid >= DFF / 8) return;
    const int c0 = tid * 8;
    float wg[3][8], wv[3][8], bg[8], bv[8];
#pragma unroll
    for (int k = 0; k < 3; ++k)
#pragma unroll
        for (int j = 0; j < 8; ++j) { wg[k][j] = p.ffn_conv_w[(size_t)(l * 3 + k) * DFF2 + c0 + j]; wv[k][j] = p.ffn_conv_w[(size_t)(l * 3 + k) * DFF2 + DFF + c0 + j]; }
#pragma unroll
    for (int j = 0; j < 8; ++j) { bg[j] = p.ffn_conv_b[(size_t)l * DFF2 + c0 + j]; bv[j] = p.ffn_conv_b[(size_t)l * DFF2 + DFF + c0 + j]; }
    for (int item = blockIdx.x; item < TC / 64; item += gridDim.x) {
        const int r0 = item * 64;
        float g1[8], g2[8], v1[8], v2[8];
        if ((r0 % SEQ) == 0) {
#pragma unroll
            for (int j = 0; j < 8; ++j) { g1[j] = 0.f; g2[j] = 0.f; v1[j] = 0.f; v2[j] = 0.f; }
        } else {
            unpack8(*(const u32x4*)(u + (size_t)(r0 - 1) * DFF2 + c0), g1); unpack8(*(const u32x4*)(u + (size_t)(r0 - 2) * DFF2 + c0), g2);
            unpack8(*(const u32x4*)(u + (size_t)(r0 - 1) * DFF2 + DFF + c0), v1); unpack8(*(const u32x4*)(u + (size_t)(r0 - 2) * DFF2 + DFF + c0), v2);
        }
        for (int i0 = 0; i0 < 64; i0 += 8) {
            u32x4 rg[8], rv[8];
#pragma unroll
            for (int i = 0; i < 8; ++i) { const size_t r = (size_t)(r0 + i0 + i); rg[i] = *(const u32x4*)(u + r * DFF2 + c0); rv[i] = *(const u32x4*)(u + r * DFF2 + DFF + c0); }
#pragma unroll
            for (int i = 0; i < 8; ++i) { const size_t r = (size_t)(r0 + i0 + i);
                float g0[8], v0[8]; unpack8(rg[i], g0); unpack8(rv[i], v0);
                float o[8];
#pragma unroll
                for (int j = 0; j < 8; ++j) { const float cgv = bg[j] + wg[0][j] * g2[j] + wg[1][j] * g1[j] + wg[2][j] * g0[j]; const float cvv = bv[j] + wv[0][j] * v2[j] + wv[1][j] * v1[j] + wv[2][j] * v0[j];
                    o[j] = (cgv * __builtin_amdgcn_rcpf(1.0f + __expf(-cgv))) * cvv; g2[j] = g1[j]; g1[j] = g0[j]; v2[j] = v1[j]; v1[j] = v0[j]; }
                u32x4 pk;
#pragma unroll
                for (int j = 0; j < 4; ++j) pk[j] = pack2(o[2 * j], o[2 * j + 1]);
                *(u32x4*)(act + r * DFF + c0) = pk; }
        }
    }
}

#ifndef PHASE_MASK
#define PHASE_MASK 0xFFFFF
#endif
#define PH(k) ((PHASE_MASK >> (k)) & 1)
#ifndef REP_GRP
#define REP_GRP 0
#endif
#ifndef REP_P2
#define REP_P2 0
#endif
#ifndef REP_P8
#define REP_P8 0
#endif
#ifndef REP_MISC
#define REP_MISC 0
#endif
#ifndef DRY_MOBA
#define DRY_MOBA 0
#endif
#ifndef DRY_SWA
#define DRY_SWA 0
#endif
#ifndef DRY_RNN
#define DRY_RNN 0
#endif

#define XB_TMO      128
#define XB_XCNT(j)  (256  + 64 * (j))
#define XB_XSUB(j)  (1280 + 64 * (j))
#define XB_XGEN(j)  (2304 + 64 * (j))
#define XB_TOP      3328
#define XB_TOPGEN   3392
#define XCD_BAR_WORDS 3456
#define XB_SPIN_CAP (1u << 18)
__device__ __forceinline__ unsigned xb_ld(unsigned* p)              { return __hip_atomic_load(p, __ATOMIC_RELAXED, __HIP_MEMORY_SCOPE_AGENT); }
__device__ __forceinline__ unsigned xb_add(unsigned* p, unsigned v) { return __hip_atomic_fetch_add(p, v, __ATOMIC_RELAXED, __HIP_MEMORY_SCOPE_AGENT); }
__device__ __forceinline__ unsigned xb_xcc_id() { return (unsigned)__builtin_amdgcn_s_getreg((3 << 11) | 20) & 0xFu; }
#define XB_SPIN(cond, bar) do { unsigned _sp = 0; while (cond) { __builtin_amdgcn_s_sleep(1); \
    if ((++_sp & 255u) == 0u) { if (xb_ld(&(bar)[XB_TMO])) break; if (_sp > XB_SPIN_CAP) { atomicAdd(&(bar)[XB_TMO], 1u); break; } } } } while (0)
struct XcdBarrier { unsigned* bar; unsigned x; volatile LAS unsigned* st; };
__device__ __forceinline__ XcdBarrier xcd_barrier_post(unsigned* bar, volatile LAS unsigned* st) {
    XcdBarrier b; b.bar = bar; b.x = xb_xcc_id(); b.st = st;
    if (threadIdx.x == 0) (void)xb_add(&bar[XB_XCNT(b.x)], 1u);
    return b;
}
__device__ __forceinline__ void xcd_barrier_complete(unsigned* bar, unsigned x, unsigned& nloc, unsigned& nx) {
    const unsigned G = gridDim.x * gridDim.y * gridDim.z;
    unsigned sum, cnt, mine, sp = 0u;
    for (;;) {
        sum = 0u; cnt = 0u; mine = 0u;
#pragma unroll
        for (unsigned j = 0; j < 16; ++j) { const unsigned c = xb_ld(&bar[XB_XCNT(j)]); sum += c; cnt += (c > 0u) ? 1u : 0u; mine = (j == x) ? c : mine; }
        if (sum == G) break;
        __builtin_amdgcn_s_sleep(1);
        if ((++sp & 255u) == 0u) { if (xb_ld(&bar[XB_TMO])) break; if (sp > XB_SPIN_CAP) { atomicAdd(&bar[XB_TMO], 1u); break; } }
    }
    nloc = mine > 0u ? mine : 1u; nx = cnt > 0u ? cnt : 1u;
}
__device__ __forceinline__ void xcd_barrier(const XcdBarrier& b) {
    asm volatile("s_waitcnt vmcnt(0)" ::: "memory");
    __syncthreads();
    if (opaque_tid() == 0) {
        unsigned* bar = b.bar;
        __builtin_amdgcn_s_waitcnt(0);
        unsigned nloc = b.st[0], nx = b.st[1];
        if (nloc == 0u) { xcd_barrier_complete(bar, b.x, nloc, nx); b.st[0] = nloc; b.st[1] = nx; }
        const unsigned old = xb_add(&bar[XB_XSUB(b.x)], 1u);
        const unsigned gen = old / nloc;
        if (old + 1u == (gen + 1u) * nloc) {
            __builtin_amdgcn_fence(__ATOMIC_RELEASE, "agent");
            asm volatile("s_waitcnt vmcnt(0)" ::: "memory");
            const unsigned og = xb_add(&bar[XB_TOP], 1u);
            const unsigned tg = og / nx;
            if (og + 1u == (tg + 1u) * nx) xb_add(&bar[XB_TOPGEN], 1u);
            else XB_SPIN(xb_ld(&bar[XB_TOPGEN]) == tg, bar);
            __builtin_amdgcn_fence(__ATOMIC_ACQUIRE, "agent");
            xb_add(&bar[XB_XGEN(b.x)], 1u);
            asm volatile("s_waitcnt vmcnt(0)" ::: "memory");
        } else {
            XB_SPIN(xb_ld(&bar[XB_XGEN(b.x)]) == gen, bar);
            __builtin_amdgcn_fence(__ATOMIC_ACQUIRE, "agent");
            asm volatile("s_waitcnt vmcnt(0)" ::: "memory");
        }
    }
    __syncthreads();
}
#ifndef REP_SYNC
#define REP_SYNC 0
#endif
#define GSYNC() do { for (int _r = 0; _r < 1 + REP_SYNC; ++_r) xcd_barrier(xbar); } while (0)
__global__ void __launch_bounds__(NTHREADS, 2) fwd_megakernel(P p_arg) {
    extern __shared__ __attribute__((aligned(16))) unsigned char lds_raw[];
    LAS unsigned char* lds = (LAS unsigned char*)lds_raw;
    cg::grid_group grid = cg::this_grid();
    const int G = gridDim.x, bx = blockIdx.x;
#define RELOAD const P p = load_params(); const float* mod_l = (const float*)(p.ws + WS_MOD) + (size_t)l * NB * 6144; bf16_t* Hb = (bf16_t*)(p.ws + WS_H); bf16_t* Zb = (bf16_t*)(p.ws + WS_Z); bf16_t* ACTb = (bf16_t*)(p.ws + WS_ACT); \
    const float* xin = ((l == 0) ? p.x : p.out) + (size_t)ch * TC * DM; float* xout = p.out + (size_t)ch * TC * DM; (void)mod_l; (void)Hb; (void)Zb; (void)ACTb; (void)xin; (void)xout;

    { LAS unsigned* st = (LAS unsigned*)(lds + LDS_BYTES - 16); if (threadIdx.x == 0) { st[0] = 0u; st[1] = 0u; } __syncthreads(); }
    const XcdBarrier xbar = xcd_barrier_post((unsigned*)(p_arg.ws + WS_BAR), (volatile LAS unsigned*)(lds + LDS_BYTES - 16));
    if (PH(0)) { const P p = load_params(); phase0(p, lds); }
    grid.sync();

    for (int l = 0; l < DEPTH; ++l) {
        for (int ch = 0; ch < NCHUNK; ++ch) {
            const int b0 = ch * BPC;
            for (int rep3 = 0; rep3 < 1 + REP_MISC; ++rep3) { RELOAD
            if (PH(1)) if (ch == 0) phase_convert(p, l, lds);
            if (PH(2)) phase_norm(xin, p.norm_mix + l * DM, mod_l, 0, 1024, b0, Hb, p.ws + WS_H8); }
            GSYNC();
            for (int rep = 0; rep < 1 + REP_GRP; ++rep) {
            for (int rep2 = 0; rep2 < 1 + REP_P2; ++rep2) {
            if (PH(3)) { RELOAD
              { pg8::SchedPlain S{(const char*)Hb, (const char*)(p.ws + WS_WIN), DM * 2, DM * 2, DM / 64, TC / 256, C_G / 256, G, bx};
                pg8::EpiStoreBf16 E{Zb, DIN, 1 << 30, 1.0f};
                pg8::gemm_phase(lds, S, E); }
              {
                pg8::SchedPlain S{(const char*)(p.ws + WS_H8), (const char*)(p.ws + WS_WG8), DM, DM, DM / 128, TC / 256, (DIN - C_G) / 256, G, bx};
                pg8::EpiStoreBf16 E{Zb + C_G, DIN, 0, 1.0f / 64.0f};
                pg8::gemm_phase<pg8::SchedPlain, pg8::EpiStoreBf16, true>(lds, S, E); } }
            GSYNC();
            }
            { RELOAD
            if (PH(4)) phase_qknorm(p, l, Zb);
            if (PH(5)) phase_kcnorm(p, l, Zb, lds);
            if (bx == 0) { const int t_ = opaque_tid(); if (t_ < BPC * 8 * 32) ((int*)(p.ws + WS_MCNT))[t_] = 0; if (t_ == 0) *((int*)(p.ws + WS_MQ)) = 0; }
            if (PH(6)) phase_rnn0(p, l, lds, Zb); }
            GSYNC();
            { RELOAD
              for (int it = bx; it < BPC * 8 * 31; it += G) { const int n = 31 - it / (BPC * 8), h = it & 7, bl = (it >> 3) & 1; moba_gate_item(p, lds, Zb, bl, h, n); } }
            GSYNC();
            { RELOAD constexpr int N_MOBA = BPC * 8 * 32, N_SWA = BPC * 8 * 64, N_RNN = BPC * 16 * 64;
              float biasmax = 0.f, ga = 0.f, gc = 0.f;
              for (int i = 0; i < 32 * 16; ++i) biasmax = fmaxf(biasmax, fabsf(p.rel_bias[i]));
              for (int d = 0; d < 64; ++d) { ga = fmaxf(ga, fabsf(p.qnorm_a[l * 64 + d] * p.knorm_a[l * 64 + d])); gc = fmaxf(gc, fabsf(p.qnorm_c[l * 64 + d] * p.knorm_c[l * 64 + d])); }
              const float Mb_a = 8.0f * 1.03f * ga + biasmax, Mb_c = 8.0f * 1.03f * gc + biasmax;
              for (int j = bx; j < BPC * 2 * 64; j += G) { if (PH(8)) { const int qb = j & 63, kvh = (j >> 6) & 1, bl = j >> 7; swa_item(p, l, lds, Zb, bl, kvh, qb, Mb_a); } }
              if (PH(9)) phase_rnn_apply(p, lds, Zb);
              if (PH(7)) {
                  int* qhead = (int*)(p.ws + WS_MQ); LAS int* sQ = (LAS int*)(lds + LDS_BYTES - 32);
                  for (;;) {
                      if (opaque_tid() == 0) *sQ = __hip_atomic_fetch_add(qhead, 1, __ATOMIC_RELAXED, __HIP_MEMORY_SCOPE_AGENT);
                      __syncthreads();
                      const int i = *sQ;
                      __syncthreads();
                      if (i >= N_MSUB * BPC * 8) break;
                      const unsigned sv = MOBA_SUB[i >> 4]; const int h = i & 7, bl = (i >> 3) & 1;
                      moba_attn_item(p, lds, Zb, bl, h, (int)(sv & 31u), (int)((sv >> 5) & 7u), (int)(sv >> 8), Mb_c); } } }
            GSYNC();
            { RELOAD phase_moba_combine(p, Zb); }
            GSYNC();
            }
            if (PH(10)) { RELOAD pg8::SchedMerge S{(const char*)Zb, (const char*)(p.ws + WS_WB), DIN * 2, 2048 * 2, TC / 256, DM / 256, G, bx};
              pg8::EpiMerge E{Zb, Hb};
              pg8::gemm_phase(lds, S, E); }
            GSYNC();
            if (PH(11)) { RELOAD pg8::SchedPlain S{(const char*)Hb, (const char*)(p.ws + WS_WOUT), DM * 2, DM * 2, DM / 64, TC / 256, DM / 256, G, bx};
              pg8::EpiResid E{xin, xout, mod_l + 2048, b0};
              pg8::gemm_phase(lds, S, E); }
            GSYNC();
            for (int rep3 = 0; rep3 < 1 + REP_MISC; ++rep3) if (PH(12)) { RELOAD phase_norm(xout, p.norm_ffn + l * DM, mod_l, 3072, 4096, b0, Hb, nullptr); }
            GSYNC();
            for (int rep2 = 0; rep2 < 1 + REP_P8; ++rep2) {
            if (PH(13)) { RELOAD pg8::SchedPlain S{(const char*)Hb, (const char*)(p.ws + WS_WUP), DM * 2, DM * 2, DM / 64, TC / 256, DFF2 / 256, G, bx};
              pg8::EpiStoreBf16 E{Zb, DFF2, 1 << 30, 1.0f};
              pg8::gemm_phase(lds, S, E); }
            GSYNC();
            }
            for (int rep3 = 0; rep3 < 1 + REP_MISC; ++rep3) if (PH(14)) { RELOAD phase_act(p, l, Zb, ACTb); }
            GSYNC();
            if (PH(15)) { RELOAD pg8::SchedPlain S{(const char*)ACTb, (const char*)(p.ws + WS_WDOWN), DFF * 2, DFF * 2, DFF / 64, TC / 256, DM / 256, G, bx};
              pg8::EpiResid E{xout, xout, mod_l + 5120, b0};
              pg8::gemm_phase(lds, S, E); }
            GSYNC();
        }
    }
}

extern "C" void kernel_launch(void* const* d_in, const int* in_sizes, int n_in, void* d_out, int out_size, void* d_ws, size_t ws_size, hipStream_t stream) {
    static int grid = 0;
    if (grid == 0) {
        if (n_in != 26 || ws_size < WS_END) { fprintf(stderr, "kernel_launch: need 26 inputs and >= %zu bytes of workspace (got %d, %zu)\n", (size_t)WS_END, n_in, ws_size); grid = -1; return; }
        int dev = 0, cus = 0, per_cu = 0;
        (void)hipGetDevice(&dev);
        (void)hipDeviceGetAttribute(&cus, hipDeviceAttributeMultiprocessorCount, dev);
        if (hipFuncSetAttribute((const void*)fwd_megakernel, hipFuncAttributeMaxDynamicSharedMemorySize, LDS_BYTES) != hipSuccess) { fprintf(stderr, "kernel_launch: hipFuncSetAttribute failed\n"); grid = -1; return; }
        if (hipOccupancyMaxActiveBlocksPerMultiprocessor(&per_cu, (const void*)fwd_megakernel, NTHREADS, LDS_BYTES) != hipSuccess || per_cu < 1) { fprintf(stderr, "kernel_launch: occupancy query gives %d\n", per_cu); per_cu = 1; (void)hipGetLastError(); }
        grid = cus * per_cu;
        fprintf(stderr, "kernel_launch: grid %d (cus %d x %d)\n", grid, cus, per_cu);
    }
    if (grid < 0) return;
    P prm{};
    const float** pp = (const float**)&prm;
    for (int i = 0; i < 26; ++i) pp[i] = (const float*)d_in[i];
    prm.out = (float*)d_out; prm.ws = (unsigned char*)d_ws;
    if (hipMemsetAsync((char*)d_ws + WS_BAR, 0, 3456 * 4, stream) != hipSuccess) { fprintf(stderr, "kernel_launch: memset of barrier words failed\n"); return; }
    void* args[] = {&prm};
    hipError_t e = hipLaunchCooperativeKernel((const void*)fwd_megakernel, dim3(grid), dim3(NTHREADS), args, LDS_BYTES, stream);
    if (e != hipSuccess) fprintf(stderr, "kernel_launch: cooperative launch failed: %s (grid %d)\n", hipGetErrorString(e), grid);
}
```

```cpp
#include <hip/hip_runtime.h>
#include <hip/hip_cooperative_groups.h>
#include <cstdio>
#include <cstdint>
namespace cg = cooperative_groups;

#define LAS __attribute__((address_space(3)))
typedef unsigned short bf16_t;
typedef short bf16x8 __attribute__((ext_vector_type(8)));
typedef float f32x4 __attribute__((ext_vector_type(4)));
typedef unsigned u32x4 __attribute__((ext_vector_type(4)));
typedef unsigned u32x2 __attribute__((ext_vector_type(2)));
typedef int i32x8 __attribute__((ext_vector_type(8)));
typedef unsigned u32x8 __attribute__((ext_vector_type(8)));

constexpr int NB = 4, SEQ = 8192, DM = 1024, NTOK = NB * SEQ, DEPTH = 4;
constexpr int DIN = 7424, DFF = 2816, DFF2 = 5632;
constexpr int C_QA = 0, C_KA = 512, C_VA = 640, C_XR = 768, C_YR = 1792, C_QC = 2816, C_KC = 3328, C_VC = 3840, C_G = 4352;
constexpr int NCHUNK = 2, TC = NTOK / NCHUNK, BPC = NB / NCHUNK;
constexpr int NTHREADS = 512;
constexpr int LDS_BYTES = 160 * 1024;
constexpr float RMS_EPS = 1e-6f;

constexpr size_t alup(size_t x) { return (x + 255) & ~(size_t)255; }
constexpr size_t WS_MOD = 0;
constexpr size_t WS_MB = alup(WS_MOD + (size_t)DEPTH * NB * 6144 * 4);
constexpr size_t WS_BIASA = alup(WS_MB + 256);
constexpr size_t WS_BIASC = alup(WS_BIASA + 8 * 128 * 4);
constexpr size_t WS_KMEAN = alup(WS_BIASC + 8 * 8192 * 4);
constexpr size_t WS_RSUM = alup(WS_KMEAN + (size_t)BPC * 8 * 32 * 64 * 4);
constexpr size_t WS_WIN = alup(WS_RSUM + (size_t)BPC * 64 * 1024 * 2 * 4);
constexpr size_t WS_WB = alup(WS_WIN + (size_t)DIN * 1024 * 2);
constexpr size_t WS_WOUT = alup(WS_WB + (size_t)1024 * 2048 * 2);
constexpr size_t WS_WUP = alup(WS_WOUT + (size_t)1024 * 1024 * 2);
constexpr size_t WS_WDOWN = alup(WS_WUP + (size_t)DFF2 * 1024 * 2);
constexpr size_t WS_GT = alup(WS_WDOWN + (size_t)1024 * DFF * 2);
constexpr size_t WS_H = alup(WS_GT + (size_t)2 * 64 * 1024 * 2);
constexpr size_t WS_Z = alup(WS_H + (size_t)TC * 1024 * 2);
constexpr size_t WS_ACT = alup(WS_Z + (size_t)TC * DIN * 2);
constexpr size_t WS_VTC = alup(WS_ACT + (size_t)TC * DFF * 2);
constexpr size_t WS_BAR = alup(WS_VTC + (size_t)BPC * 8 * 64 * SEQ * 2);
constexpr int LCAP = 8192;
constexpr size_t WS_MCNT = alup(WS_BAR + 3456 * 4);
constexpr size_t WS_MQ = alup(WS_MCNT + (size_t)BPC * 8 * 32 * 4);
constexpr size_t WS_MLIST = alup(WS_MQ + 256);
constexpr size_t WS_MPART = alup(WS_MLIST + (size_t)BPC * 8 * 32 * LCAP * 4);
constexpr size_t WS_MLSUM = alup(WS_MPART + (size_t)TC * 8 * 4 * 64 * 2);
constexpr size_t WS_H8 = alup(WS_MLSUM + (size_t)TC * 8 * 4 * 4);
constexpr size_t WS_WG8 = alup(WS_H8 + (size_t)TC * 1024);
constexpr size_t WS_END = alup(WS_WG8 + (size_t)3072 * 1024);

struct P {
    const float *x, *c, *w_mod, *b_mod, *norm_mix, *norm_ffn, *w_in, *qnorm_a, *knorm_a, *sinks, *rnn_conv_w, *rnn_conv_b, *ga_w, *ga_b, *gx_w, *gx_b, *lam,
        *qnorm_c, *knorm_c, *rel_bias, *w_branch, *w_out, *w_up, *ffn_conv_w, *ffn_conv_b, *w_down;
    float* out; unsigned char* ws;
};

__device__ __forceinline__ P load_params() {
#if defined(__HIP_DEVICE_COMPILE__)
    unsigned long long v = (unsigned long long)__builtin_amdgcn_kernarg_segment_ptr(); asm volatile("" : "+s"(v));
    const P __attribute__((address_space(4)))* kp = (const P __attribute__((address_space(4)))*)v;
    return *kp;
#else
    return P{};
#endif
}
__device__ __forceinline__ int opaque_tid() { int t = threadIdx.x; asm volatile("" : "+v"(t)); return t; }
__device__ __forceinline__ float bf2f(unsigned v) { return __uint_as_float(v << 16); }
__device__ __forceinline__ unsigned cvt_pk_bf16(float lo, float hi) { unsigned r; asm volatile("v_cvt_pk_bf16_f32 %0, %1, %2" : "=v"(r) : "v"(lo), "v"(hi)); return r; }
__device__ __forceinline__ bf16_t f2bf(float f) { return (bf16_t)(cvt_pk_bf16(f, 0.0f) & 0xffffu); }
__device__ __forceinline__ unsigned pack2(float lo, float hi) { return cvt_pk_bf16(lo, hi); }
__device__ __forceinline__ void unpack8(const u32x4 v, float* f) {
    f[0] = bf2f(v[0] & 0xffffu); f[1] = bf2f(v[0] >> 16); f[2] = bf2f(v[1] & 0xffffu); f[3] = bf2f(v[1] >> 16);
    f[4] = bf2f(v[2] & 0xffffu); f[5] = bf2f(v[2] >> 16); f[6] = bf2f(v[3] & 0xffffu); f[7] = bf2f(v[3] >> 16);
}
__device__ __forceinline__ f32x4 mfma16(bf16x8 a, bf16x8 b, f32x4 c) { return __builtin_amdgcn_mfma_f32_16x16x32_bf16(a, b, c, 0, 0, 0); }
__device__ __forceinline__ int t5_bucket(int d) {
    if (d < 16) return d;
    const float lr = logf((float)d / 16.0f) / 4.852030263919617f;
    int large = 16 + (int)(lr * 16.0f);
    return large < 31 ? large : 31;
}
__device__ __forceinline__ float gelu_tanh(float y) { const float t = 0.7978845608028654f * (y + 0.044715f * y * y * y);
    return y * __builtin_amdgcn_rcpf(1.0f + __expf(-2.0f * t)); }
__device__ __forceinline__ float log1p_small(float x) { return (x < 0.125f) ? x * (1.0f + x * (-0.5f + x * (0.33333334f + x * (-0.25f + x * (0.2f + x * (-0.16666667f + x * 0.14285715f)))))) : __logf(1.0f + x); }
__device__ __forceinline__ float sigmoidf_(float v) { return 1.0f / (1.0f + __expf(-v)); }

namespace pg8 {
constexpr int BM = 256, BK = 64, HALF = 128, HTB = HALF * BK * 2, STAGE_BYTES = 8 * HTB, NXCD = 8, WGM = 8;
__device__ __forceinline__ int lds_byte(int r, int c) { const int st = (r >> 4) * 2 + (c >> 5), rr = r & 15, cc = c & 31, ob = rr * 64 + cc * 2; return st * 1024 + (ob ^ (((ob >> 9) & 1) << 5)); }
__device__ __forceinline__ void stage_rc(int b, int& R, int& C) { const int st = b / 1024, sb = b % 1024, swz = sb ^ (((sb >> 9) & 1) << 5); R = (st >> 1) * 16 + swz / 64; C = (st & 1) * 32 + (swz % 64) / 2; }
__device__ __forceinline__ int perm32(int rho) { const int n = rho >> 4, i = rho & 15; return 8 * (i >> 2) + 4 * n + (i & 3); }

struct Seg { const char* A; const char* B; int nt, pm, pn, pass; };

__device__ __forceinline__ bool unit_of(int i, int G, int c, int nM, int nN, int& pm, int& pn) {
    const int nwg = nM * nN; const long L = (long)i * G + c; if (L >= nwg) return false;
    int wgid = (int)L; { const int q = nwg / NXCD, r = nwg % NXCD, xcd = wgid % NXCD, off = wgid / NXCD; wgid = (xcd < r ? xcd * (q + 1) : r * (q + 1) + (xcd - r) * q) + off; }
    const int nig = WGM * nN, gid = wgid / nig, fm = gid * WGM, gsz = (nM - fm) < WGM ? (nM - fm) : WGM;
    pm = fm + ((wgid % nig) % gsz); pn = (wgid % nig) / gsz; return true;
}
struct SchedPlain {
    const char* A; const char* B; unsigned lda2, ldb2; int nt, nM, nN, G, c;
    __device__ __forceinline__ bool get(int i, Seg& s) const {
        int pm, pn; if (!unit_of(i, G, c, nM, nN, pm, pn)) return false;
        s.A = A + (size_t)pm * 256 * lda2; s.B = B + (size_t)pn * 256 * ldb2; s.nt = nt; s.pm = pm; s.pn = pn; s.pass = 0; return true;
    }
};
struct SchedMerge {
    const char* z; const char* wb; unsigned lda2, ldb2; int nM, nN, G, c;
    __device__ __forceinline__ bool get(int i, Seg& s) const {
        const int u = i / 3, ps = i - 3 * u; int pm, pn; if (!unit_of(u, G, c, nM, nN, pm, pn)) return false;
        const char* zr = z + (size_t)pm * 256 * (DIN * 2); const char* br = wb + (size_t)pn * 256 * 4096;
        s.pm = pm; s.pn = pn; s.pass = ps;
        if (ps == 0) { s.A = zr + C_QA * 2; s.B = br; s.nt = 8; }
        else if (ps == 1) { s.A = zr + C_YR * 2; s.B = br + 512 * 2; s.nt = 16; }
        else { s.A = zr + C_QC * 2; s.B = br + 1536 * 2; s.nt = 8; }
        return true;
    }
};

struct EpiStoreBf16 {
    static constexpr bool PERM = true;
    bf16_t* O; int ldc; int sig_from; float mul;
    __device__ __forceinline__ bool after(f32x4 (&acc)[2][2][4][2], const Seg& u, int wr, int wc, int fr, int fq) const {
        if (u.pn >= sig_from) {
#pragma unroll
            for (int ai = 0; ai < 2; ++ai)
#pragma unroll
                for (int bj = 0; bj < 2; ++bj)
#pragma unroll
                    for (int m = 0; m < 4; ++m)
#pragma unroll
                        for (int n = 0; n < 2; ++n)
#pragma unroll
                            for (int e = 0; e < 4; ++e) acc[ai][bj][m][n][e] = 1.0f + __builtin_amdgcn_exp2f(-1.4426950408889634f * fmaxf(acc[ai][bj][m][n][e] * mul, -60.0f));
        }
        const unsigned loff = (unsigned)((wr * 64 + fr) * ldc + wc * 32 + 8 * fq) * 2u;
        char* ub = (char*)O + ((size_t)u.pm * BM * ldc + (size_t)u.pn * BM) * 2;
#pragma unroll
        for (int ai = 0; ai < 2; ++ai)
#pragma unroll
            for (int m = 0; m < 4; ++m) { char* rb = ub + (size_t)(ai * HALF + m * 16) * ldc * 2;
#pragma unroll
                for (int bj = 0; bj < 2; ++bj) { const f32x4 v0 = acc[ai][bj][m][0], v1 = acc[ai][bj][m][1];
                    u32x4 pk; pk[0] = cvt_pk_bf16(v0[0], v0[1]); pk[1] = cvt_pk_bf16(v0[2], v0[3]); pk[2] = cvt_pk_bf16(v1[0], v1[1]); pk[3] = cvt_pk_bf16(v1[2], v1[3]);
                    { const unsigned vo = loff + (unsigned)(bj * HALF * 2); asm volatile("global_store_dwordx4 %0, %1, %2 sc1\n\ts_nop 1" :: "v"(vo), "v"(pk), "s"(rb) : "memory"); } } }
        return true;
    }
};
struct EpiResid {
    static constexpr bool PERM = false;
    const float* xin; float* xout; const float* gate; int b0;
    __device__ __forceinline__ bool after(f32x4 (&acc)[2][2][4][2], const Seg& u, int wr, int wc, int fr, int fq) const {
        const unsigned loff = (unsigned)((wr * 64 + fr) * DM + wc * 32 + 4 * fq) * 4u;
        const size_t uo = ((size_t)u.pm * BM * DM + (size_t)u.pn * BM) * 4;
        const char* ib = (const char*)xin + uo; char* ob = (char*)xout + uo;
        const char* gp = (const char*)(gate + (size_t)(b0 + (u.pm * BM) / SEQ) * 6144 + u.pn * BM);
        const unsigned goff = (unsigned)(wc * 32 + 4 * fq) * 4u;
        f32x4 gv[2][2];
#pragma unroll
        for (int bj = 0; bj < 2; ++bj)
#pragma unroll
            for (int n = 0; n < 2; ++n) gv[bj][n] = *(const f32x4*)(gp + goff + (bj * HALF + n * 16) * 4);
#pragma unroll
        for (int ai = 0; ai < 2; ++ai)
#pragma unroll
          for (int mh = 0; mh < 2; ++mh) {
            f32x4 xv[2][2][2];
#pragma unroll
            for (int m2 = 0; m2 < 2; ++m2) { const char* irb = ib + (size_t)(ai * HALF + (mh * 2 + m2) * 16) * DM * 4;
#pragma unroll
                for (int bj = 0; bj < 2; ++bj)
#pragma unroll
                    for (int n = 0; n < 2; ++n) xv[m2][bj][n] = *(const f32x4*)(irb + loff + (bj * HALF + n * 16) * 4); }
            __builtin_amdgcn_sched_barrier(0);
#pragma unroll
            for (int m2 = 0; m2 < 2; ++m2) { char* orb = ob + (size_t)(ai * HALF + (mh * 2 + m2) * 16) * DM * 4;
#pragma unroll
                for (int bj = 0; bj < 2; ++bj)
#pragma unroll
                    for (int n = 0; n < 2; ++n) *(f32x4*)(orb + loff + (bj * HALF + n * 16) * 4) = xv[m2][bj][n] + gv[bj][n] * acc[ai][bj][mh * 2 + m2][n]; }
            __builtin_amdgcn_sched_barrier(0); }
        return true;
    }
};
struct EpiMerge {
    static constexpr bool PERM = true;
    const bf16_t* z; bf16_t* O;
    __device__ __forceinline__ bool after(f32x4 (&acc)[2][2][4][2], const Seg& u, int wr, int wc, int fr, int fq) const {
        const int ps = u.pass;
        const int gA = (ps == 2) ? 2 : ps, gB = (ps == 2) ? 2 : ps + 1;
        const unsigned zoff = (unsigned)((wr * 64 + fr) * DIN + wc * 32 + 8 * fq) * 2u, ooff = (unsigned)((wr * 64 + fr) * DM + wc * 32 + 8 * fq) * 2u;
        const char* zb = (const char*)z + ((size_t)u.pm * BM * DIN + C_G + (size_t)u.pn * BM) * 2;
        const char* zA = zb + (size_t)gA * 2048; const char* zB = zb + (size_t)gB * 2048;
        char* ob = (char*)O + ((size_t)u.pm * BM * DM + (size_t)u.pn * BM) * 2;
#pragma unroll
        for (int ai = 0; ai < 2; ++ai)
#pragma unroll
          for (int mh = 0; mh < 2; ++mh) {
            u32x4 la[2][2], lb[2][2];
#pragma unroll
            for (int m2 = 0; m2 < 2; ++m2) { const size_t rz = (size_t)(ai * HALF + (mh * 2 + m2) * 16) * DIN * 2;
#pragma unroll
                for (int bj = 0; bj < 2; ++bj) { la[m2][bj] = *(const u32x4*)(zA + rz + zoff + bj * HALF * 2); lb[m2][bj] = *(const u32x4*)(zB + rz + zoff + bj * HALF * 2); } }
            __builtin_amdgcn_sched_barrier(0);
#pragma unroll
            for (int m2 = 0; m2 < 2; ++m2) { const int m = mh * 2 + m2; const size_t rO = (size_t)(ai * HALF + m * 16) * DM * 2;
#pragma unroll
                for (int bj = 0; bj < 2; ++bj) {
                    float fa[8], fb[8]; unpack8(la[m2][bj], fa); unpack8(lb[m2][bj], fb);
                    float sc[8];
#pragma unroll
                    for (int e = 0; e < 8; ++e) sc[e] = ((ps == 2) ? 1.0f : fb[e]) * __builtin_amdgcn_rcpf(fa[e]);
                    f32x4 v0 = acc[ai][bj][m][0], v1 = acc[ai][bj][m][1];
                    v0[0] *= sc[0]; v0[1] *= sc[1]; v0[2] *= sc[2]; v0[3] *= sc[3]; v1[0] *= sc[4]; v1[1] *= sc[5]; v1[2] *= sc[6]; v1[3] *= sc[7];
                    acc[ai][bj][m][0] = v0; acc[ai][bj][m][1] = v1;
                    if (ps == 2) { u32x4 pk; pk[0] = cvt_pk_bf16(v0[0], v0[1]); pk[1] = cvt_pk_bf16(v0[2], v0[3]); pk[2] = cvt_pk_bf16(v1[0], v1[1]); pk[3] = cvt_pk_bf16(v1[2], v1[3]);
                        *(u32x4*)(ob + rO + ooff + bj * HALF * 2) = pk; } } }
            __builtin_amdgcn_sched_barrier(0); }
        return ps == 2;
    }
};

template <class Sched, class Epi, bool FP8 = false, bool ALIGN_EPI = true, bool SP2 = true>
__device__ __forceinline__ void gemm_phase(LAS unsigned char* lds, const Sched& S, const Epi& E) {
    const int tid = opaque_tid(), wid = __builtin_amdgcn_readfirstlane(tid >> 6), lane = tid & 63, wr = wid >> 2, wc = wid & 3, fr = lane & 15, fq = lane >> 4;
    const unsigned cla = S.lda2, clb = S.ldb2;
    unsigned RA[2], RB[2];
#pragma unroll
    for (int i = 0; i < 2; ++i) { int R, C; stage_rc(tid * 16 + i * 8192, R, C); const int Rb = Epi::PERM ? ((R & ~31) + perm32(R & 31)) : R;
        RA[i] = (unsigned)R * cla + (unsigned)C * 2u; RB[i] = (unsigned)Rb * clb + (unsigned)C * 2u; }
    const size_t kstep = (size_t)(BK * 2);
    const unsigned ldsw = (unsigned)wid * 1024u;
    unsigned ofs_slot = (unsigned)tid * 16u;
    if constexpr (FP8) { u32x4 o4; o4[0] = RA[0]; o4[1] = RA[1]; o4[2] = RB[0]; o4[3] = RB[1]; *(LAS u32x4*)(lds + STAGE_BYTES + ofs_slot) = o4; asm volatile("" : "+v"(ofs_slot)); }
    const int aoff = lds_byte(wr * 64 + fr, fq * 8), boff = lds_byte(wc * 32 + fr, fq * 8);
#define PG8_SA(b, h) (((b) * 2 + (h)) * HTB)
#define PG8_SB(b, h) ((4 + (b) * 2 + (h)) * HTB)
#define PG8_STG(bufoff, gbase, RR, ld2) do { if constexpr (FP8) {   \
            const u32x4 _o4 = *(const LAS u32x4*)(lds + STAGE_BYTES + ofs_slot); const bool _isB = (&(RR)[0] == &RB[0]); \
            _Pragma("unroll") for (int _i = 0; _i < 2; ++_i) \
            __builtin_amdgcn_global_load_lds((const unsigned*)((const char*)(gbase) + (_isB ? _o4[2 + _i] : _o4[_i])), (LAS unsigned*)(lds + (bufoff) + ldsw + _i * 8192), 16, 0, 0); } \
        else { _Pragma("unroll") for (int _i = 0; _i < 2; ++_i) \
        __builtin_amdgcn_global_load_lds((const unsigned*)((const char*)(gbase) + (RR)[_i]), (LAS unsigned*)(lds + (bufoff) + ldsw + _i * 8192), 16, 0, 0); } } while (0)
#define PG8_LDA(dst, b, h) do { if constexpr (FP8) { _Pragma("unroll") for (int m = 0; m < 4; ++m) { \
            const u32x4 _lo = *(const LAS u32x4*)(lds + PG8_SA(b, h) + aoff + m * 2048), _hi = *(const LAS u32x4*)(lds + PG8_SA(b, h) + aoff + m * 2048 + 1024); \
            dst##_8[m] = __builtin_shufflevector(_lo, _hi, 0, 1, 2, 3, 4, 5, 6, 7); } } \
        else { _Pragma("unroll") for (int m = 0; m < 4; ++m) _Pragma("unroll") for (int k = 0; k < 2; ++k) dst[m][k] = *(const LAS bf16x8*)(lds + PG8_SA(b, h) + aoff + m * 2048 + k * 1024); } } while (0)
#define PG8_LDB(dst, b, h) do { if constexpr (FP8) { _Pragma("unroll") for (int n = 0; n < 2; ++n) { \
            const u32x4 _lo = *(const LAS u32x4*)(lds + PG8_SB(b, h) + boff + n * 2048), _hi = *(const LAS u32x4*)(lds + PG8_SB(b, h) + boff + n * 2048 + 1024); \
            dst##_8[n] = __builtin_shufflevector(_lo, _hi, 0, 1, 2, 3, 4, 5, 6, 7); } } \
        else { _Pragma("unroll") for (int n = 0; n < 2; ++n) _Pragma("unroll") for (int k = 0; k < 2; ++k) dst[n][k] = *(const LAS bf16x8*)(lds + PG8_SB(b, h) + boff + n * 2048 + k * 1024); } } while (0)
#define PG8_MMA(ai, bj, At, Bt) do { __builtin_amdgcn_s_setprio(1); \
        if constexpr (FP8) { _Pragma("unroll") for (int m = 0; m < 4; ++m) _Pragma("unroll") for (int n = 0; n < 2; ++n) \
            acc[ai][bj][m][n] = __builtin_amdgcn_mfma_scale_f32_16x16x128_f8f6f4(__builtin_bit_cast(i32x8, Bt##_8[n]), __builtin_bit_cast(i32x8, At##_8[m]), acc[ai][bj][m][n], 0, 0, 0, 0x7f7f7f7f, 0, 0x7f7f7f7f); } \
        else { _Pragma("unroll") for (int m = 0; m < 4; ++m) _Pragma("unroll") for (int n = 0; n < 2; ++n) _Pragma("unroll") for (int k = 0; k < 2; ++k) \
            acc[ai][bj][m][n] = __builtin_amdgcn_mfma_f32_16x16x32_bf16(Bt[n][k], At[m][k], acc[ai][bj][m][n], 0, 0, 0); } \
        __builtin_amdgcn_s_setprio(0); } while (0)
#define PG8_WAIT_V(n) asm volatile("s_waitcnt vmcnt(" #n ")" ::: "memory")
#define PG8_WAIT_L(n) asm volatile("s_waitcnt lgkmcnt(" #n ")" ::: "memory")
#define PG8_BAR __builtin_amdgcn_s_barrier()
#define PG8_SCHED __builtin_amdgcn_sched_barrier(0)
    Seg cur, nxt; int si = 0;
    if (!S.get(0, cur)) return;
    f32x4 acc[2][2][4][2];
#pragma unroll
    for (int a = 0; a < 2; ++a)
#pragma unroll
        for (int b = 0; b < 2; ++b)
#pragma unroll
            for (int m = 0; m < 4; ++m)
#pragma unroll
                for (int n = 0; n < 2; ++n) acc[a][b][m][n] = (f32x4){0.f, 0.f, 0.f, 0.f};
    bf16x8 At[4][2], B0[2][2], B1[2][2];
    u32x8 At_8[4], B0_8[2], B1_8[2];
    const char* cA = cur.A; const char* cB = cur.B;
    if constexpr (SP2) {
        PG8_STG(PG8_SB(0, 0), cB, RB, clb); PG8_STG(PG8_SB(0, 1), cB + (size_t)HALF * clb, RB, clb); PG8_STG(PG8_SA(0, 0), cA, RA, cla); PG8_STG(PG8_SA(0, 1), cA + (size_t)HALF * cla, RA, cla);
        if (wr == 1) PG8_BAR;
        PG8_WAIT_V(2); PG8_BAR;
        PG8_STG(PG8_SB(1, 0), cB + kstep, RB, clb); PG8_STG(PG8_SA(1, 0), cA + kstep, RA, cla); PG8_STG(PG8_SB(1, 1), cB + (size_t)HALF * clb + kstep, RB, clb);
        PG8_WAIT_V(6); PG8_BAR;
    } else {
    PG8_STG(PG8_SB(0, 0), cB, RB, clb); PG8_STG(PG8_SA(0, 0), cA, RA, cla); PG8_STG(PG8_SB(0, 1), cB + (size_t)HALF * clb, RB, clb); PG8_STG(PG8_SA(0, 1), cA + (size_t)HALF * cla, RA, cla);
    if (wr == 1) PG8_BAR;
    PG8_WAIT_V(4); PG8_BAR;
    PG8_STG(PG8_SB(1, 0), cB + kstep, RB, clb); PG8_STG(PG8_SA(1, 0), cA + kstep, RA, cla); PG8_STG(PG8_SB(1, 1), cB + (size_t)HALF * clb + kstep, RB, clb);
    PG8_WAIT_V(6); PG8_BAR;
    }
    for (;;) {
        const bool has_next = S.get(si + 1, nxt);
        const char* nA = has_next ? nxt.A : cA; const char* nB = has_next ? nxt.B : cB;
        const int nt = cur.nt;
        for (int t = 0; t < nt; t += 2) {
            const bool last = (t == nt - 2);
            const char* a1 = cA + (size_t)(t + 1) * kstep;
            const char* a2 = last ? nA : cA + (size_t)(t + 2) * kstep; const char* b2 = last ? nB : cB + (size_t)(t + 2) * kstep;
            const unsigned la2 = cla, lb2 = clb;
            const char* a3 = a2 + kstep; const char* b3 = b2 + kstep;
            if constexpr (SP2) {
            PG8_LDB(B0, 0, 0); PG8_LDB(B1, 0, 1); PG8_SCHED; PG8_LDA(At, 0, 0); PG8_STG(PG8_SA(1, 1), a1 + (size_t)HALF * cla, RA, cla);
            PG8_WAIT_V(8); PG8_WAIT_L(0); PG8_BAR; PG8_MMA(0, 0, At, B0); PG8_MMA(0, 1, At, B1); PG8_BAR; PG8_SCHED;
            PG8_LDA(At, 0, 1); PG8_STG(PG8_SB(0, 0), b2, RB, lb2); PG8_STG(PG8_SB(0, 1), b2 + (size_t)HALF * lb2, RB, lb2); PG8_STG(PG8_SA(0, 0), a2, RA, la2);
            PG8_WAIT_V(8); PG8_WAIT_L(0); PG8_BAR; PG8_MMA(1, 0, At, B0); PG8_MMA(1, 1, At, B1); PG8_BAR; PG8_SCHED;
            PG8_LDB(B0, 1, 0); PG8_LDB(B1, 1, 1); PG8_SCHED; PG8_LDA(At, 1, 0); PG8_STG(PG8_SA(0, 1), a2 + (size_t)HALF * la2, RA, la2);
            PG8_WAIT_V(8); PG8_WAIT_L(0); PG8_BAR; PG8_MMA(0, 0, At, B0); PG8_MMA(0, 1, At, B1); PG8_BAR; PG8_SCHED;
            PG8_LDA(At, 1, 1); PG8_STG(PG8_SB(1, 0), b3, RB, lb2); PG8_STG(PG8_SB(1, 1), b3 + (size_t)HALF * lb2, RB, lb2); PG8_STG(PG8_SA(1, 0), a3, RA, la2);
            PG8_WAIT_V(8); PG8_WAIT_L(0); PG8_BAR; PG8_MMA(1, 0, At, B0); PG8_MMA(1, 1, At, B1); PG8_BAR; PG8_SCHED;
            } else {
            PG8_LDB(B0, 0, 0); PG8_SCHED; PG8_LDA(At, 0, 0); PG8_STG(PG8_SA(1, 1), a1 + (size_t)HALF * cla, RA, cla);
            PG8_WAIT_L(8); PG8_BAR; PG8_WAIT_L(0); PG8_MMA(0, 0, At, B0); PG8_BAR; PG8_SCHED;
            PG8_LDB(B1, 0, 1); PG8_STG(PG8_SB(0, 0), b2, RB, lb2);
            PG8_BAR; PG8_WAIT_L(0); PG8_MMA(0, 1, At, B1); PG8_BAR;
            PG8_LDA(At, 0, 1); PG8_STG(PG8_SA(0, 0), a2, RA, la2);
            PG8_BAR; PG8_WAIT_L(0); PG8_MMA(1, 0, At, B0); PG8_BAR; PG8_SCHED;
            PG8_STG(PG8_SB(0, 1), b2 + (size_t)HALF * lb2, RB, lb2);
            PG8_WAIT_V(6); PG8_BAR; PG8_MMA(1, 1, At, B1); PG8_BAR;
            PG8_LDB(B0, 1, 0); PG8_SCHED; PG8_LDA(At, 1, 0); PG8_STG(PG8_SA(0, 1), a2 + (size_t)HALF * la2, RA, la2);
            PG8_WAIT_L(8); PG8_BAR; PG8_WAIT_L(0); PG8_MMA(0, 0, At, B0); PG8_BAR; PG8_SCHED;
            PG8_LDB(B1, 1, 1); PG8_STG(PG8_SB(1, 0), b3, RB, lb2);
            PG8_BAR; PG8_WAIT_L(0); PG8_MMA(0, 1, At, B1); PG8_BAR;
            PG8_LDA(At, 1, 1); PG8_STG(PG8_SA(1, 0), a3, RA, la2);
            PG8_BAR; PG8_WAIT_L(0); PG8_MMA(1, 0, At, B0); PG8_BAR; PG8_SCHED;
            PG8_STG(PG8_SB(1, 1), b3 + (size_t)HALF * lb2, RB, lb2);
            PG8_WAIT_V(6); PG8_BAR; PG8_MMA(1, 1, At, B1); PG8_BAR;
            }
        }
        if constexpr (ALIGN_EPI) { if (wr == 0) PG8_BAR; }
        const bool done = E.after(acc, cur, wr, wc, fr, fq);
        if (!has_next) break;
        if (done) {
#pragma unroll
            for (int a = 0; a < 2; ++a)
#pragma unroll
                for (int b = 0; b < 2; ++b)
#pragma unroll
                    for (int m = 0; m < 4; ++m)
#pragma unroll
                        for (int n = 0; n < 2; ++n) acc[a][b][m][n] = (f32x4){0.f, 0.f, 0.f, 0.f};
        }
        cur = nxt; cA = nA; cB = nB; ++si;
        if constexpr (ALIGN_EPI) { if (wr == 1) PG8_BAR; }
    }
    PG8_WAIT_V(0);
    if constexpr (!ALIGN_EPI) { if (wr == 0) PG8_BAR; }
    PG8_BAR;
#undef PG8_SA
#undef PG8_SB
#undef PG8_STG
#undef PG8_LDA
#undef PG8_LDB
#undef PG8_MMA
#undef PG8_WAIT_V
#undef PG8_WAIT_L
#undef PG8_BAR
#undef PG8_SCHED
}
}

__device__ __forceinline__ void phase0(const P& p, LAS unsigned char* lds) {
    float* mod = (float*)(p.ws + WS_MOD);
    LAS float* sc = (LAS float*)lds;
    LAS float* red = sc + 4096;
    const int tid = opaque_tid();
    for (int i = tid; i < 4096; i += NTHREADS) { const float v = p.c[i]; sc[i] = v / (1.0f + __expf(-v)); }
    __syncthreads();
    const int cl = tid & 63, kg = tid >> 6;
    for (int item = blockIdx.x; item < DEPTH * 96; item += gridDim.x) {
        const int l = item / 96, j = (item % 96) * 64 + cl;
        const float* w = p.w_mod + (size_t)l * 1024 * 6144 + j;
        float a0 = 0.f, a1 = 0.f, a2 = 0.f, a3 = 0.f;
#pragma unroll 8
        for (int k = kg * 128; k < kg * 128 + 128; ++k) { const float wv = w[(size_t)k * 6144]; a0 += sc[k] * wv; a1 += sc[1024 + k] * wv; a2 += sc[2048 + k] * wv; a3 += sc[3072 + k] * wv; }
        red[(kg * 64 + cl) * 4 + 0] = a0; red[(kg * 64 + cl) * 4 + 1] = a1; red[(kg * 64 + cl) * 4 + 2] = a2; red[(kg * 64 + cl) * 4 + 3] = a3;
        __syncthreads();
        if (tid < 256) { const int b = tid >> 6, c2 = tid & 63; float s = 0.f;
#pragma unroll
            for (int g = 0; g < 8; ++g) s += red[(g * 64 + c2) * 4 + b];
            const int jj = (item % 96) * 64 + c2; mod[(size_t)(l * 4 + b) * 6144 + jj] = s + p.b_mod[l * 6144 + jj]; }
        __syncthreads();
    }
    float* biasA = (float*)(p.ws + WS_BIASA); float* biasC = (float*)(p.ws + WS_BIASC);
    if (blockIdx.x == 0 && tid < DEPTH) {
        float biasmax = 0.f, ga = 0.f, gc = 0.f;
        for (int i = 0; i < 32 * 16; ++i) biasmax = fmaxf(biasmax, fabsf(p.rel_bias[i]));
        for (int d = 0; d < 64; ++d) { ga = fmaxf(ga, fabsf(p.qnorm_a[tid * 64 + d] * p.knorm_a[tid * 64 + d])); gc = fmaxf(gc, fabsf(p.qnorm_c[tid * 64 + d] * p.knorm_c[tid * 64 + d])); }
        float* mb = (float*)(p.ws + WS_MB); mb[tid * 2] = 8.0f * 1.03f * ga + biasmax; mb[tid * 2 + 1] = 8.0f * 1.03f * gc + biasmax; }
    for (int i = blockIdx.x * NTHREADS + tid; i < 8 * 8192; i += gridDim.x * NTHREADS) { const int h = i >> 13, d = i & 8191; biasC[i] = p.rel_bias[t5_bucket(d) * 16 + 8 + h]; }
    for (int i = blockIdx.x * NTHREADS + tid; i < 8 * 128; i += gridDim.x * NTHREADS) { const int h = i >> 7, d = i & 127; biasA[i] = p.rel_bias[t5_bucket(d) * 16 + h]; }
}

__device__ __forceinline__ void phase_norm(const float* xsrc, const float* gain, const float* mod_l, int shift_off, int scale_off, int b0, bf16_t* H, unsigned char* H8) {
    const int tid = opaque_tid(), wid = tid >> 6, lane = tid & 63;
    constexpr int RPW = TC / (256 * 8);
    const int wglob = blockIdx.x * 8 + wid, nw = gridDim.x * 8;
    for (int r0 = wglob * 4; r0 < TC; r0 += nw * 4) {
        f32x4 v[4][4]; float ss[4];
#pragma unroll
        for (int q = 0; q < 4; ++q) { const f32x4* xr = (const f32x4*)(xsrc + (size_t)(r0 + q) * DM);
#pragma unroll
            for (int i = 0; i < 4; ++i) v[q][i] = xr[lane + 64 * i]; }
#pragma unroll
        for (int q = 0; q < 4; ++q) { float a = 0.f;
#pragma unroll
            for (int i = 0; i < 4; ++i) a += v[q][i][0] * v[q][i][0] + v[q][i][1] * v[q][i][1] + v[q][i][2] * v[q][i][2] + v[q][i][3] * v[q][i][3];
            ss[q] = a; }
#pragma unroll
        for (int off = 32; off >= 1; off >>= 1) {
#pragma unroll
            for (int q = 0; q < 4; ++q) ss[q] += __shfl_xor(ss[q], off); }
        const float* mb = mod_l + (size_t)(b0 + r0 / SEQ) * 6144;
#pragma unroll
        for (int i = 0; i < 4; ++i) { const int col = (lane + 64 * i) * 4;
            const f32x4 g = *(const f32x4*)(gain + col), sc = *(const f32x4*)(mb + scale_off + col), sh = *(const f32x4*)(mb + shift_off + col);
#pragma unroll
            for (int q = 0; q < 4; ++q) { const float rinv = rsqrtf(ss[q] * (1.0f / 1024.0f) + RMS_EPS);
                float h[4];
#pragma unroll
                for (int e = 0; e < 4; ++e) h[e] = (v[q][i][e] * rinv * g[e]) * (1.0f + sc[e]) + sh[e];
                u32x2 pk; pk[0] = cvt_pk_bf16(h[0], h[1]); pk[1] = cvt_pk_bf16(h[2], h[3]);
                *(u32x2*)(H + (size_t)(r0 + q) * DM + col) = pk;
                if (H8) { unsigned p8 = 0u; p8 = __builtin_amdgcn_cvt_pk_fp8_f32(h[0], h[1], p8, false); p8 = __builtin_amdgcn_cvt_pk_fp8_f32(h[2], h[3], p8, true);
                    *(unsigned*)(H8 + (size_t)(r0 + q) * DM + col) = p8; } } }
    }
    (void)RPW;
}

__device__ __forceinline__ void phase_convert(const P& p, int l, LAS unsigned char* lds) {
    LAS float* t = (LAS float*)lds;
    constexpr int NJ = 8;
    const float* srcs[NJ] = { p.w_in + (size_t)l * 1024 * DIN, p.w_branch + (size_t)l * 2048 * 1024, p.w_out + (size_t)l * 1024 * 1024, p.w_up + (size_t)l * 1024 * DFF2,
        p.w_down + (size_t)l * DFF * 1024, p.ga_w + (size_t)l * 1024 * 64, p.gx_w + (size_t)l * 1024 * 64, p.w_in + (size_t)l * 1024 * DIN + C_G };
    const int Ks[NJ] = { 1024, 2048, 1024, 1024, DFF, 1024, 1024, 1024 };
    const int Ns[NJ] = { C_G, 1024, 1024, DFF2, 1024, 64, 64, 3072 };
    const int Ls[NJ] = { DIN, 1024, 1024, DFF2, 1024, 64, 64, DIN };
    const size_t dsts[NJ] = { WS_WIN, WS_WB, WS_WOUT, WS_WUP, WS_WDOWN, WS_GT, WS_GT + (size_t)64 * 1024 * 2, WS_WG8 };
    const int tid = opaque_tid();
    const int r = tid >> 4, c4 = (tid & 15) * 4, n = tid >> 3, kk = (tid & 7) * 8;
    int base = 0;
#pragma unroll
    for (int j = 0; j < NJ; ++j) {
        const int tn = Ns[j] / 64, ntile = (Ks[j] / 64) * tn;
        const float* src = srcs[j]; const int ldn = Ls[j], ldk = Ks[j]; bf16_t* dst = (bf16_t*)(p.ws + dsts[j]);
        int ti = (int)blockIdx.x - (base % (int)gridDim.x); if (ti < 0) ti += gridDim.x;
        f32x4 v0 = (f32x4){0.f, 0.f, 0.f, 0.f}, v1 = v0;
        if (ti < ntile) { const int kt = ti / tn, nn = ti - kt * tn; const float* sp = src + (size_t)(kt * 64 + r) * ldn + nn * 64 + c4; v0 = *(const f32x4*)sp; v1 = *(const f32x4*)(sp + (size_t)32 * ldn); }
        for (; ti < ntile; ti += gridDim.x) {
            const int kt = ti / tn, nn = ti - kt * tn;
            t[r * 65 + c4 + 0] = v0[0]; t[r * 65 + c4 + 1] = v0[1]; t[r * 65 + c4 + 2] = v0[2]; t[r * 65 + c4 + 3] = v0[3];
            t[(r + 32) * 65 + c4 + 0] = v1[0]; t[(r + 32) * 65 + c4 + 1] = v1[1]; t[(r + 32) * 65 + c4 + 2] = v1[2]; t[(r + 32) * 65 + c4 + 3] = v1[3];
            __syncthreads();
            const int tnx = ti + (int)gridDim.x;
            if (tnx < ntile) { const int kt2 = tnx / tn, nn2 = tnx - kt2 * tn; const float* sp = src + (size_t)(kt2 * 64 + r) * ldn + nn2 * 64 + c4; v0 = *(const f32x4*)sp; v1 = *(const f32x4*)(sp + (size_t)32 * ldn); }
            if (j == 7) { u32x2 p8; p8[0] = 0u; p8[1] = 0u;
#pragma unroll
                for (int q = 0; q < 2; ++q) { p8[q] = __builtin_amdgcn_cvt_pk_fp8_f32(t[(kk + 4 * q) * 65 + n] * 64.0f, t[(kk + 4 * q + 1) * 65 + n] * 64.0f, p8[q], false);
                    p8[q] = __builtin_amdgcn_cvt_pk_fp8_f32(t[(kk + 4 * q + 2) * 65 + n] * 64.0f, t[(kk + 4 * q + 3) * 65 + n] * 64.0f, p8[q], true); }
                *(u32x2*)((unsigned char*)dst + (size_t)(nn * 64 + n) * ldk + kt * 64 + kk) = p8; }
            else { u32x4 pk;
#pragma unroll
                for (int q = 0; q < 4; ++q) pk[q] = cvt_pk_bf16(t[(kk + 2 * q) * 65 + n], t[(kk + 2 * q + 1) * 65 + n]);
                *(u32x4*)(dst + (size_t)(nn * 64 + n) * ldk + kt * 64 + kk) = pk; }
            __syncthreads();
        }
        base += ntile;
    }
}

__device__ __forceinline__ void phase_qknorm(const P& p, int l, bf16_t* z) {
    const int tid = opaque_tid(), wid = tid >> 6, lane = tid & 63, g8 = lane & 7;
    float gqa[8], gka[8], gqc[8];
#pragma unroll
    for (int j = 0; j < 8; ++j) { gqa[j] = p.qnorm_a[l * 64 + g8 * 8 + j]; gka[j] = p.knorm_a[l * 64 + g8 * 8 + j]; gqc[j] = p.qnorm_c[l * 64 + g8 * 8 + j]; }
    for (int r0 = (blockIdx.x * 8 + wid) * 4; r0 < TC; r0 += gridDim.x * 8 * 4) {
        u32x4 raw[4][3];
#pragma unroll
        for (int q = 0; q < 4; ++q) { const bf16_t* rowp = z + (size_t)(r0 + q) * DIN;
            raw[q][0] = *(const u32x4*)(rowp + C_QA + lane * 8); raw[q][1] = *(const u32x4*)(rowp + C_KA + (lane & 15) * 8); raw[q][2] = *(const u32x4*)(rowp + C_QC + lane * 8); }
#pragma unroll
        for (int q = 0; q < 4; ++q) { bf16_t* rowp = z + (size_t)(r0 + q) * DIN;
#pragma unroll
            for (int it = 0; it < 3; ++it) {
                const int col = (it == 0) ? C_QA + lane * 8 : (it == 1) ? C_KA + (lane & 15) * 8 : C_QC + lane * 8;
                float f[8]; unpack8(raw[q][it], f);
                float ss = 0.f;
#pragma unroll
                for (int j = 0; j < 8; ++j) ss += f[j] * f[j];
                ss += __shfl_xor(ss, 1); ss += __shfl_xor(ss, 2); ss += __shfl_xor(ss, 4);
                const float rinv = rsqrtf(ss * (1.0f / 64.0f) + RMS_EPS);
                u32x4 pk;
#pragma unroll
                for (int j = 0; j < 4; ++j) { const float g0 = (it == 0) ? gqa[2 * j] : (it == 1) ? gka[2 * j] : gqc[2 * j], g1 = (it == 0) ? gqa[2 * j + 1] : (it == 1) ? gka[2 * j + 1] : gqc[2 * j + 1];
                    pk[j] = cvt_pk_bf16(f[2 * j] * rinv * g0, f[2 * j + 1] * rinv * g1); }
                if (it != 1 || lane < 16) *(u32x4*)(rowp + col) = pk;
            } }
    }
}
__device__ __forceinline__ void phase_kcnorm(const P& p, int l, bf16_t* z, LAS unsigned char* lds) {
    LAS float* red = (LAS float*)lds;
    LAS bf16_t* sT = (LAS bf16_t*)(lds + 16384);
    float* kmean = (float*)(p.ws + WS_KMEAN);
    const int tid = opaque_tid(), g8 = tid & 7, tg = tid >> 3;
    float gk[8];
#pragma unroll
    for (int j = 0; j < 8; ++j) gk[j] = p.knorm_c[l * 64 + g8 * 8 + j];
    for (int item = blockIdx.x; item < BPC * 8 * 32; item += gridDim.x) {
        const int m = item & 31, h = (item >> 5) & 7, bl = item >> 8;
        bf16_t* kbase = z + ((size_t)bl * SEQ + m * 256 + tg) * DIN + C_KC + h * 64 + g8 * 8;
        u32x4 kraw[4], vraw[4];
#pragma unroll
        for (int ps = 0; ps < 4; ++ps) kraw[ps] = *(const u32x4*)(kbase + (size_t)ps * 64 * DIN);
#pragma unroll
        for (int k = 0; k < 4; ++k) { const int i = tid + k * NTHREADS, kj = i >> 3, c8 = (i & 7) * 8;
            vraw[k] = *(const u32x4*)(z + ((size_t)bl * SEQ + m * 256 + kj) * DIN + C_VC + h * 64 + c8); }
        float ms[8];
#pragma unroll
        for (int j = 0; j < 8; ++j) ms[j] = 0.f;
#pragma unroll
        for (int ps = 0; ps < 4; ++ps) {
            float f[8]; unpack8(kraw[ps], f);
            float ss = 0.f;
#pragma unroll
            for (int j = 0; j < 8; ++j) ss += f[j] * f[j];
            ss += __shfl_xor(ss, 1); ss += __shfl_xor(ss, 2); ss += __shfl_xor(ss, 4);
            const float rinv = rsqrtf(ss * (1.0f / 64.0f) + RMS_EPS);
            float y[8];
#pragma unroll
            for (int j = 0; j < 8; ++j) { y[j] = f[j] * rinv * gk[j]; ms[j] += y[j]; }
            u32x4 pk;
#pragma unroll
            for (int j = 0; j < 4; ++j) pk[j] = cvt_pk_bf16(y[2 * j], y[2 * j + 1]);
            *(u32x4*)(kbase + (size_t)ps * 64 * DIN) = pk;
        }
#pragma unroll
        for (int j = 0; j < 8; ++j) red[tg * 64 + g8 * 8 + j] = ms[j];
#pragma unroll
        for (int k = 0; k < 4; ++k) { const int i = tid + k * NTHREADS, kj = i >> 3, c8 = (i & 7) * 8; *(LAS u32x4*)(sT + kj * 72 + c8) = vraw[k]; }
        __syncthreads();
        if (tid < 64) { float sm = 0.f; for (int g = 0; g < 64; ++g) sm += red[g * 64 + tid]; kmean[((size_t)(bl * 8 + h) * 32 + m) * 64 + tid] = sm * (1.0f / 256.0f); }
        {
            bf16_t* Vtg = (bf16_t*)(p.ws + WS_VTC) + (size_t)(bl * 8 + h) * 64 * SEQ;
            const int d = tid >> 3, tgp = tid & 7;
#pragma unroll
            for (int g = 0; g < 4; ++g) { const int t8 = tgp * 32 + g * 8; u32x4 pk;
#pragma unroll
                for (int j = 0; j < 4; ++j) pk[j] = (unsigned)sT[(t8 + 2 * j) * 72 + d] | ((unsigned)sT[(t8 + 2 * j + 1) * 72 + d] << 16);
                *(u32x4*)(Vtg + (size_t)d * SEQ + m * 256 + t8) = pk; }
        }
        __syncthreads();
    }
}

__device__ __forceinline__ void phase_rnn0(const P& p, int l, LAS unsigned char* lds, const bf16_t* z) {
    LAS float* sX = (LAS float*)lds;
    LAS float* sA = sX + 131 * 64 + 64;
    LAS float* sU = sA + 128 * 64;
    LAS float* sS = sU + 128 * 64;
    LAS bf16_t* sXb = (LAS bf16_t*)(sS + 8 * 64 * 2);
    LAS bf16_t* sGt = sXb + 128 * 72;
    float* rsum = (float*)(p.ws + WS_RSUM);
    const bf16_t* Gt = (const bf16_t*)(p.ws + WS_GT);
    bf16_t* OM = (bf16_t*)(p.ws + WS_ACT); bf16_t* UU = OM + (size_t)TC * 1024;
    const int tid = opaque_tid(), wid = tid >> 6, lane = tid & 63, fr = lane & 15, fq = lane >> 4;
    const int nbg = (int)gridDim.x >> 4;
    const int nb = blockIdx.x & 15, first = (int)blockIdx.x >> 4;
    if (first >= nbg) return;
    for (int i = tid; i < 2 * 64 * 8; i += NTHREADS) { const int g = i >> 9, d = (i >> 3) & 63, c8 = (i & 7) * 8;
        *(LAS u32x4*)(sGt + (g * 64 + d) * 72 + c8) = *(const u32x4*)(Gt + (size_t)g * 64 * 1024 + (size_t)d * 1024 + nb * 64 + c8); }
    const int ch = nb * 64 + lane;
    const float w0 = p.rnn_conv_w[(size_t)(l * 4 + 0) * 1024 + ch], w1 = p.rnn_conv_w[(size_t)(l * 4 + 1) * 1024 + ch], w2 = p.rnn_conv_w[(size_t)(l * 4 + 2) * 1024 + ch],
                w3 = p.rnn_conv_w[(size_t)(l * 4 + 3) * 1024 + ch], cb = p.rnn_conv_b[l * 1024 + ch];
    float bra[4], bix[4], spv[4];
#pragma unroll
    for (int nt = 0; nt < 4; ++nt) { const int chd = nb * 64 + nt * 16 + fr; bra[nt] = p.ga_b[l * 1024 + chd]; bix[nt] = p.gx_b[l * 1024 + chd];
        const float lamv = p.lam[l * 1024 + chd]; spv[nt] = (lamv > 15.f) ? __expf(-lamv) : log1p_small(__expf(-lamv)); }
    u32x4 xr[3];
#define RNN_PREFETCH(idx_) do { const int bl_ = (idx_) >> 6, t0_ = ((idx_) & 63) * 128; _Pragma("unroll") for (int k_ = 0; k_ < 3; ++k_) { const int i_ = tid + k_ * NTHREADS; const int rr_ = i_ >> 3, c8_ = (i_ & 7) * 8, t_ = t0_ - 3 + rr_; \
        xr[k_] = (u32x4){0u, 0u, 0u, 0u}; if (i_ < 131 * 8 && t_ >= 0) xr[k_] = *(const u32x4*)(z + ((size_t)bl_ * SEQ + t_) * DIN + C_XR + nb * 64 + c8_); } } while (0)
    RNN_PREFETCH(first);
    for (int idx = first; idx < BPC * 64; idx += nbg) {
        const int bl = idx >> 6, seg = idx & 63, t0 = seg * 128;
#pragma unroll
        for (int k = 0; k < 3; ++k) { const int i = tid + k * NTHREADS; if (i < 131 * 8) { const int rr = i >> 3, c8 = (i & 7) * 8; float f[8]; unpack8(xr[k], f);
            *(LAS f32x4*)(sX + rr * 64 + c8) = (f32x4){f[0], f[1], f[2], f[3]}; *(LAS f32x4*)(sX + rr * 64 + c8 + 4) = (f32x4){f[4], f[5], f[6], f[7]}; } }
        __syncthreads();
        if (idx + nbg < BPC * 64) RNN_PREFETCH(idx + nbg);
#pragma unroll
        for (int i = 0; i < 16; ++i) { const int tt = wid * 16 + i;
            const float xc = cb + w0 * sX[(tt + 0) * 64 + lane] + w1 * sX[(tt + 1) * 64 + lane] + w2 * sX[(tt + 2) * 64 + lane] + w3 * sX[(tt + 3) * 64 + lane];
            sXb[tt * 72 + lane] = f2bf(xc); }
        __syncthreads();
        { bf16x8 a[2];
#pragma unroll
          for (int ks = 0; ks < 2; ++ks) a[ks] = *(const LAS bf16x8*)(sXb + (16 * wid + fr) * 72 + ks * 32 + fq * 8);
#pragma unroll
          for (int nt = 0; nt < 4; ++nt) {
              f32x4 ar = (f32x4){0.f, 0.f, 0.f, 0.f}, ai = (f32x4){0.f, 0.f, 0.f, 0.f};
#pragma unroll
              for (int ks = 0; ks < 2; ++ks) {
                  const bf16x8 br = *(const LAS bf16x8*)(sGt + (nt * 16 + fr) * 72 + ks * 32 + fq * 8);
                  const bf16x8 bi = *(const LAS bf16x8*)(sGt + (64 + nt * 16 + fr) * 72 + ks * 32 + fq * 8);
                  ar = mfma16(a[ks], br, ar); ai = mfma16(a[ks], bi, ai); }
              const int d = nt * 16 + fr;
#pragma unroll
              for (int j = 0; j < 4; ++j) { const int tok = 16 * wid + 4 * fq + j;
                  const float r = __builtin_amdgcn_rcpf(1.0f + __expf(-(ar[j] + bra[nt]))), ig = __builtin_amdgcn_rcpf(1.0f + __expf(-(ai[j] + bix[nt])));
                  const float log_a = -8.0f * r * spv[nt]; const float av = __expf(log_a);
                  const float x2 = 2.0f * log_a;
                  const float om2 = (x2 > -0.25f) ? -x2 * (1.0f + x2 * (0.5f + x2 * (0.16666667f + x2 * (0.041666668f + x2 * (0.0083333338f + x2 * 0.0013888889f))))) : 1.0f - av * av;
                  float mult = __builtin_amdgcn_sqrtf(fmaxf(om2, 0.f));
                  if (t0 + tok == 0) mult = 1.0f;
                  sA[tok * 64 + d] = av; sU[tok * 64 + d] = mult * (ig * bf2f((unsigned)sXb[tok * 72 + d])); }
          } }
        __syncthreads();
        { float hl = 0.f, Pp = 1.f;
          const unsigned go0 = (unsigned)((bl * SEQ + t0 + wid * 16) * 1024 + ch);
#pragma unroll 4
          for (int i = 0; i < 16; ++i) { const int tt = wid * 16 + i;
              const bf16_t omb = f2bf(1.0f - sA[tt * 64 + lane]), ub = f2bf(sU[tt * 64 + lane]);
              const float av = 1.0f - bf2f((unsigned)omb), uv = bf2f((unsigned)ub);
              OM[go0 + (unsigned)i * 1024u] = omb; UU[go0 + (unsigned)i * 1024u] = ub;
              hl = av * hl + uv; Pp *= av; }
          sS[(wid * 64 + lane) * 2] = Pp; sS[(wid * 64 + lane) * 2 + 1] = hl; }
        __syncthreads();
        if (wid == 0) { float Pt = 1.f, Ht = 0.f;
#pragma unroll
            for (int w = 0; w < 8; ++w) { const float Pw = sS[(w * 64 + lane) * 2], Hw = sS[(w * 64 + lane) * 2 + 1]; Ht = Pw * Ht + Hw; Pt *= Pw; }
            float* o = rsum + ((size_t)(bl * 64 + seg) * 1024 + ch) * 2; o[0] = Pt; o[1] = Ht; }
    }
#undef RNN_PREFETCH
    __syncthreads();
}

__device__ __forceinline__ void phase_rnn_apply(const P& p, LAS unsigned char* lds, bf16_t* z) {
    LAS float* sS = (LAS float*)lds;
    LAS float* sC = sS + 8 * 64 * 2;
    const float* rsum = (const float*)(p.ws + WS_RSUM);
    const bf16_t* OM = (const bf16_t*)(p.ws + WS_ACT); const bf16_t* UU = OM + (size_t)TC * 1024;
    const int tid = opaque_tid(), wid = tid >> 6, lane = tid & 63;
    constexpr int N_RNN = BPC * 16 * 64;
    unsigned short ra[16], ru[16], ry[16]; float pp[8], hh[8];
#define RNN1_PREFETCH(j_) do { const int seg_ = (j_) & 63, nb_ = ((j_) >> 6) & 15, bl_ = (j_) >> 10; const int ch_ = nb_ * 64 + lane; const unsigned r_ = (unsigned)(bl_ * SEQ + seg_ * 128 + wid * 16); \
        _Pragma("unroll") for (int i_ = 0; i_ < 16; ++i_) { ra[i_] = OM[(r_ + i_) * 1024u + ch_]; ru[i_] = UU[(r_ + i_) * 1024u + ch_]; ry[i_] = z[(size_t)(r_ + i_) * DIN + C_YR + ch_]; } \
        _Pragma("unroll") for (int k_ = 0; k_ < 8; ++k_) { const int s2_ = wid * 8 + k_; pp[k_] = 1.f; hh[k_] = 0.f; \
            if (s2_ < seg_) { const float2 o_ = *(const float2*)(rsum + ((size_t)(bl_ * 64 + s2_) * 1024 + ch_) * 2); pp[k_] = o_.x; hh[k_] = o_.y; } } } while (0)
    int j = blockIdx.x;
    if (j < N_RNN) RNN1_PREFETCH(j);
    for (; j < N_RNN; j += gridDim.x) {
        const int seg = j & 63, nb = (j >> 6) & 15, bl = j >> 10; const int ch = nb * 64 + lane; const unsigned r0 = (unsigned)(bl * SEQ + seg * 128 + wid * 16);
        float a16[16], u16[16], y16[16];
#pragma unroll
        for (int i = 0; i < 16; ++i) { a16[i] = 1.0f - bf2f((unsigned)ra[i]); u16[i] = bf2f((unsigned)ru[i]); y16[i] = bf2f((unsigned)ry[i]); }
        { float Pw = 1.f, Hw = 0.f;
#pragma unroll
          for (int k = 0; k < 8; ++k) { Hw = pp[k] * Hw + hh[k]; Pw *= pp[k]; }
          sC[(wid * 64 + lane) * 2] = Pw; sC[(wid * 64 + lane) * 2 + 1] = Hw; }
        if (j + (int)gridDim.x < N_RNN) RNN1_PREFETCH(j + (int)gridDim.x);
        { float hl = 0.f, Pp = 1.f;
#pragma unroll
          for (int i = 0; i < 16; ++i) { hl = a16[i] * hl + u16[i]; Pp *= a16[i]; }
          sS[(wid * 64 + lane) * 2] = Pp; sS[(wid * 64 + lane) * 2 + 1] = hl; }
        __syncthreads();
        float h = 0.f;
#pragma unroll
        for (int w = 0; w < 8; ++w) h = sC[(w * 64 + lane) * 2] * h + sC[(w * 64 + lane) * 2 + 1];
        for (int w = 0; w < wid; ++w) h = sS[(w * 64 + lane) * 2] * h + sS[(w * 64 + lane) * 2 + 1];
#pragma unroll 4
        for (int i = 0; i < 16; ++i) { h = a16[i] * h + u16[i];
            z[(size_t)(r0 + i) * DIN + C_YR + ch] = f2bf(h * gelu_tanh(y16[i])); }
        __syncthreads();
    }
#undef RNN1_PREFETCH
}

__device__ __forceinline__ void swa_item(const P& p, int l, LAS unsigned char* lds, bf16_t* z, int bl, int kvh, int qb, float Mb) {
    LAS bf16_t* sK = (LAS bf16_t*)lds;
    LAS bf16_t* sVt = sK + 256 * 72;
    LAS float* sBA = (LAS float*)(lds + 70656);
    const float* biasA = (const float*)(p.ws + WS_BIASA);
    const int tid = opaque_tid(), wid = tid >> 6, lane = tid & 63, fr = lane & 15, fq = lane >> 4;
    const size_t rq0 = (size_t)bl * SEQ + (size_t)qb * 128;
    bf16x8 q[2][4];
#pragma unroll
    for (int i = 0; i < 2; ++i) { const int tile = wid + 8 * i, g = tile >> 2, q0 = (tile & 3) * 32;
        const bf16_t* qp = z + (rq0 + q0 + fr) * DIN + C_QA + (kvh * 4 + g) * 64 + fq * 8;
        q[i][0] = *(const bf16x8*)qp; q[i][1] = *(const bf16x8*)(qp + 32); q[i][2] = *(const bf16x8*)(qp + (size_t)16 * DIN); q[i][3] = *(const bf16x8*)(qp + (size_t)16 * DIN + 32); }
    for (int i = tid; i < 256 * 8; i += NTHREADS) { const int sj = i >> 3, c8 = (i & 7) * 8; const int tk = (qb - 1) * 128 + sj;
        u32x4 kv = (u32x4){0u, 0u, 0u, 0u}, vv = (u32x4){0u, 0u, 0u, 0u};
        if (tk >= 0) { const bf16_t* rowp = z + ((size_t)bl * SEQ + tk) * DIN; kv = *(const u32x4*)(rowp + C_KA + kvh * 64 + c8); vv = *(const u32x4*)(rowp + C_VA + kvh * 64 + c8); }
        *(LAS u32x4*)(sK + sj * 72 + c8) = kv;
#pragma unroll
        for (int j = 0; j < 4; ++j) { sVt[(c8 + 2 * j) * 264 + sj] = (bf16_t)(vv[j] & 0xffffu); sVt[(c8 + 2 * j + 1) * 264 + sj] = (bf16_t)(vv[j] >> 16); } }
    for (int i = tid; i < 4 * 384; i += NTHREADS) { const int g = i / 384, diff = i - g * 384 - 128; const int hq = kvh * 4 + g;
        const float Mh = fmaxf(Mb, p.sinks[l * 8 + hq]);
        sBA[i] = (diff >= 0 && diff < 128) ? (biasA[hq * 128 + diff] - Mh) * 1.4426950408889634f : -1.0e30f; }
    __syncthreads();
#pragma unroll
    for (int i = 0; i < 2; ++i) { const int tile = wid + 8 * i, g = tile >> 2, q0 = (tile & 3) * 32; const int hq = kvh * 4 + g;
        const LAS float* pbA = sBA + g * 384 + 128 + (q0 + fr + 128 - 4 * fq - 255); const LAS float* pbB = pbA + 16;
        float lsA = 0.f, lsB = 0.f;
        f32x4 oA[4], oB[4];
#pragma unroll
        for (int nd = 0; nd < 4; ++nd) { oA[nd] = (f32x4){0.f, 0.f, 0.f, 0.f}; oB[nd] = (f32x4){0.f, 0.f, 0.f, 0.f}; }
        int kq0 = (q0 + 1) >> 6; const int kq1 = ((q0 + 159) >> 6) + 1;
        if (qb == 0 && kq0 < 2) kq0 = 2;
        for (int kq = kq0; kq < kq1; ++kq) {
            unsigned pkA[4][2], pkB[4][2];
            const LAS float* pa = pbA - kq * 64; const LAS float* pb = pbB - kq * 64;
#pragma unroll
            for (int nt = 0; nt < 4; ++nt) {
                const LAS bf16_t* kp = sK + (kq * 64 + nt * 16 + fr) * 72 + fq * 8;
                const bf16x8 k0 = *(const LAS bf16x8*)kp, k1 = *(const LAS bf16x8*)(kp + 32);
                f32x4 aA = (f32x4){0.f, 0.f, 0.f, 0.f}, aB = (f32x4){0.f, 0.f, 0.f, 0.f};
                aA = mfma16(k0, q[i][0], aA); aB = mfma16(k0, q[i][2], aB); aA = mfma16(k1, q[i][1], aA); aB = mfma16(k1, q[i][3], aB);
                float pjA[4], pjB[4];
#pragma unroll
                for (int j = 0; j < 4; ++j) {
                    const float pvA = __builtin_amdgcn_exp2f(aA[j] * 0.18033688011112042f + pa[255 - nt * 16 - j]), pvB = __builtin_amdgcn_exp2f(aB[j] * 0.18033688011112042f + pb[255 - nt * 16 - j]);
                    lsA += pvA; lsB += pvB; pjA[j] = pvA; pjB[j] = pvB; }
                pkA[nt][0] = cvt_pk_bf16(pjA[0], pjA[1]); pkA[nt][1] = cvt_pk_bf16(pjA[2], pjA[3]);
                pkB[nt][0] = cvt_pk_bf16(pjB[0], pjB[1]); pkB[nt][1] = cvt_pk_bf16(pjB[2], pjB[3]); }
#pragma unroll
            for (int tt = 0; tt < 2; ++tt) {
                u32x4 bwA, bwB; bwA[0] = pkA[2 * tt][0]; bwA[1] = pkA[2 * tt][1]; bwA[2] = pkA[2 * tt + 1][0]; bwA[3] = pkA[2 * tt + 1][1];
                bwB[0] = pkB[2 * tt][0]; bwB[1] = pkB[2 * tt][1]; bwB[2] = pkB[2 * tt + 1][0]; bwB[3] = pkB[2 * tt + 1][1];
                const bf16x8 bfA = __builtin_bit_cast(bf16x8, bwA), bfB = __builtin_bit_cast(bf16x8, bwB);
#pragma unroll
                for (int nd = 0; nd < 4; ++nd) { const LAS bf16_t* vp = sVt + (nd * 16 + fr) * 264 + kq * 64 + 32 * tt + 4 * fq;
                    const u32x2 lo = *(const LAS u32x2*)vp, hi = *(const LAS u32x2*)(vp + 16);
                    u32x4 aw; aw[0] = lo[0]; aw[1] = lo[1]; aw[2] = hi[0]; aw[3] = hi[1];
                    const bf16x8 vf = __builtin_bit_cast(bf16x8, aw);
                    oA[nd] = mfma16(vf, bfA, oA[nd]); oB[nd] = mfma16(vf, bfB, oB[nd]); } }
        }
        lsA += __shfl_xor(lsA, 16); lsA += __shfl_xor(lsA, 32); lsB += __shfl_xor(lsB, 16); lsB += __shfl_xor(lsB, 32);
        const float sinkv = p.sinks[l * 8 + hq]; const float es = __expf(sinkv - fmaxf(Mb, sinkv));
        const float invA = 1.0f / (lsA + es), invB = 1.0f / (lsB + es);
        bf16_t* opA = z + (rq0 + q0 + fr) * DIN + C_QA + hq * 64 + 4 * fq; bf16_t* opB = opA + (size_t)16 * DIN;
#pragma unroll
        for (int nd = 0; nd < 4; ++nd) { u32x2 pa2, pb2; pa2[0] = cvt_pk_bf16(oA[nd][0] * invA, oA[nd][1] * invA); pa2[1] = cvt_pk_bf16(oA[nd][2] * invA, oA[nd][3] * invA);
            pb2[0] = cvt_pk_bf16(oB[nd][0] * invB, oB[nd][1] * invB); pb2[1] = cvt_pk_bf16(oB[nd][2] * invB, oB[nd][3] * invB);
            *(u32x2*)(opA + nd * 16) = pa2; *(u32x2*)(opB + nd * 16) = pb2; }
    }
    __syncthreads();
}

constexpr int N_MSUB = 52;
__device__ const unsigned short MOBA_SUB[N_MSUB] = {269, 270, 271, 517, 549, 272, 518, 550, 770, 802, 834, 273, 519, 551, 1024, 1056, 1088, 1120, 274, 771, 803, 835, 520, 552, 275, 1025, 1057, 1089, 1121, 521, 553, 276, 772, 804, 836, 522, 554, 277, 523, 555, 278, 524, 556, 279, 280, 281, 282, 283, 284, 285, 286, 287};
__device__ __forceinline__ void moba_gate_item(const P& p, LAS unsigned char* lds, const bf16_t* z, int bl, int h, int n) {
    LAS float* sKm = (LAS float*)lds;
    LAS int* sCnt = (LAS int*)(lds + 8192);
    int* CNT = (int*)(p.ws + WS_MCNT) + (bl * 8 + h) * 32;
    unsigned* LIST = (unsigned*)(p.ws + WS_MLIST) + (size_t)(bl * 8 + h) * 32 * LCAP;
    const float* kmean = (const float*)(p.ws + WS_KMEAN) + (size_t)(bl * 8 + h) * 32 * 64;
    const int tid = opaque_tid();
    if (tid < 64) sCnt[tid] = 0;
    for (int i = tid; i < n * 64; i += NTHREADS) sKm[i] = kmean[i];
    __syncthreads();
    int s0 = -1, s1 = -1, s2 = -1, p0 = 0, p1 = 0, p2 = 0;
    if (tid < 256) {
        float qv[64];
        const bf16_t* qp = z + ((size_t)bl * SEQ + (size_t)n * 256 + tid) * DIN + C_QC + h * 64;
#pragma unroll
        for (int c = 0; c < 8; ++c) { const u32x4 raw = *(const u32x4*)(qp + c * 8); unpack8(raw, qv + c * 8); }
        float v0 = -3.0e38f, v1 = -3.0e38f, v2 = -3.0e38f;
        for (int m = 0; m < n; ++m) { float g = 0.f;
#pragma unroll
            for (int d = 0; d < 64; ++d) g += qv[d] * sKm[m * 64 + d];
            if (g > v0) { v2 = v1; s2 = s1; v1 = v0; s1 = s0; v0 = g; s0 = m; }
            else if (g > v1) { v2 = v1; s2 = s1; v1 = g; s1 = m; }
            else if (g > v2) { v2 = g; s2 = m; } }
        if (s0 >= 0) p0 = atomicAdd((int*)(sCnt + s0), 1);
        if (s1 >= 0) p1 = atomicAdd((int*)(sCnt + s1), 1);
        if (s2 >= 0) p2 = atomicAdd((int*)(sCnt + s2), 1);
    }
    __syncthreads();
    if (tid < n) { const int c = sCnt[tid]; sCnt[32 + tid] = (c > 0) ? atomicAdd(CNT + tid, c) : 0; }
    __syncthreads();
    if (tid < 256) { const unsigned qpos = (unsigned)(n * 256 + tid);
        if (s0 >= 0) LIST[(size_t)s0 * LCAP + sCnt[32 + s0] + p0] = qpos;
        if (s1 >= 0) LIST[(size_t)s1 * LCAP + sCnt[32 + s1] + p1] = qpos | (1u << 16);
        if (s2 >= 0) LIST[(size_t)s2 * LCAP + sCnt[32 + s2] + p2] = qpos | (2u << 16); }
    __syncthreads();
}

template <bool OWN>
__device__ __forceinline__ void moba_tile(unsigned ecA, unsigned ecB, bool vA, bool vB, bf16x8 qA0, bf16x8 qA1, bf16x8 qB0, bf16x8 qB1, int kqn, int m, int bl, int h, float cb,
                                          const LAS bf16_t* sK, const LAS bf16_t* sVt, const LAS float* sB2, bf16_t* PART, float* LSUM, int fr, int fq) {
    const int qposA = (int)(ecA & 0xffffu), slotA = (int)(ecA >> 16), qposB = (int)(ecB & 0xffffu), slotB = (int)(ecB >> 16);
    const int dqfA = qposA - m * 256 - 4 * fq, dqfB = qposB - m * 256 - 4 * fq;
    const bool farb = !OWN && (__all(dqfA + 4 * fq - 255 >= 1513 && dqfB + 4 * fq - 255 >= 1513) != 0);
    const LAS float* pbA = sB2 + (272 + dqfA - 255); const LAS float* pbB = sB2 + (272 + dqfB - 255);
    float lsA = 0.f, lsB = 0.f;
    f32x4 oA[4], oB[4];
#pragma unroll
    for (int nd = 0; nd < 4; ++nd) { oA[nd] = (f32x4){0.f, 0.f, 0.f, 0.f}; oB[nd] = (f32x4){0.f, 0.f, 0.f, 0.f}; }
    for (int kq = 0; kq < kqn; ++kq) {
        unsigned pkA[4][2], pkB[4][2];
        const LAS float* pa = pbA - kq * 64; const LAS float* pb = pbB - kq * 64;
#pragma unroll
        for (int nt = 0; nt < 4; ++nt) {
            const LAS bf16_t* kp = sK + (kq * 64 + nt * 16 + fr) * 72 + fq * 8;
            const bf16x8 k0 = *(const LAS bf16x8*)kp, k1 = *(const LAS bf16x8*)(kp + 32);
            f32x4 aA = (f32x4){0.f, 0.f, 0.f, 0.f}, aB = (f32x4){0.f, 0.f, 0.f, 0.f};
            aA = mfma16(k0, qA0, aA); aB = mfma16(k0, qB0, aB); aA = mfma16(k1, qA1, aA); aB = mfma16(k1, qB1, aB);
            float pjA[4], pjB[4];
#pragma unroll
            for (int j = 0; j < 4; ++j) {
                const float b2A = farb ? cb : pa[255 - nt * 16 - j], b2B = farb ? cb : pb[255 - nt * 16 - j];
                float pvA = __builtin_amdgcn_exp2f(aA[j] * 0.18033688011112042f + b2A), pvB = __builtin_amdgcn_exp2f(aB[j] * 0.18033688011112042f + b2B);
                if (OWN) { if (dqfA - (kq * 64 + nt * 16 + j) < 0) pvA = 0.f; if (dqfB - (kq * 64 + nt * 16 + j) < 0) pvB = 0.f; }
                lsA += pvA; lsB += pvB; pjA[j] = pvA; pjB[j] = pvB; }
            pkA[nt][0] = cvt_pk_bf16(pjA[0], pjA[1]); pkA[nt][1] = cvt_pk_bf16(pjA[2], pjA[3]);
            pkB[nt][0] = cvt_pk_bf16(pjB[0], pjB[1]); pkB[nt][1] = cvt_pk_bf16(pjB[2], pjB[3]); }
#pragma unroll
        for (int tt = 0; tt < 2; ++tt) {
            u32x4 bwA, bwB; bwA[0] = pkA[2 * tt][0]; bwA[1] = pkA[2 * tt][1]; bwA[2] = pkA[2 * tt + 1][0]; bwA[3] = pkA[2 * tt + 1][1];
            bwB[0] = pkB[2 * tt][0]; bwB[1] = pkB[2 * tt][1]; bwB[2] = pkB[2 * tt + 1][0]; bwB[3] = pkB[2 * tt + 1][1];
            const bf16x8 bfA = __builtin_bit_cast(bf16x8, bwA), bfB = __builtin_bit_cast(bf16x8, bwB);
#pragma unroll
            for (int nd = 0; nd < 4; ++nd) { const LAS bf16_t* vp = sVt + (nd * 16 + fr) * 264 + kq * 64 + 32 * tt + 4 * fq;
                const u32x2 lo = *(const LAS u32x2*)vp, hi = *(const LAS u32x2*)(vp + 16);
                u32x4 aw; aw[0] = lo[0]; aw[1] = lo[1]; aw[2] = hi[0]; aw[3] = hi[1];
                const bf16x8 vf = __builtin_bit_cast(bf16x8, aw);
                oA[nd] = mfma16(vf, bfA, oA[nd]); oB[nd] = mfma16(vf, bfB, oB[nd]); } }
    }
    lsA += __shfl_xor(lsA, 16); lsA += __shfl_xor(lsA, 32); lsB += __shfl_xor(lsB, 16); lsB += __shfl_xor(lsB, 32);
    if (vA) { const size_t pi = (((size_t)bl * SEQ + qposA) * 8 + h) * 4 + slotA;
        if (fq == 0) LSUM[pi] = lsA;
#pragma unroll
        for (int nd = 0; nd < 4; ++nd) { u32x2 pk2; pk2[0] = cvt_pk_bf16(oA[nd][0], oA[nd][1]); pk2[1] = cvt_pk_bf16(oA[nd][2], oA[nd][3]);
            *(u32x2*)(PART + pi * 64 + nd * 16 + 4 * fq) = pk2; } }
    if (vB) { const size_t pi = (((size_t)bl * SEQ + qposB) * 8 + h) * 4 + slotB;
        if (fq == 0) LSUM[pi] = lsB;
#pragma unroll
        for (int nd = 0; nd < 4; ++nd) { u32x2 pk2; pk2[0] = cvt_pk_bf16(oB[nd][0], oB[nd][1]); pk2[1] = cvt_pk_bf16(oB[nd][2], oB[nd][3]);
            *(u32x2*)(PART + pi * 64 + nd * 16 + 4 * fq) = pk2; } }
}
__device__ __forceinline__ void moba_attn_item(const P& p, LAS unsigned char* lds, const bf16_t* z, int bl, int h, int m, int part, int parts, float M) {
    LAS bf16_t* sK = (LAS bf16_t*)lds;
    LAS bf16_t* sVt = sK + 256 * 72;
    LAS float* sB2 = (LAS float*)(lds + 70656);
    const int tid = opaque_tid(), wid = tid >> 6, lane = tid & 63, fr = lane & 15, fq = lane >> 4;
    const bf16_t* Vtg = (const bf16_t*)(p.ws + WS_VTC) + (size_t)(bl * 8 + h) * 64 * SEQ;
    const float* biasC = (const float*)(p.ws + WS_BIASC) + h * 8192;
    const unsigned* LIST = (const unsigned*)(p.ws + WS_MLIST) + ((size_t)(bl * 8 + h) * 32 + m) * LCAP;
    bf16_t* PART = (bf16_t*)(p.ws + WS_MPART); float* LSUM = (float*)(p.ws + WS_MLSUM);
    const int cnt = ((const int*)(p.ws + WS_MCNT))[(bl * 8 + h) * 32 + m];
    const int ntl = (cnt + 31) >> 5, ntot = ntl + 8;
    const int tlo = (part * ntot) / parts, thi = ((part + 1) * ntot) / parts;
#define MOBA_ENTRY1(ix_, e, v) do { v = (ix_) < cnt; e = LIST[(ix_) < cnt ? (ix_) : (cnt > 0 ? cnt - 1 : 0)]; } while (0)
#define MOBA_ENTRY(t, ea, va, eb, vb) do { if ((t) < ntl) { MOBA_ENTRY1((t) * 32 + fr, ea, va); MOBA_ENTRY1((t) * 32 + 16 + fr, eb, vb); } \
        else { va = vb = (t) < thi; ea = (unsigned)(m * 256 + (((t) - ntl) & 7) * 32 + fr) | (3u << 16); eb = ea + 16u; } } while (0)
#define MOBA_QGATHER(e, a0, a1) do { const bf16_t* qp_ = z + ((size_t)bl * SEQ + ((e) & 0xffffu)) * DIN + C_QC + h * 64 + fq * 8; a0 = *(const bf16x8*)qp_; a1 = *(const bf16x8*)(qp_ + 32); } while (0)
#define MOBA_KQN(t) ((((((t) - ntl) & 7) * 32 + 31) >> 6) + 1)
    int t = tlo + wid;
    unsigned e0a = 0u, e0b = 0u, e1a = 0u, e1b = 0u, e2a = 0u, e2b = 0u; bool v0a = false, v0b = false, v1a = false, v1b = false, v2a = false, v2b = false;
    bf16x8 qa0, qa1, qa2, qa3, qb0, qb1, qb2, qb3, qc0, qc1, qc2, qc3;
    MOBA_ENTRY(t, e0a, v0a, e0b, v0b); MOBA_ENTRY(t + 8, e1a, v1a, e1b, v1b); MOBA_ENTRY(t + 16, e2a, v2a, e2b, v2b);
    MOBA_QGATHER(e0a, qa0, qa1); MOBA_QGATHER(e0b, qa2, qa3); MOBA_QGATHER(e1a, qb0, qb1); MOBA_QGATHER(e1b, qb2, qb3);
    qc0 = qa0; qc1 = qa1; qc2 = qa2; qc3 = qa3;
#pragma unroll
    for (int k = 0; k < 4; ++k) { const int i = tid + k * NTHREADS;
        const u32x4 kv = *(const u32x4*)(z + ((size_t)bl * SEQ + (size_t)m * 256 + (i >> 3)) * DIN + C_KC + h * 64 + (i & 7) * 8);
        const u32x4 vv = *(const u32x4*)(Vtg + (size_t)(i >> 5) * SEQ + m * 256 + (i & 31) * 8);
        *(LAS u32x4*)(sK + (i >> 3) * 72 + (i & 7) * 8) = kv; *(LAS u32x4*)(sVt + (i >> 5) * 264 + (i & 31) * 8) = vv;
    }
    for (int i = tid; i < 8192 + 272; i += NTHREADS) { const int dist = i - 272; sB2[i] = (biasC[dist < 0 ? 0 : dist] - M) * 1.4426950408889634f; }
    __syncthreads();
    const float cb = sB2[272 + 8191];
#define MOBA_RUN(ea, eb, va, vb, q0, q1, q2, q3) do { if (t >= ntl) moba_tile<true>(ea, eb, (va) && t < thi, (vb) && t < thi, q0, q1, q2, q3, MOBA_KQN(t), m, bl, h, cb, sK, sVt, sB2, PART, LSUM, fr, fq); \
        else moba_tile<false>(ea, eb, (va) && t < thi, (vb) && t < thi, q0, q1, q2, q3, 4, m, bl, h, cb, sK, sVt, sB2, PART, LSUM, fr, fq); } while (0)
    for (;;) {
        if (t >= thi) break;
        { const unsigned ca = e0a, cbb = e0b; const bool wa = v0a, wb = v0b; MOBA_QGATHER(e2a, qc0, qc1); MOBA_QGATHER(e2b, qc2, qc3); MOBA_ENTRY(t + 24, e0a, v0a, e0b, v0b);
          MOBA_RUN(ca, cbb, wa, wb, qa0, qa1, qa2, qa3); t += 8; }
        if (t >= thi) break;
        { const unsigned ca = e1a, cbb = e1b; const bool wa = v1a, wb = v1b; MOBA_QGATHER(e0a, qa0, qa1); MOBA_QGATHER(e0b, qa2, qa3); MOBA_ENTRY(t + 24, e1a, v1a, e1b, v1b);
          MOBA_RUN(ca, cbb, wa, wb, qb0, qb1, qb2, qb3); t += 8; }
        if (t >= thi) break;
        { const unsigned ca = e2a, cbb = e2b; const bool wa = v2a, wb = v2b; MOBA_QGATHER(e1a, qb0, qb1); MOBA_QGATHER(e1b, qb2, qb3); MOBA_ENTRY(t + 24, e2a, v2a, e2b, v2b);
          MOBA_RUN(ca, cbb, wa, wb, qc0, qc1, qc2, qc3); t += 8; }
    }
#undef MOBA_ENTRY1
#undef MOBA_ENTRY
#undef MOBA_QGATHER
#undef MOBA_KQN
#undef MOBA_RUN
    __syncthreads();
}

__device__ __forceinline__ void phase_moba_combine(const P& p, bf16_t* z) {
    const bf16_t* PART = (const bf16_t*)(p.ws + WS_MPART); const float* LSUM = (const float*)(p.ws + WS_MLSUM);
    const int tid = opaque_tid(), wid = tid >> 6, lane = tid & 63, h = lane >> 3, d8 = (lane & 7) * 8;
    for (int r0 = (blockIdx.x * 8 + wid) * 2; r0 < TC; r0 += gridDim.x * 8 * 2) {
#pragma unroll
        for (int q = 0; q < 2; ++q) { const int r = r0 + q; const int n = (r % SEQ) >> 8; const int nsel = n < 3 ? n : 3;
            const size_t pi = ((size_t)r * 8 + h) * 4;
            float acc[8], lt = LSUM[pi + 3];
            unpack8(*(const u32x4*)(PART + (pi + 3) * 64 + d8), acc);
#pragma unroll
            for (int k = 0; k < 3; ++k) if (k < nsel) { float f[8]; unpack8(*(const u32x4*)(PART + (pi + k) * 64 + d8), f); lt += LSUM[pi + k];
#pragma unroll
                for (int j = 0; j < 8; ++j) acc[j] += f[j]; }
            const float inv = 1.0f / lt; u32x4 pk;
#pragma unroll
            for (int j = 0; j < 4; ++j) pk[j] = cvt_pk_bf16(acc[2 * j] * inv, acc[2 * j + 1] * inv);
            *(u32x4*)(z + (size_t)r * DIN + C_QC + h * 64 + d8) = pk; }
    }
}

__device__ __forceinline__ void phase_act(const P& p, int l, const bf16_t* u, bf16_t* act) {
    const int tid = opaque_tid();
    if (tid >= DFF / 8) return;
    const int c0 = tid * 8;
    float wg[3][8], wv[3][8], bg[8], bv[8];
#pragma unroll
    for (int k = 0; k < 3; ++k)
#pragma unroll
        for (int j = 0; j < 8; ++j) { wg[k][j] = p.ffn_conv_w[(size_t)(l * 3 + k) * DFF2 + c0 + j]; wv[k][j] = p.ffn_conv_w[(size_t)(l * 3 + k) * DFF2 + DFF + c0 + j]; }
#pragma unroll
    for (int j = 0; j < 8; ++j) { bg[j] = p.ffn_conv_b[(size_t)l * DFF2 + c0 + j]; bv[j] = p.ffn_conv_b[(size_t)l * DFF2 + DFF + c0 + j]; }
    for (int item = blockIdx.x; item < TC / 64; item += gridDim.x) {
        const int r0 = item * 64;
        float g1[8], g2[8], v1[8], v2[8];
        if ((r0 % SEQ) == 0) {
#pragma unroll
            for (int j = 0; j < 8; ++j) { g1[j] = 0.f; g2[j] = 0.f; v1[j] = 0.f; v2[j] = 0.f; }
        } else {
            unpack8(*(const u32x4*)(u + (size_t)(r0 - 1) * DFF2 + c0), g1); unpack8(*(const u32x4*)(u + (size_t)(r0 - 2) * DFF2 + c0), g2);
            unpack8(*(const u32x4*)(u + (size_t)(r0 - 1) * DFF2 + DFF + c0), v1); unpack8(*(const u32x4*)(u + (size_t)(r0 - 2) * DFF2 + DFF + c0), v2);
        }
        for (int i0 = 0; i0 < 64; i0 += 8) {
            u32x4 rg[8], rv[8];
#pragma unroll
            for (int i = 0; i < 8; ++i) { const size_t r = (size_t)(r0 + i0 + i); rg[i] = *(const u32x4*)(u + r * DFF2 + c0); rv[i] = *(const u32x4*)(u + r * DFF2 + DFF + c0); }
#pragma unroll
            for (int i = 0; i < 8; ++i) { const size_t r = (size_t)(r0 + i0 + i);
                float g0[8], v0[8]; unpack8(rg[i], g0); unpack8(rv[i], v0);
                float o[8];
#pragma unroll
                for (int j = 0; j < 8; ++j) { const float cgv = bg[j] + wg[0][j] * g2[j] + wg[1][j] * g1[j] + wg[2][j] * g0[j]; const float cvv = bv[j] + wv[0][j] * v2[j] + wv[1][j] * v1[j] + wv[2][j] * v0[j];
                    o[j] = (cgv * __builtin_amdgcn_rcpf(1.0f + __expf(-cgv))) * cvv; g2[j] = g1[j]; g1[j] = g0[j]; v2[j] = v1[j]; v1[j] = v0[j]; }
                u32x4 pk;
#pragma unroll
                for (int j = 0; j < 4; ++j) pk[j] = pack2(o[2 * j], o[2 * j + 1]);
                *(u32x4*)(act + r * DFF + c0) = pk; }
        }
    }
}

#ifndef PHASE_MASK
#define PHASE_MASK 0xFFFFF
#endif
#define PH(k) ((PHASE_MASK >> (k)) & 1)
#ifndef REP_GRP
#define REP_GRP 0
#endif
#ifndef REP_P2
#define REP_P2 0
#endif
#ifndef REP_P8
#define REP_P8 0
#endif
#ifndef REP_MISC
#define REP_MISC 0
#endif
#ifndef DRY_MOBA
#define DRY_MOBA 0
#endif
#ifndef DRY_SWA
#define DRY_SWA 0
#endif
#ifndef DRY_RNN
#define DRY_RNN 0
#endif

#define XB_TMO      128
#define XB_XCNT(j)  (256  + 64 * (j))
#define XB_XSUB(j)  (1280 + 64 * (j))
#define XB_XGEN(j)  (2304 + 64 * (j))
#define XB_TOP      3328
#define XB_TOPGEN   3392
#define XCD_BAR_WORDS 3456
#define XB_SPIN_CAP (1u << 18)
__device__ __forceinline__ unsigned xb_ld(unsigned* p)              { return __hip_atomic_load(p, __ATOMIC_RELAXED, __HIP_MEMORY_SCOPE_AGENT); }
__device__ __forceinline__ unsigned xb_add(unsigned* p, unsigned v) { return __hip_atomic_fetch_add(p, v, __ATOMIC_RELAXED, __HIP_MEMORY_SCOPE_AGENT); }
__device__ __forceinline__ unsigned xb_xcc_id() { return (unsigned)__builtin_amdgcn_s_getreg((3 << 11) | 20) & 0xFu; }
#define XB_SPIN(cond, bar) do { unsigned _sp = 0; while (cond) { __builtin_amdgcn_s_sleep(1); \
    if ((++_sp & 255u) == 0u) { if (xb_ld(&(bar)[XB_TMO])) break; if (_sp > XB_SPIN_CAP) { atomicAdd(&(bar)[XB_TMO], 1u); break; } } } } while (0)
struct XcdBarrier { unsigned* bar; unsigned x; volatile LAS unsigned* st; };
__device__ __forceinline__ XcdBarrier xcd_barrier_post(unsigned* bar, volatile LAS unsigned* st) {
    XcdBarrier b; b.bar = bar; b.x = xb_xcc_id(); b.st = st;
    if (threadIdx.x == 0) (void)xb_add(&bar[XB_XCNT(b.x)], 1u);
    return b;
}
__device__ __forceinline__ void xcd_barrier_complete(unsigned* bar, unsigned x, unsigned& nloc, unsigned& nx) {
    const unsigned G = gridDim.x * gridDim.y * gridDim.z;
    unsigned sum, cnt, mine, sp = 0u;
    for (;;) {
        sum = 0u; cnt = 0u; mine = 0u;
#pragma unroll
        for (unsigned j = 0; j < 16; ++j) { const unsigned c = xb_ld(&bar[XB_XCNT(j)]); sum += c; cnt += (c > 0u) ? 1u : 0u; mine = (j == x) ? c : mine; }
        if (sum == G) break;
        __builtin_amdgcn_s_sleep(1);
        if ((++sp & 255u) == 0u) { if (xb_ld(&bar[XB_TMO])) break; if (sp > XB_SPIN_CAP) { atomicAdd(&bar[XB_TMO], 1u); break; } }
    }
    nloc = mine > 0u ? mine : 1u; nx = cnt > 0u ? cnt : 1u;
}
__device__ __forceinline__ void xcd_barrier(const XcdBarrier& b) {
    asm volatile("s_waitcnt vmcnt(0)" ::: "memory");
    __syncthreads();
    if (opaque_tid() == 0) {
        unsigned* bar = b.bar;
        __builtin_amdgcn_s_waitcnt(0);
        unsigned nloc = b.st[0], nx = b.st[1];
        if (nloc == 0u) { xcd_barrier_complete(bar, b.x, nloc, nx); b.st[0] = nloc; b.st[1] = nx; }
        const unsigned old = xb_add(&bar[XB_XSUB(b.x)], 1u);
        const unsigned gen = old / nloc;
        if (old + 1u == (gen + 1u) * nloc) {
            __builtin_amdgcn_fence(__ATOMIC_RELEASE, "agent");
            asm volatile("s_waitcnt vmcnt(0)" ::: "memory");
            const unsigned og = xb_add(&bar[XB_TOP], 1u);
            const unsigned tg = og / nx;
            if (og + 1u == (tg + 1u) * nx) xb_add(&bar[XB_TOPGEN], 1u);
            else XB_SPIN(xb_ld(&bar[XB_TOPGEN]) == tg, bar);
            __builtin_amdgcn_fence(__ATOMIC_ACQUIRE, "agent");
            xb_add(&bar[XB_XGEN(b.x)], 1u);
            asm volatile("s_waitcnt vmcnt(0)" ::: "memory");
        } else {
            XB_SPIN(xb_ld(&bar[XB_XGEN(b.x)]) == gen, bar);
            __builtin_amdgcn_fence(__ATOMIC_ACQUIRE, "agent");
            asm volatile("s_waitcnt vmcnt(0)" ::: "memory");
        }
    }
    __syncthreads();
}
#ifndef REP_SYNC
#define REP_SYNC 0
#endif
#define GSYNC() do { for (int _r = 0; _r < 1 + REP_SYNC; ++_r) xcd_barrier(xbar); } while (0)
__global__ void __launch_bounds__(NTHREADS, 2) fwd_megakernel(P p_arg) {
    extern __shared__ __attribute__((aligned(16))) unsigned char lds_raw[];
    LAS unsigned char* lds = (LAS unsigned char*)lds_raw;
    cg::grid_group grid = cg::this_grid();
    const int G = gridDim.x, bx = blockIdx.x;
#define RELOAD const P p = load_params(); const float* mod_l = (const float*)(p.ws + WS_MOD) + (size_t)l * NB * 6144; bf16_t* Hb = (bf16_t*)(p.ws + WS_H); bf16_t* Zb = (bf16_t*)(p.ws + WS_Z); bf16_t* ACTb = (bf16_t*)(p.ws + WS_ACT); \
    const float* xin = ((l == 0) ? p.x : p.out) + (size_t)ch * TC * DM; float* xout = p.out + (size_t)ch * TC * DM; (void)mod_l; (void)Hb; (void)Zb; (void)ACTb; (void)xin; (void)xout;

    { LAS unsigned* st = (LAS unsigned*)(lds + LDS_BYTES - 16); if (threadIdx.x == 0) { st[0] = 0u; st[1] = 0u; } __syncthreads(); }
    const XcdBarrier xbar = xcd_barrier_post((unsigned*)(p_arg.ws + WS_BAR), (volatile LAS unsigned*)(lds + LDS_BYTES - 16));
    if (PH(0)) { const P p = load_params(); phase0(p, lds); }
    grid.sync();

    for (int l = 0; l < DEPTH; ++l) {
        for (int ch = 0; ch < NCHUNK; ++ch) {
            const int b0 = ch * BPC;
            for (int rep3 = 0; rep3 < 1 + REP_MISC; ++rep3) { RELOAD
            if (PH(1)) if (ch == 0) phase_convert(p, l, lds);
            if (PH(2)) phase_norm(xin, p.norm_mix + l * DM, mod_l, 0, 1024, b0, Hb, p.ws + WS_H8); }
            GSYNC();
            for (int rep = 0; rep < 1 + REP_GRP; ++rep) {
            for (int rep2 = 0; rep2 < 1 + REP_P2; ++rep2) {
            if (PH(3)) { RELOAD
              { pg8::SchedPlain S{(const char*)Hb, (const char*)(p.ws + WS_WIN), DM * 2, DM * 2, DM / 64, TC / 256, C_G / 256, G, bx};
                pg8::EpiStoreBf16 E{Zb, DIN, 1 << 30, 1.0f};
                pg8::gemm_phase(lds, S, E); }
              {
                pg8::SchedPlain S{(const char*)(p.ws + WS_H8), (const char*)(p.ws + WS_WG8), DM, DM, DM / 128, TC / 256, (DIN - C_G) / 256, G, bx};
                pg8::EpiStoreBf16 E{Zb + C_G, DIN, 0, 1.0f / 64.0f};
                pg8::gemm_phase<pg8::SchedPlain, pg8::EpiStoreBf16, true>(lds, S, E); } }
            GSYNC();
            }
            { RELOAD
            if (PH(4)) phase_qknorm(p, l, Zb);
            if (PH(5)) phase_kcnorm(p, l, Zb, lds);
            if (bx == 0) { const int t_ = opaque_tid(); if (t_ < BPC * 8 * 32) ((int*)(p.ws + WS_MCNT))[t_] = 0; if (t_ == 0) *((int*)(p.ws + WS_MQ)) = 0; }
            if (PH(6)) phase_rnn0(p, l, lds, Zb); }
            GSYNC();
            { RELOAD
              for (int it = bx; it < BPC * 8 * 31; it += G) { const int n = 31 - it / (BPC * 8), h = it & 7, bl = (it >> 3) & 1; moba_gate_item(p, lds, Zb, bl, h, n); } }
            GSYNC();
            { RELOAD constexpr int N_MOBA = BPC * 8 * 32, N_SWA = BPC * 8 * 64, N_RNN = BPC * 16 * 64;
              const float Mb_a = ((const float*)(p.ws + WS_MB))[l * 2], Mb_c = ((const float*)(p.ws + WS_MB))[l * 2 + 1];
              for (int j = bx; j < BPC * 2 * 64; j += G) { if (PH(8)) { const int qb = j & 63, kvh = (j >> 6) & 1, bl = j >> 7; swa_item(p, l, lds, Zb, bl, kvh, qb, Mb_a); } }
              if (PH(9)) phase_rnn_apply(p, lds, Zb);
              if (PH(7)) {
                  int* qhead = (int*)(p.ws + WS_MQ); LAS int* sQ = (LAS int*)(lds + LDS_BYTES - 32);
                  for (;;) {
                      if (opaque_tid() == 0) *sQ = __hip_atomic_fetch_add(qhead, 1, __ATOMIC_RELAXED, __HIP_MEMORY_SCOPE_AGENT);
                      __syncthreads();
                      const int i = *sQ;
                      __syncthreads();
                      if (i >= N_MSUB * BPC * 8) break;
                      const unsigned sv = MOBA_SUB[i >> 4]; const int h = i & 7, bl = (i >> 3) & 1;
                      moba_attn_item(p, lds, Zb, bl, h, (int)(sv & 31u), (int)((sv >> 5) & 7u), (int)(sv >> 8), Mb_c); } } }
            GSYNC();
            { RELOAD phase_moba_combine(p, Zb); }
            GSYNC();
            }
            if (PH(10)) { RELOAD pg8::SchedMerge S{(const char*)Zb, (const char*)(p.ws + WS_WB), DIN * 2, 2048 * 2, TC / 256, DM / 256, G, bx};
              pg8::EpiMerge E{Zb, Hb};
              pg8::gemm_phase(lds, S, E); }
            GSYNC();
            if (PH(11)) { RELOAD pg8::SchedPlain S{(const char*)Hb, (const char*)(p.ws + WS_WOUT), DM * 2, DM * 2, DM / 64, TC / 256, DM / 256, G, bx};
              pg8::EpiResid E{xin, xout, mod_l + 2048, b0};
              pg8::gemm_phase(lds, S, E); }
            GSYNC();
            for (int rep3 = 0; rep3 < 1 + REP_MISC; ++rep3) if (PH(12)) { RELOAD phase_norm(xout, p.norm_ffn + l * DM, mod_l, 3072, 4096, b0, Hb, nullptr); }
            GSYNC();
            for (int rep2 = 0; rep2 < 1 + REP_P8; ++rep2) {
            if (PH(13)) { RELOAD pg8::SchedPlain S{(const char*)Hb, (const char*)(p.ws + WS_WUP), DM * 2, DM * 2, DM / 64, TC / 256, DFF2 / 256, G, bx};
              pg8::EpiStoreBf16 E{Zb, DFF2, 1 << 30, 1.0f};
              pg8::gemm_phase(lds, S, E); }
            GSYNC();
            }
            for (int rep3 = 0; rep3 < 1 + REP_MISC; ++rep3) if (PH(14)) { RELOAD phase_act(p, l, Zb, ACTb); }
            GSYNC();
            if (PH(15)) { RELOAD pg8::SchedPlain S{(const char*)ACTb, (const char*)(p.ws + WS_WDOWN), DFF * 2, DFF * 2, DFF / 64, TC / 256, DM / 256, G, bx};
              pg8::EpiResid E{xout, xout, mod_l + 5120, b0};
              pg8::gemm_phase(lds, S, E); }
            GSYNC();
        }
    }
}

extern "C" void kernel_launch(void* const* d_in, const int* in_sizes, int n_in, void* d_out, int out_size, void* d_ws, size_t ws_size, hipStream_t stream) {
    static int grid = 0;
    if (grid == 0) {
        if (n_in != 26 || ws_size < WS_END) { fprintf(stderr, "kernel_launch: need 26 inputs and >= %zu bytes of workspace (got %d, %zu)\n", (size_t)WS_END, n_in, ws_size); grid = -1; return; }
        int dev = 0, cus = 0, per_cu = 0;
        (void)hipGetDevice(&dev);
        (void)hipDeviceGetAttribute(&cus, hipDeviceAttributeMultiprocessorCount, dev);
        if (hipFuncSetAttribute((const void*)fwd_megakernel, hipFuncAttributeMaxDynamicSharedMemorySize, LDS_BYTES) != hipSuccess) { fprintf(stderr, "kernel_launch: hipFuncSetAttribute failed\n"); grid = -1; return; }
        if (hipOccupancyMaxActiveBlocksPerMultiprocessor(&per_cu, (const void*)fwd_megakernel, NTHREADS, LDS_BYTES) != hipSuccess || per_cu < 1) { fprintf(stderr, "kernel_launch: occupancy query gives %d\n", per_cu); per_cu = 1; (void)hipGetLastError(); }
        grid = cus * per_cu;
        fprintf(stderr, "kernel_launch: grid %d (cus %d x %d)\n", grid, cus, per_cu);
    }
    if (grid < 0) return;
    P prm{};
    const float** pp = (const float**)&prm;
    for (int i = 0; i < 26; ++i) pp[i] = (const float*)d_in[i];
    prm.out = (float*)d_out; prm.ws = (unsigned char*)d_ws;
    if (hipMemsetAsync((char*)d_ws + WS_BAR, 0, 3456 * 4, stream) != hipSuccess) { fprintf(stderr, "kernel_launch: memset of barrier words failed\n"); return; }
    void* args[] = {&prm};
    hipError_t e = hipLaunchCooperativeKernel((const void*)fwd_megakernel, dim3(grid), dim3(NTHREADS), args, LDS_BYTES, stream);
    if (e != hipSuccess) fprintf(stderr, "kernel_launch: cooperative launch failed: %s (grid %d)\n", hipGetErrorString(e), grid);
}
```

```cpp
#include <hip/hip_runtime.h>
#include <hip/hip_cooperative_groups.h>
#include <cstdio>
#include <cstdint>
namespace cg = cooperative_groups;

#define LAS __attribute__((address_space(3)))
typedef unsigned short bf16_t;
typedef short bf16x8 __attribute__((ext_vector_type(8)));
typedef float f32x4 __attribute__((ext_vector_type(4)));
typedef unsigned u32x4 __attribute__((ext_vector_type(4)));
typedef unsigned u32x2 __attribute__((ext_vector_type(2)));
typedef int i32x8 __attribute__((ext_vector_type(8)));
typedef unsigned u32x8 __attribute__((ext_vector_type(8)));

constexpr int NB = 4, SEQ = 8192, DM = 1024, NTOK = NB * SEQ, DEPTH = 4;
constexpr int DIN = 7424, DFF = 2816, DFF2 = 5632;
constexpr int C_QA = 0, C_KA = 512, C_VA = 640, C_XR = 768, C_YR = 1792, C_QC = 2816, C_KC = 3328, C_VC = 3840, C_G = 4352;
constexpr int NCHUNK = 2, TC = NTOK / NCHUNK, BPC = NB / NCHUNK;
constexpr int NTHREADS = 512;
constexpr int LDS_BYTES = 160 * 1024;
constexpr float RMS_EPS = 1e-6f;

constexpr size_t alup(size_t x) { return (x + 255) & ~(size_t)255; }
constexpr size_t WS_MOD = 0;
constexpr size_t WS_MB = alup(WS_MOD + (size_t)DEPTH * NB * 6144 * 4);
constexpr size_t WS_BIASA = alup(WS_MB + 256);
constexpr size_t WS_BIASC = alup(WS_BIASA + 8 * 128 * 4);
constexpr size_t WS_KMEAN = alup(WS_BIASC + 8 * 8192 * 4);
constexpr size_t WS_RSUM = alup(WS_KMEAN + (size_t)BPC * 8 * 32 * 64 * 4);
constexpr size_t WS_WIN = alup(WS_RSUM + (size_t)BPC * 64 * 1024 * 2 * 4);
constexpr size_t WS_WB = alup(WS_WIN + (size_t)DIN * 1024 * 2);
constexpr size_t WS_WOUT = alup(WS_WB + (size_t)1024 * 2048 * 2);
constexpr size_t WS_WUP = alup(WS_WOUT + (size_t)1024 * 1024 * 2);
constexpr size_t WS_WDOWN = alup(WS_WUP + (size_t)DFF2 * 1024 * 2);
constexpr size_t WS_GT = alup(WS_WDOWN + (size_t)1024 * DFF * 2);
constexpr size_t WS_H = alup(WS_GT + (size_t)2 * 64 * 1024 * 2);
constexpr size_t WS_Z = alup(WS_H + (size_t)TC * 1024 * 2);
constexpr size_t WS_ACT = alup(WS_Z + (size_t)TC * DIN * 2);
constexpr size_t WS_VTC = alup(WS_ACT + (size_t)TC * DFF * 2);
constexpr size_t WS_BAR = alup(WS_VTC + (size_t)BPC * 8 * 64 * SEQ * 2);
constexpr int LCAP = 8192;
constexpr size_t WS_MCNT = alup(WS_BAR + 3456 * 4);
constexpr size_t WS_MQ = alup(WS_MCNT + (size_t)BPC * 8 * 32 * 4);
constexpr size_t WS_MLIST = alup(WS_MQ + 256);
constexpr size_t WS_MPART = alup(WS_MLIST + (size_t)BPC * 8 * 32 * LCAP * 4);
constexpr size_t WS_MLSUM = alup(WS_MPART + (size_t)TC * 8 * 4 * 64 * 2);
constexpr size_t WS_H8 = alup(WS_MLSUM + (size_t)TC * 8 * 4 * 4);
constexpr size_t WS_WG8 = alup(WS_H8 + (size_t)TC * 1024);
constexpr size_t WS_B2T = alup(WS_WG8 + (size_t)3072 * 1024);
constexpr size_t WS_END = alup(WS_B2T + (size_t)8 * (8192 + 272) * 4);

struct P {
    const float *x, *c, *w_mod, *b_mod, *norm_mix, *norm_ffn, *w_in, *qnorm_a, *knorm_a, *sinks, *rnn_conv_w, *rnn_conv_b, *ga_w, *ga_b, *gx_w, *gx_b, *lam,
        *qnorm_c, *knorm_c, *rel_bias, *w_branch, *w_out, *w_up, *ffn_conv_w, *ffn_conv_b, *w_down;
    float* out; unsigned char* ws;
};

__device__ __forceinline__ P load_params() {
#if defined(__HIP_DEVICE_COMPILE__)
    unsigned long long v = (unsigned long long)__builtin_amdgcn_kernarg_segment_ptr(); asm volatile("" : "+s"(v));
    const P __attribute__((address_space(4)))* kp = (const P __attribute__((address_space(4)))*)v;
    return *kp;
#else
    return P{};
#endif
}
__device__ __forceinline__ int opaque_tid() { int t = threadIdx.x; asm volatile("" : "+v"(t)); return t; }
__device__ __forceinline__ float bf2f(unsigned v) { return __uint_as_float(v << 16); }
__device__ __forceinline__ unsigned cvt_pk_bf16(float lo, float hi) { unsigned r; asm volatile("v_cvt_pk_bf16_f32 %0, %1, %2" : "=v"(r) : "v"(lo), "v"(hi)); return r; }
__device__ __forceinline__ bf16_t f2bf(float f) { return (bf16_t)(cvt_pk_bf16(f, 0.0f) & 0xffffu); }
__device__ __forceinline__ unsigned pack2(float lo, float hi) { return cvt_pk_bf16(lo, hi); }
__device__ __forceinline__ void unpack8(const u32x4 v, float* f) {
    f[0] = bf2f(v[0] & 0xffffu); f[1] = bf2f(v[0] >> 16); f[2] = bf2f(v[1] & 0xffffu); f[3] = bf2f(v[1] >> 16);
    f[4] = bf2f(v[2] & 0xffffu); f[5] = bf2f(v[2] >> 16); f[6] = bf2f(v[3] & 0xffffu); f[7] = bf2f(v[3] >> 16);
}
__device__ __forceinline__ f32x4 mfma16(bf16x8 a, bf16x8 b, f32x4 c) { return __builtin_amdgcn_mfma_f32_16x16x32_bf16(a, b, c, 0, 0, 0); }
__device__ __forceinline__ int t5_bucket(int d) {
    if (d < 16) return d;
    const float lr = logf((float)d / 16.0f) / 4.852030263919617f;
    int large = 16 + (int)(lr * 16.0f);
    return large < 31 ? large : 31;
}
__device__ __forceinline__ float gelu_tanh(float y) { const float t = 0.7978845608028654f * (y + 0.044715f * y * y * y);
    return y * __builtin_amdgcn_rcpf(1.0f + __expf(-2.0f * t)); }
__device__ __forceinline__ float log1p_small(float x) { return (x < 0.125f) ? x * (1.0f + x * (-0.5f + x * (0.33333334f + x * (-0.25f + x * (0.2f + x * (-0.16666667f + x * 0.14285715f)))))) : __logf(1.0f + x); }
__device__ __forceinline__ float sigmoidf_(float v) { return 1.0f / (1.0f + __expf(-v)); }

namespace pg8 {
constexpr int BM = 256, BK = 64, HALF = 128, HTB = HALF * BK * 2, STAGE_BYTES = 8 * HTB, NXCD = 8, WGM = 8;
__device__ __forceinline__ int lds_byte(int r, int c) { const int st = (r >> 4) * 2 + (c >> 5), rr = r & 15, cc = c & 31, ob = rr * 64 + cc * 2; return st * 1024 + (ob ^ (((ob >> 9) & 1) << 5)); }
__device__ __forceinline__ void stage_rc(int b, int& R, int& C) { const int st = b / 1024, sb = b % 1024, swz = sb ^ (((sb >> 9) & 1) << 5); R = (st >> 1) * 16 + swz / 64; C = (st & 1) * 32 + (swz % 64) / 2; }
__device__ __forceinline__ int perm32(int rho) { const int n = rho >> 4, i = rho & 15; return 8 * (i >> 2) + 4 * n + (i & 3); }

struct Seg { const char* A; const char* B; int nt, pm, pn, pass; };

__device__ __forceinline__ bool unit_of(int i, int G, int c, int nM, int nN, int& pm, int& pn) {
    const int nwg = nM * nN; const long L = (long)i * G + c; if (L >= nwg) return false;
    int wgid = (int)L; { const int q = nwg / NXCD, r = nwg % NXCD, xcd = wgid % NXCD, off = wgid / NXCD; wgid = (xcd < r ? xcd * (q + 1) : r * (q + 1) + (xcd - r) * q) + off; }
    const int nig = WGM * nN, gid = wgid / nig, fm = gid * WGM, gsz = (nM - fm) < WGM ? (nM - fm) : WGM;
    pm = fm + ((wgid % nig) % gsz); pn = (wgid % nig) / gsz; return true;
}
struct SchedPlain {
    const char* A; const char* B; unsigned lda2, ldb2; int nt, nM, nN, G, c;
    __device__ __forceinline__ bool get(int i, Seg& s) const {
        int pm, pn; if (!unit_of(i, G, c, nM, nN, pm, pn)) return false;
        s.A = A + (size_t)pm * 256 * lda2; s.B = B + (size_t)pn * 256 * ldb2; s.nt = nt; s.pm = pm; s.pn = pn; s.pass = 0; return true;
    }
};
struct SchedMerge {
    const char* z; const char* wb; unsigned lda2, ldb2; int nM, nN, G, c;
    __device__ __forceinline__ bool get(int i, Seg& s) const {
        const int u = i / 3, ps = i - 3 * u; int pm, pn; if (!unit_of(u, G, c, nM, nN, pm, pn)) return false;
        const char* zr = z + (size_t)pm * 256 * (DIN * 2); const char* br = wb + (size_t)pn * 256 * 4096;
        s.pm = pm; s.pn = pn; s.pass = ps;
        if (ps == 0) { s.A = zr + C_QA * 2; s.B = br; s.nt = 8; }
        else if (ps == 1) { s.A = zr + C_YR * 2; s.B = br + 512 * 2; s.nt = 16; }
        else { s.A = zr + C_QC * 2; s.B = br + 1536 * 2; s.nt = 8; }
        return true;
    }
};

struct EpiStoreBf16 {
    static constexpr bool PERM = true;
    bf16_t* O; int ldc; int sig_from; float mul;
    __device__ __forceinline__ bool after(f32x4 (&acc)[2][2][4][2], const Seg& u, int wr, int wc, int fr, int fq) const {
        if (u.pn >= sig_from) {
#pragma unroll
            for (int ai = 0; ai < 2; ++ai)
#pragma unroll
                for (int bj = 0; bj < 2; ++bj)
#pragma unroll
                    for (int m = 0; m < 4; ++m)
#pragma unroll
                        for (int n = 0; n < 2; ++n)
#pragma unroll
                            for (int e = 0; e < 4; ++e) acc[ai][bj][m][n][e] = 1.0f + __builtin_amdgcn_exp2f(-1.4426950408889634f * fmaxf(acc[ai][bj][m][n][e] * mul, -60.0f));
        }
        const unsigned loff = (unsigned)((wr * 64 + fr) * ldc + wc * 32 + 8 * fq) * 2u;
        char* ub = (char*)O + ((size_t)u.pm * BM * ldc + (size_t)u.pn * BM) * 2;
#pragma unroll
        for (int ai = 0; ai < 2; ++ai)
#pragma unroll
            for (int m = 0; m < 4; ++m) { char* rb = ub + (size_t)(ai * HALF + m * 16) * ldc * 2;
#pragma unroll
                for (int bj = 0; bj < 2; ++bj) { const f32x4 v0 = acc[ai][bj][m][0], v1 = acc[ai][bj][m][1];
                    u32x4 pk; pk[0] = cvt_pk_bf16(v0[0], v0[1]); pk[1] = cvt_pk_bf16(v0[2], v0[3]); pk[2] = cvt_pk_bf16(v1[0], v1[1]); pk[3] = cvt_pk_bf16(v1[2], v1[3]);
                    { const unsigned vo = loff + (unsigned)(bj * HALF * 2); asm volatile("global_store_dwordx4 %0, %1, %2 sc1\n\ts_nop 1" :: "v"(vo), "v"(pk), "s"(rb) : "memory"); } } }
        return true;
    }
};
struct EpiResid {
    static constexpr bool PERM = false;
    const float* xin; float* xout; const float* gate; int b0;
    __device__ __forceinline__ bool after(f32x4 (&acc)[2][2][4][2], const Seg& u, int wr, int wc, int fr, int fq) const {
        const unsigned loff = (unsigned)((wr * 64 + fr) * DM + wc * 32 + 4 * fq) * 4u;
        const size_t uo = ((size_t)u.pm * BM * DM + (size_t)u.pn * BM) * 4;
        const char* ib = (const char*)xin + uo; char* ob = (char*)xout + uo;
        const char* gp = (const char*)(gate + (size_t)(b0 + (u.pm * BM) / SEQ) * 6144 + u.pn * BM);
        const unsigned goff = (unsigned)(wc * 32 + 4 * fq) * 4u;
        f32x4 gv[2][2];
#pragma unroll
        for (int bj = 0; bj < 2; ++bj)
#pragma unroll
            for (int n = 0; n < 2; ++n) gv[bj][n] = *(const f32x4*)(gp + goff + (bj * HALF + n * 16) * 4);
#pragma unroll
        for (int ai = 0; ai < 2; ++ai)
#pragma unroll
          for (int mh = 0; mh < 2; ++mh) {
            f32x4 xv[2][2][2];
#pragma unroll
            for (int m2 = 0; m2 < 2; ++m2) { const char* irb = ib + (size_t)(ai * HALF + (mh * 2 + m2) * 16) * DM * 4;
#pragma unroll
                for (int bj = 0; bj < 2; ++bj)
#pragma unroll
                    for (int n = 0; n < 2; ++n) xv[m2][bj][n] = *(const f32x4*)(irb + loff + (bj * HALF + n * 16) * 4); }
            __builtin_amdgcn_sched_barrier(0);
#pragma unroll
            for (int m2 = 0; m2 < 2; ++m2) { char* orb = ob + (size_t)(ai * HALF + (mh * 2 + m2) * 16) * DM * 4;
#pragma unroll
                for (int bj = 0; bj < 2; ++bj)
#pragma unroll
                    for (int n = 0; n < 2; ++n) *(f32x4*)(orb + loff + (bj * HALF + n * 16) * 4) = xv[m2][bj][n] + gv[bj][n] * acc[ai][bj][mh * 2 + m2][n]; }
            __builtin_amdgcn_sched_barrier(0); }
        return true;
    }
};
struct EpiMerge {
    static constexpr bool PERM = true;
    const bf16_t* z; bf16_t* O;
    __device__ __forceinline__ bool after(f32x4 (&acc)[2][2][4][2], const Seg& u, int wr, int wc, int fr, int fq) const {
        const int ps = u.pass;
        const int gA = (ps == 2) ? 2 : ps, gB = (ps == 2) ? 2 : ps + 1;
        const unsigned zoff = (unsigned)((wr * 64 + fr) * DIN + wc * 32 + 8 * fq) * 2u, ooff = (unsigned)((wr * 64 + fr) * DM + wc * 32 + 8 * fq) * 2u;
        const char* zb = (const char*)z + ((size_t)u.pm * BM * DIN + C_G + (size_t)u.pn * BM) * 2;
        const char* zA = zb + (size_t)gA * 2048; const char* zB = zb + (size_t)gB * 2048;
        char* ob = (char*)O + ((size_t)u.pm * BM * DM + (size_t)u.pn * BM) * 2;
#pragma unroll
        for (int ai = 0; ai < 2; ++ai)
#pragma unroll
          for (int mh = 0; mh < 2; ++mh) {
            u32x4 la[2][2], lb[2][2];
#pragma unroll
            for (int m2 = 0; m2 < 2; ++m2) { const size_t rz = (size_t)(ai * HALF + (mh * 2 + m2) * 16) * DIN * 2;
#pragma unroll
                for (int bj = 0; bj < 2; ++bj) { la[m2][bj] = *(const u32x4*)(zA + rz + zoff + bj * HALF * 2); lb[m2][bj] = *(const u32x4*)(zB + rz + zoff + bj * HALF * 2); } }
            __builtin_amdgcn_sched_barrier(0);
#pragma unroll
            for (int m2 = 0; m2 < 2; ++m2) { const int m = mh * 2 + m2; const size_t rO = (size_t)(ai * HALF + m * 16) * DM * 2;
#pragma unroll
                for (int bj = 0; bj < 2; ++bj) {
                    float fa[8], fb[8]; unpack8(la[m2][bj], fa); unpack8(lb[m2][bj], fb);
                    float sc[8];
#pragma unroll
                    for (int e = 0; e < 8; ++e) sc[e] = ((ps == 2) ? 1.0f : fb[e]) * __builtin_amdgcn_rcpf(fa[e]);
                    f32x4 v0 = acc[ai][bj][m][0], v1 = acc[ai][bj][m][1];
                    v0[0] *= sc[0]; v0[1] *= sc[1]; v0[2] *= sc[2]; v0[3] *= sc[3]; v1[0] *= sc[4]; v1[1] *= sc[5]; v1[2] *= sc[6]; v1[3] *= sc[7];
                    acc[ai][bj][m][0] = v0; acc[ai][bj][m][1] = v1;
                    if (ps == 2) { u32x4 pk; pk[0] = cvt_pk_bf16(v0[0], v0[1]); pk[1] = cvt_pk_bf16(v0[2], v0[3]); pk[2] = cvt_pk_bf16(v1[0], v1[1]); pk[3] = cvt_pk_bf16(v1[2], v1[3]);
                        *(u32x4*)(ob + rO + ooff + bj * HALF * 2) = pk; } } }
            __builtin_amdgcn_sched_barrier(0); }
        return ps == 2;
    }
};

template <class Sched, class Epi, bool FP8 = false, bool ALIGN_EPI = true, bool SP2 = true>
__device__ __forceinline__ void gemm_phase(LAS unsigned char* lds, const Sched& S, const Epi& E) {
    const int tid = opaque_tid(), wid = __builtin_amdgcn_readfirstlane(tid >> 6), lane = tid & 63, wr = wid >> 2, wc = wid & 3, fr = lane & 15, fq = lane >> 4;
    const unsigned cla = S.lda2, clb = S.ldb2;
    unsigned RA[2], RB[2];
#pragma unroll
    for (int i = 0; i < 2; ++i) { int R, C; stage_rc(tid * 16 + i * 8192, R, C); const int Rb = Epi::PERM ? ((R & ~31) + perm32(R & 31)) : R;
        RA[i] = (unsigned)R * cla + (unsigned)C * 2u; RB[i] = (unsigned)Rb * clb + (unsigned)C * 2u; }
    const size_t kstep = (size_t)(BK * 2);
    const unsigned ldsw = (unsigned)wid * 1024u;
    unsigned ofs_slot = (unsigned)tid * 16u;
    if constexpr (FP8) { u32x4 o4; o4[0] = RA[0]; o4[1] = RA[1]; o4[2] = RB[0]; o4[3] = RB[1]; *(LAS u32x4*)(lds + STAGE_BYTES + ofs_slot) = o4; asm volatile("" : "+v"(ofs_slot)); }
    const int aoff = lds_byte(wr * 64 + fr, fq * 8), boff = lds_byte(wc * 32 + fr, fq * 8);
#define PG8_SA(b, h) (((b) * 2 + (h)) * HTB)
#define PG8_SB(b, h) ((4 + (b) * 2 + (h)) * HTB)
#define PG8_STG(bufoff, gbase, RR, ld2) do { if constexpr (FP8) {   \
            const u32x4 _o4 = *(const LAS u32x4*)(lds + STAGE_BYTES + ofs_slot); const bool _isB = (&(RR)[0] == &RB[0]); \
            _Pragma("unroll") for (int _i = 0; _i < 2; ++_i) \
            __builtin_amdgcn_global_load_lds((const unsigned*)((const char*)(gbase) + (_isB ? _o4[2 + _i] : _o4[_i])), (LAS unsigned*)(lds + (bufoff) + ldsw + _i * 8192), 16, 0, 0); } \
        else { _Pragma("unroll") for (int _i = 0; _i < 2; ++_i) \
        __builtin_amdgcn_global_load_lds((const unsigned*)((const char*)(gbase) + (RR)[_i]), (LAS unsigned*)(lds + (bufoff) + ldsw + _i * 8192), 16, 0, 0); } } while (0)
#define PG8_LDA(dst, b, h) do { if constexpr (FP8) { _Pragma("unroll") for (int m = 0; m < 4; ++m) { \
            const u32x4 _lo = *(const LAS u32x4*)(lds + PG8_SA(b, h) + aoff + m * 2048), _hi = *(const LAS u32x4*)(lds + PG8_SA(b, h) + aoff + m * 2048 + 1024); \
            dst##_8[m] = __builtin_shufflevector(_lo, _hi, 0, 1, 2, 3, 4, 5, 6, 7); } } \
        else { _Pragma("unroll") for (int m = 0; m < 4; ++m) _Pragma("unroll") for (int k = 0; k < 2; ++k) dst[m][k] = *(const LAS bf16x8*)(lds + PG8_SA(b, h) + aoff + m * 2048 + k * 1024); } } while (0)
#define PG8_LDB(dst, b, h) do { if constexpr (FP8) { _Pragma("unroll") for (int n = 0; n < 2; ++n) { \
            const u32x4 _lo = *(const LAS u32x4*)(lds + PG8_SB(b, h) + boff + n * 2048), _hi = *(const LAS u32x4*)(lds + PG8_SB(b, h) + boff + n * 2048 + 1024); \
            dst##_8[n] = __builtin_shufflevector(_lo, _hi, 0, 1, 2, 3, 4, 5, 6, 7); } } \
        else { _Pragma("unroll") for (int n = 0; n < 2; ++n) _Pragma("unroll") for (int k = 0; k < 2; ++k) dst[n][k] = *(const LAS bf16x8*)(lds + PG8_SB(b, h) + boff + n * 2048 + k * 1024); } } while (0)
#define PG8_MMA(ai, bj, At, Bt) do { __builtin_amdgcn_s_setprio(1); \
        if constexpr (FP8) { _Pragma("unroll") for (int m = 0; m < 4; ++m) _Pragma("unroll") for (int n = 0; n < 2; ++n) \
            acc[ai][bj][m][n] = __builtin_amdgcn_mfma_scale_f32_16x16x128_f8f6f4(__builtin_bit_cast(i32x8, Bt##_8[n]), __builtin_bit_cast(i32x8, At##_8[m]), acc[ai][bj][m][n], 0, 0, 0, 0x7f7f7f7f, 0, 0x7f7f7f7f); } \
        else { _Pragma("unroll") for (int m = 0; m < 4; ++m) _Pragma("unroll") for (int n = 0; n < 2; ++n) _Pragma("unroll") for (int k = 0; k < 2; ++k) \
            acc[ai][bj][m][n] = __builtin_amdgcn_mfma_f32_16x16x32_bf16(Bt[n][k], At[m][k], acc[ai][bj][m][n], 0, 0, 0); } \
        __builtin_amdgcn_s_setprio(0); } while (0)
#define PG8_WAIT_V(n) asm volatile("s_waitcnt vmcnt(" #n ")" ::: "memory")
#define PG8_WAIT_L(n) asm volatile("s_waitcnt lgkmcnt(" #n ")" ::: "memory")
#define PG8_BAR __builtin_amdgcn_s_barrier()
#define PG8_SCHED __builtin_amdgcn_sched_barrier(0)
    Seg cur, nxt; int si = 0;
    if (!S.get(0, cur)) return;
    f32x4 acc[2][2][4][2];
#pragma unroll
    for (int a = 0; a < 2; ++a)
#pragma unroll
        for (int b = 0; b < 2; ++b)
#pragma unroll
            for (int m = 0; m < 4; ++m)
#pragma unroll
                for (int n = 0; n < 2; ++n) acc[a][b][m][n] = (f32x4){0.f, 0.f, 0.f, 0.f};
    bf16x8 At[4][2], B0[2][2], B1[2][2];
    u32x8 At_8[4], B0_8[2], B1_8[2];
    const char* cA = cur.A; const char* cB = cur.B;
    if constexpr (SP2) {
        PG8_STG(PG8_SB(0, 0), cB, RB, clb); PG8_STG(PG8_SB(0, 1), cB + (size_t)HALF * clb, RB, clb); PG8_STG(PG8_SA(0, 0), cA, RA, cla); PG8_STG(PG8_SA(0, 1), cA + (size_t)HALF * cla, RA, cla);
        if (wr == 1) PG8_BAR;
        PG8_WAIT_V(2); PG8_BAR;
        PG8_STG(PG8_SB(1, 0), cB + kstep, RB, clb); PG8_STG(PG8_SA(1, 0), cA + kstep, RA, cla); PG8_STG(PG8_SB(1, 1), cB + (size_t)HALF * clb + kstep, RB, clb);
        PG8_WAIT_V(6); PG8_BAR;
    } else {
    PG8_STG(PG8_SB(0, 0), cB, RB, clb); PG8_STG(PG8_SA(0, 0), cA, RA, cla); PG8_STG(PG8_SB(0, 1), cB + (size_t)HALF * clb, RB, clb); PG8_STG(PG8_SA(0, 1), cA + (size_t)HALF * cla, RA, cla);
    if (wr == 1) PG8_BAR;
    PG8_WAIT_V(4); PG8_BAR;
    PG8_STG(PG8_SB(1, 0), cB + kstep, RB, clb); PG8_STG(PG8_SA(1, 0), cA + kstep, RA, cla); PG8_STG(PG8_SB(1, 1), cB + (size_t)HALF * clb + kstep, RB, clb);
    PG8_WAIT_V(6); PG8_BAR;
    }
    for (;;) {
        const bool has_next = S.get(si + 1, nxt);
        const char* nA = has_next ? nxt.A : cA; const char* nB = has_next ? nxt.B : cB;
        const int nt = cur.nt;
        for (int t = 0; t < nt; t += 2) {
            const bool last = (t == nt - 2);
            const char* a1 = cA + (size_t)(t + 1) * kstep;
            const char* a2 = last ? nA : cA + (size_t)(t + 2) * kstep; const char* b2 = last ? nB : cB + (size_t)(t + 2) * kstep;
            const unsigned la2 = cla, lb2 = clb;
            const char* a3 = a2 + kstep; const char* b3 = b2 + kstep;
            if constexpr (SP2) {
            PG8_LDB(B0, 0, 0); PG8_LDB(B1, 0, 1); PG8_SCHED; PG8_LDA(At, 0, 0); PG8_STG(PG8_SA(1, 1), a1 + (size_t)HALF * cla, RA, cla);
            PG8_WAIT_V(8); PG8_WAIT_L(0); PG8_BAR; PG8_MMA(0, 0, At, B0); PG8_MMA(0, 1, At, B1); PG8_BAR; PG8_SCHED;
            PG8_LDA(At, 0, 1); PG8_STG(PG8_SB(0, 0), b2, RB, lb2); PG8_STG(PG8_SB(0, 1), b2 + (size_t)HALF * lb2, RB, lb2); PG8_STG(PG8_SA(0, 0), a2, RA, la2);
            PG8_WAIT_V(8); PG8_WAIT_L(0); PG8_BAR; PG8_MMA(1, 0, At, B0); PG8_MMA(1, 1, At, B1); PG8_BAR; PG8_SCHED;
            PG8_LDB(B0, 1, 0); PG8_LDB(B1, 1, 1); PG8_SCHED; PG8_LDA(At, 1, 0); PG8_STG(PG8_SA(0, 1), a2 + (size_t)HALF * la2, RA, la2);
            PG8_WAIT_V(8); PG8_WAIT_L(0); PG8_BAR; PG8_MMA(0, 0, At, B0); PG8_MMA(0, 1, At, B1); PG8_BAR; PG8_SCHED;
            PG8_LDA(At, 1, 1); PG8_STG(PG8_SB(1, 0), b3, RB, lb2); PG8_STG(PG8_SB(1, 1), b3 + (size_t)HALF * lb2, RB, lb2); PG8_STG(PG8_SA(1, 0), a3, RA, la2);
            PG8_WAIT_V(8); PG8_WAIT_L(0); PG8_BAR; PG8_MMA(1, 0, At, B0); PG8_MMA(1, 1, At, B1); PG8_BAR; PG8_SCHED;
            } else {
            PG8_LDB(B0, 0, 0); PG8_SCHED; PG8_LDA(At, 0, 0); PG8_STG(PG8_SA(1, 1), a1 + (size_t)HALF * cla, RA, cla);
            PG8_WAIT_L(8); PG8_BAR; PG8_WAIT_L(0); PG8_MMA(0, 0, At, B0); PG8_BAR; PG8_SCHED;
            PG8_LDB(B1, 0, 1); PG8_STG(PG8_SB(0, 0), b2, RB, lb2);
            PG8_BAR; PG8_WAIT_L(0); PG8_MMA(0, 1, At, B1); PG8_BAR;
            PG8_LDA(At, 0, 1); PG8_STG(PG8_SA(0, 0), a2, RA, la2);
            PG8_BAR; PG8_WAIT_L(0); PG8_MMA(1, 0, At, B0); PG8_BAR; PG8_SCHED;
            PG8_STG(PG8_SB(0, 1), b2 + (size_t)HALF * lb2, RB, lb2);
            PG8_WAIT_V(6); PG8_BAR; PG8_MMA(1, 1, At, B1); PG8_BAR;
            PG8_LDB(B0, 1, 0); PG8_SCHED; PG8_LDA(At, 1, 0); PG8_STG(PG8_SA(0, 1), a2 + (size_t)HALF * la2, RA, la2);
            PG8_WAIT_L(8); PG8_BAR; PG8_WAIT_L(0); PG8_MMA(0, 0, At, B0); PG8_BAR; PG8_SCHED;
            PG8_LDB(B1, 1, 1); PG8_STG(PG8_SB(1, 0), b3, RB, lb2);
            PG8_BAR; PG8_WAIT_L(0); PG8_MMA(0, 1, At, B1); PG8_BAR;
            PG8_LDA(At, 1, 1); PG8_STG(PG8_SA(1, 0), a3, RA, la2);
            PG8_BAR; PG8_WAIT_L(0); PG8_MMA(1, 0, At, B0); PG8_BAR; PG8_SCHED;
            PG8_STG(PG8_SB(1, 1), b3 + (size_t)HALF * lb2, RB, lb2);
            PG8_WAIT_V(6); PG8_BAR; PG8_MMA(1, 1, At, B1); PG8_BAR;
            }
        }
        if constexpr (ALIGN_EPI) { if (wr == 0) PG8_BAR; }
        const bool done = E.after(acc, cur, wr, wc, fr, fq);
        if (!has_next) break;
        if (done) {
#pragma unroll
            for (int a = 0; a < 2; ++a)
#pragma unroll
                for (int b = 0; b < 2; ++b)
#pragma unroll
                    for (int m = 0; m < 4; ++m)
#pragma unroll
                        for (int n = 0; n < 2; ++n) acc[a][b][m][n] = (f32x4){0.f, 0.f, 0.f, 0.f};
        }
        cur = nxt; cA = nA; cB = nB; ++si;
        if constexpr (ALIGN_EPI) { if (wr == 1) PG8_BAR; }
    }
    PG8_WAIT_V(0);
    if constexpr (!ALIGN_EPI) { if (wr == 0) PG8_BAR; }
    PG8_BAR;
#undef PG8_SA
#undef PG8_SB
#undef PG8_STG
#undef PG8_LDA
#undef PG8_LDB
#undef PG8_MMA
#undef PG8_WAIT_V
#undef PG8_WAIT_L
#undef PG8_BAR
#undef PG8_SCHED
}
}

__device__ __forceinline__ void phase0(const P& p, LAS unsigned char* lds) {
    float* mod = (float*)(p.ws + WS_MOD);
    LAS float* sc = (LAS float*)lds;
    LAS float* red = sc + 4096;
    const int tid = opaque_tid();
    for (int i = tid; i < 4096; i += NTHREADS) { const float v = p.c[i]; sc[i] = v / (1.0f + __expf(-v)); }
    __syncthreads();
    const int cl = tid & 63, kg = tid >> 6;
    for (int item = blockIdx.x; item < DEPTH * 96; item += gridDim.x) {
        const int l = item / 96, j = (item % 96) * 64 + cl;
        const float* w = p.w_mod + (size_t)l * 1024 * 6144 + j;
        float a0 = 0.f, a1 = 0.f, a2 = 0.f, a3 = 0.f;
#pragma unroll 8
        for (int k = kg * 128; k < kg * 128 + 128; ++k) { const float wv = w[(size_t)k * 6144]; a0 += sc[k] * wv; a1 += sc[1024 + k] * wv; a2 += sc[2048 + k] * wv; a3 += sc[3072 + k] * wv; }
        red[(kg * 64 + cl) * 4 + 0] = a0; red[(kg * 64 + cl) * 4 + 1] = a1; red[(kg * 64 + cl) * 4 + 2] = a2; red[(kg * 64 + cl) * 4 + 3] = a3;
        __syncthreads();
        if (tid < 256) { const int b = tid >> 6, c2 = tid & 63; float s = 0.f;
#pragma unroll
            for (int g = 0; g < 8; ++g) s += red[(g * 64 + c2) * 4 + b];
            const int jj = (item % 96) * 64 + c2; mod[(size_t)(l * 4 + b) * 6144 + jj] = s + p.b_mod[l * 6144 + jj]; }
        __syncthreads();
    }
    float* biasA = (float*)(p.ws + WS_BIASA); float* biasC = (float*)(p.ws + WS_BIASC);
    if (blockIdx.x == 0 && tid < DEPTH) {
        float biasmax = 0.f, ga = 0.f, gc = 0.f;
        for (int i = 0; i < 32 * 16; ++i) biasmax = fmaxf(biasmax, fabsf(p.rel_bias[i]));
        for (int d = 0; d < 64; ++d) { ga = fmaxf(ga, fabsf(p.qnorm_a[tid * 64 + d] * p.knorm_a[tid * 64 + d])); gc = fmaxf(gc, fabsf(p.qnorm_c[tid * 64 + d] * p.knorm_c[tid * 64 + d])); }
        float* mb = (float*)(p.ws + WS_MB); mb[tid * 2] = 8.0f * 1.03f * ga + biasmax; mb[tid * 2 + 1] = 8.0f * 1.03f * gc + biasmax; }
    for (int i = blockIdx.x * NTHREADS + tid; i < 8 * 8192; i += gridDim.x * NTHREADS) { const int h = i >> 13, d = i & 8191; biasC[i] = p.rel_bias[t5_bucket(d) * 16 + 8 + h]; }
    for (int i = blockIdx.x * NTHREADS + tid; i < 8 * 128; i += gridDim.x * NTHREADS) { const int h = i >> 7, d = i & 127; biasA[i] = p.rel_bias[t5_bucket(d) * 16 + h]; }
}

__device__ __forceinline__ void phase_norm(const float* xsrc, const float* gain, const float* mod_l, int shift_off, int scale_off, int b0, bf16_t* H, unsigned char* H8) {
    const int tid = opaque_tid(), wid = tid >> 6, lane = tid & 63;
    constexpr int RPW = TC / (256 * 8);
    const int wglob = blockIdx.x * 8 + wid, nw = gridDim.x * 8;
    for (int r0 = wglob * 4; r0 < TC; r0 += nw * 4) {
        f32x4 v[4][4]; float ss[4];
#pragma unroll
        for (int q = 0; q < 4; ++q) { const f32x4* xr = (const f32x4*)(xsrc + (size_t)(r0 + q) * DM);
#pragma unroll
            for (int i = 0; i < 4; ++i) v[q][i] = xr[lane + 64 * i]; }
#pragma unroll
        for (int q = 0; q < 4; ++q) { float a = 0.f;
#pragma unroll
            for (int i = 0; i < 4; ++i) a += v[q][i][0] * v[q][i][0] + v[q][i][1] * v[q][i][1] + v[q][i][2] * v[q][i][2] + v[q][i][3] * v[q][i][3];
            ss[q] = a; }
#pragma unroll
        for (int off = 32; off >= 1; off >>= 1) {
#pragma unroll
            for (int q = 0; q < 4; ++q) ss[q] += __shfl_xor(ss[q], off); }
        const float* mb = mod_l + (size_t)(b0 + r0 / SEQ) * 6144;
#pragma unroll
        for (int i = 0; i < 4; ++i) { const int col = (lane + 64 * i) * 4;
            const f32x4 g = *(const f32x4*)(gain + col), sc = *(const f32x4*)(mb + scale_off + col), sh = *(const f32x4*)(mb + shift_off + col);
#pragma unroll
            for (int q = 0; q < 4; ++q) { const float rinv = rsqrtf(ss[q] * (1.0f / 1024.0f) + RMS_EPS);
                float h[4];
#pragma unroll
                for (int e = 0; e < 4; ++e) h[e] = (v[q][i][e] * rinv * g[e]) * (1.0f + sc[e]) + sh[e];
                u32x2 pk; pk[0] = cvt_pk_bf16(h[0], h[1]); pk[1] = cvt_pk_bf16(h[2], h[3]);
                *(u32x2*)(H + (size_t)(r0 + q) * DM + col) = pk;
                if (H8) { unsigned p8 = 0u; p8 = __builtin_amdgcn_cvt_pk_fp8_f32(h[0], h[1], p8, false); p8 = __builtin_amdgcn_cvt_pk_fp8_f32(h[2], h[3], p8, true);
                    *(unsigned*)(H8 + (size_t)(r0 + q) * DM + col) = p8; } } }
    }
    (void)RPW;
}

__device__ __forceinline__ void phase_convert(const P& p, int l, LAS unsigned char* lds) {
    LAS float* t = (LAS float*)lds;
    constexpr int NJ = 8;
    const float* srcs[NJ] = { p.w_in + (size_t)l * 1024 * DIN, p.w_branch + (size_t)l * 2048 * 1024, p.w_out + (size_t)l * 1024 * 1024, p.w_up + (size_t)l * 1024 * DFF2,
        p.w_down + (size_t)l * DFF * 1024, p.ga_w + (size_t)l * 1024 * 64, p.gx_w + (size_t)l * 1024 * 64, p.w_in + (size_t)l * 1024 * DIN + C_G };
    const int Ks[NJ] = { 1024, 2048, 1024, 1024, DFF, 1024, 1024, 1024 };
    const int Ns[NJ] = { C_G, 1024, 1024, DFF2, 1024, 64, 64, 3072 };
    const int Ls[NJ] = { DIN, 1024, 1024, DFF2, 1024, 64, 64, DIN };
    const size_t dsts[NJ] = { WS_WIN, WS_WB, WS_WOUT, WS_WUP, WS_WDOWN, WS_GT, WS_GT + (size_t)64 * 1024 * 2, WS_WG8 };
    const int tid = opaque_tid();
    const int r = tid >> 4, c4 = (tid & 15) * 4, n = tid >> 3, kk = (tid & 7) * 8;
    int base = 0;
#pragma unroll
    for (int j = 0; j < NJ; ++j) {
        const int tn = Ns[j] / 64, ntile = (Ks[j] / 64) * tn;
        const float* src = srcs[j]; const int ldn = Ls[j], ldk = Ks[j]; bf16_t* dst = (bf16_t*)(p.ws + dsts[j]);
        int ti = (int)blockIdx.x - (base % (int)gridDim.x); if (ti < 0) ti += gridDim.x;
        f32x4 v0 = (f32x4){0.f, 0.f, 0.f, 0.f}, v1 = v0;
        if (ti < ntile) { const int kt = ti / tn, nn = ti - kt * tn; const float* sp = src + (size_t)(kt * 64 + r) * ldn + nn * 64 + c4; v0 = *(const f32x4*)sp; v1 = *(const f32x4*)(sp + (size_t)32 * ldn); }
        for (; ti < ntile; ti += gridDim.x) {
            const int kt = ti / tn, nn = ti - kt * tn;
            t[r * 65 + c4 + 0] = v0[0]; t[r * 65 + c4 + 1] = v0[1]; t[r * 65 + c4 + 2] = v0[2]; t[r * 65 + c4 + 3] = v0[3];
            t[(r + 32) * 65 + c4 + 0] = v1[0]; t[(r + 32) * 65 + c4 + 1] = v1[1]; t[(r + 32) * 65 + c4 + 2] = v1[2]; t[(r + 32) * 65 + c4 + 3] = v1[3];
            __syncthreads();
            const int tnx = ti + (int)gridDim.x;
            if (tnx < ntile) { const int kt2 = tnx / tn, nn2 = tnx - kt2 * tn; const float* sp = src + (size_t)(kt2 * 64 + r) * ldn + nn2 * 64 + c4; v0 = *(const f32x4*)sp; v1 = *(const f32x4*)(sp + (size_t)32 * ldn); }
            if (j == 7) { u32x2 p8; p8[0] = 0u; p8[1] = 0u;
#pragma unroll
                for (int q = 0; q < 2; ++q) { p8[q] = __builtin_amdgcn_cvt_pk_fp8_f32(t[(kk + 4 * q) * 65 + n] * 64.0f, t[(kk + 4 * q + 1) * 65 + n] * 64.0f, p8[q], false);
                    p8[q] = __builtin_amdgcn_cvt_pk_fp8_f32(t[(kk + 4 * q + 2) * 65 + n] * 64.0f, t[(kk + 4 * q + 3) * 65 + n] * 64.0f, p8[q], true); }
                *(u32x2*)((unsigned char*)dst + (size_t)(nn * 64 + n) * ldk + kt * 64 + kk) = p8; }
            else { u32x4 pk;
#pragma unroll
                for (int q = 0; q < 4; ++q) pk[q] = cvt_pk_bf16(t[(kk + 2 * q) * 65 + n], t[(kk + 2 * q + 1) * 65 + n]);
                *(u32x4*)(dst + (size_t)(nn * 64 + n) * ldk + kt * 64 + kk) = pk; }
            __syncthreads();
        }
        base += ntile;
    }
}

__device__ __forceinline__ void phase_qknorm(const P& p, int l, bf16_t* z) {
    const int tid = opaque_tid(), wid = tid >> 6, lane = tid & 63, g8 = lane & 7;
    float gqa[8], gka[8], gqc[8];
#pragma unroll
    for (int j = 0; j < 8; ++j) { gqa[j] = p.qnorm_a[l * 64 + g8 * 8 + j]; gka[j] = p.knorm_a[l * 64 + g8 * 8 + j]; gqc[j] = p.qnorm_c[l * 64 + g8 * 8 + j]; }
    for (int r0 = (blockIdx.x * 8 + wid) * 4; r0 < TC; r0 += gridDim.x * 8 * 4) {
        u32x4 raw[4][3];
#pragma unroll
        for (int q = 0; q < 4; ++q) { const bf16_t* rowp = z + (size_t)(r0 + q) * DIN;
            raw[q][0] = *(const u32x4*)(rowp + C_QA + lane * 8); raw[q][1] = *(const u32x4*)(rowp + C_KA + (lane & 15) * 8); raw[q][2] = *(const u32x4*)(rowp + C_QC + lane * 8); }
#pragma unroll
        for (int q = 0; q < 4; ++q) { bf16_t* rowp = z + (size_t)(r0 + q) * DIN;
#pragma unroll
            for (int it = 0; it < 3; ++it) {
                const int col = (it == 0) ? C_QA + lane * 8 : (it == 1) ? C_KA + (lane & 15) * 8 : C_QC + lane * 8;
                float f[8]; unpack8(raw[q][it], f);
                float ss = 0.f;
#pragma unroll
                for (int j = 0; j < 8; ++j) ss += f[j] * f[j];
                ss += __shfl_xor(ss, 1); ss += __shfl_xor(ss, 2); ss += __shfl_xor(ss, 4);
                const float rinv = rsqrtf(ss * (1.0f / 64.0f) + RMS_EPS);
                u32x4 pk;
#pragma unroll
                for (int j = 0; j < 4; ++j) { const float g0 = (it == 0) ? gqa[2 * j] : (it == 1) ? gka[2 * j] : gqc[2 * j], g1 = (it == 0) ? gqa[2 * j + 1] : (it == 1) ? gka[2 * j + 1] : gqc[2 * j + 1];
                    pk[j] = cvt_pk_bf16(f[2 * j] * rinv * g0, f[2 * j + 1] * rinv * g1); }
                if (it != 1 || lane < 16) *(u32x4*)(rowp + col) = pk;
            } }
    }
}
__device__ __forceinline__ void phase_kcnorm(const P& p, int l, bf16_t* z, LAS unsigned char* lds) {
    LAS float* red = (LAS float*)lds;
    LAS bf16_t* sT = (LAS bf16_t*)(lds + 16384);
    float* kmean = (float*)(p.ws + WS_KMEAN);
    const int tid = opaque_tid(), g8 = tid & 7, tg = tid >> 3;
    float gk[8];
#pragma unroll
    for (int j = 0; j < 8; ++j) gk[j] = p.knorm_c[l * 64 + g8 * 8 + j];
    for (int item = blockIdx.x; item < BPC * 8 * 32; item += gridDim.x) {
        const int m = item & 31, h = (item >> 5) & 7, bl = item >> 8;
        bf16_t* kbase = z + ((size_t)bl * SEQ + m * 256 + tg) * DIN + C_KC + h * 64 + g8 * 8;
        u32x4 kraw[4], vraw[4];
#pragma unroll
        for (int ps = 0; ps < 4; ++ps) kraw[ps] = *(const u32x4*)(kbase + (size_t)ps * 64 * DIN);
#pragma unroll
        for (int k = 0; k < 4; ++k) { const int i = tid + k * NTHREADS, kj = i >> 3, c8 = (i & 7) * 8;
            vraw[k] = *(const u32x4*)(z + ((size_t)bl * SEQ + m * 256 + kj) * DIN + C_VC + h * 64 + c8); }
        float ms[8];
#pragma unroll
        for (int j = 0; j < 8; ++j) ms[j] = 0.f;
#pragma unroll
        for (int ps = 0; ps < 4; ++ps) {
            float f[8]; unpack8(kraw[ps], f);
            float ss = 0.f;
#pragma unroll
            for (int j = 0; j < 8; ++j) ss += f[j] * f[j];
            ss += __shfl_xor(ss, 1); ss += __shfl_xor(ss, 2); ss += __shfl_xor(ss, 4);
            const float rinv = rsqrtf(ss * (1.0f / 64.0f) + RMS_EPS);
            float y[8];
#pragma unroll
            for (int j = 0; j < 8; ++j) { y[j] = f[j] * rinv * gk[j]; ms[j] += y[j]; }
            u32x4 pk;
#pragma unroll
            for (int j = 0; j < 4; ++j) pk[j] = cvt_pk_bf16(y[2 * j], y[2 * j + 1]);
            *(u32x4*)(kbase + (size_t)ps * 64 * DIN) = pk;
        }
#pragma unroll
        for (int j = 0; j < 8; ++j) red[tg * 64 + g8 * 8 + j] = ms[j];
#pragma unroll
        for (int k = 0; k < 4; ++k) { const int i = tid + k * NTHREADS, kj = i >> 3, c8 = (i & 7) * 8; *(LAS u32x4*)(sT + kj * 72 + c8) = vraw[k]; }
        __syncthreads();
        if (tid < 64) { float sm = 0.f; for (int g = 0; g < 64; ++g) sm += red[g * 64 + tid]; kmean[((size_t)(bl * 8 + h) * 32 + m) * 64 + tid] = sm * (1.0f / 256.0f); }
        {
            bf16_t* Vtg = (bf16_t*)(p.ws + WS_VTC) + (size_t)(bl * 8 + h) * 64 * SEQ;
            const int d = tid >> 3, tgp = tid & 7;
#pragma unroll
            for (int g = 0; g < 4; ++g) { const int t8 = tgp * 32 + g * 8; u32x4 pk;
#pragma unroll
                for (int j = 0; j < 4; ++j) pk[j] = (unsigned)sT[(t8 + 2 * j) * 72 + d] | ((unsigned)sT[(t8 + 2 * j + 1) * 72 + d] << 16);
                *(u32x4*)(Vtg + (size_t)d * SEQ + m * 256 + t8) = pk; }
        }
        __syncthreads();
    }
}

__device__ __forceinline__ void phase_rnn0(const P& p, int l, LAS unsigned char* lds, const bf16_t* z) {
    LAS float* sX = (LAS float*)lds;
    LAS float* sA = sX + 131 * 64 + 64;
    LAS float* sU = sA + 128 * 64;
    LAS float* sS = sU + 128 * 64;
    LAS bf16_t* sXb = (LAS bf16_t*)(sS + 8 * 64 * 2);
    LAS bf16_t* sGt = sXb + 128 * 72;
    float* rsum = (float*)(p.ws + WS_RSUM);
    const bf16_t* Gt = (const bf16_t*)(p.ws + WS_GT);
    bf16_t* OM = (bf16_t*)(p.ws + WS_ACT); bf16_t* UU = OM + (size_t)TC * 1024;
    const int tid = opaque_tid(), wid = tid >> 6, lane = tid & 63, fr = lane & 15, fq = lane >> 4;
    const int nbg = (int)gridDim.x >> 4;
    const int nb = blockIdx.x & 15, first = (int)blockIdx.x >> 4;
    if (first >= nbg) return;
    for (int i = tid; i < 2 * 64 * 8; i += NTHREADS) { const int g = i >> 9, d = (i >> 3) & 63, c8 = (i & 7) * 8;
        *(LAS u32x4*)(sGt + (g * 64 + d) * 72 + c8) = *(const u32x4*)(Gt + (size_t)g * 64 * 1024 + (size_t)d * 1024 + nb * 64 + c8); }
    const int ch = nb * 64 + lane;
    const float w0 = p.rnn_conv_w[(size_t)(l * 4 + 0) * 1024 + ch], w1 = p.rnn_conv_w[(size_t)(l * 4 + 1) * 1024 + ch], w2 = p.rnn_conv_w[(size_t)(l * 4 + 2) * 1024 + ch],
                w3 = p.rnn_conv_w[(size_t)(l * 4 + 3) * 1024 + ch], cb = p.rnn_conv_b[l * 1024 + ch];
    float bra[4], bix[4], spv[4];
#pragma unroll
    for (int nt = 0; nt < 4; ++nt) { const int chd = nb * 64 + nt * 16 + fr; bra[nt] = p.ga_b[l * 1024 + chd]; bix[nt] = p.gx_b[l * 1024 + chd];
        const float lamv = p.lam[l * 1024 + chd]; spv[nt] = (lamv > 15.f) ? __expf(-lamv) : log1p_small(__expf(-lamv)); }
    u32x4 xr[3];
#define RNN_PREFETCH(idx_) do { const int bl_ = (idx_) >> 6, t0_ = ((idx_) & 63) * 128; _Pragma("unroll") for (int k_ = 0; k_ < 3; ++k_) { const int i_ = tid + k_ * NTHREADS; const int rr_ = i_ >> 3, c8_ = (i_ & 7) * 8, t_ = t0_ - 3 + rr_; \
        xr[k_] = (u32x4){0u, 0u, 0u, 0u}; if (i_ < 131 * 8 && t_ >= 0) xr[k_] = *(const u32x4*)(z + ((size_t)bl_ * SEQ + t_) * DIN + C_XR + nb * 64 + c8_); } } while (0)
    RNN_PREFETCH(first);
    for (int idx = first; idx < BPC * 64; idx += nbg) {
        const int bl = idx >> 6, seg = idx & 63, t0 = seg * 128;
#pragma unroll
        for (int k = 0; k < 3; ++k) { const int i = tid + k * NTHREADS; if (i < 131 * 8) { const int rr = i >> 3, c8 = (i & 7) * 8; float f[8]; unpack8(xr[k], f);
            *(LAS f32x4*)(sX + rr * 64 + c8) = (f32x4){f[0], f[1], f[2], f[3]}; *(LAS f32x4*)(sX + rr * 64 + c8 + 4) = (f32x4){f[4], f[5], f[6], f[7]}; } }
        __syncthreads();
        if (idx + nbg < BPC * 64) RNN_PREFETCH(idx + nbg);
#pragma unroll
        for (int i = 0; i < 16; ++i) { const int tt = wid * 16 + i;
            const float xc = cb + w0 * sX[(tt + 0) * 64 + lane] + w1 * sX[(tt + 1) * 64 + lane] + w2 * sX[(tt + 2) * 64 + lane] + w3 * sX[(tt + 3) * 64 + lane];
            sXb[tt * 72 + lane] = f2bf(xc); }
        __syncthreads();
        { bf16x8 a[2];
#pragma unroll
          for (int ks = 0; ks < 2; ++ks) a[ks] = *(const LAS bf16x8*)(sXb + (16 * wid + fr) * 72 + ks * 32 + fq * 8);
#pragma unroll
          for (int nt = 0; nt < 4; ++nt) {
              f32x4 ar = (f32x4){0.f, 0.f, 0.f, 0.f}, ai = (f32x4){0.f, 0.f, 0.f, 0.f};
#pragma unroll
              for (int ks = 0; ks < 2; ++ks) {
                  const bf16x8 br = *(const LAS bf16x8*)(sGt + (nt * 16 + fr) * 72 + ks * 32 + fq * 8);
                  const bf16x8 bi = *(const LAS bf16x8*)(sGt + (64 + nt * 16 + fr) * 72 + ks * 32 + fq * 8);
                  ar = mfma16(a[ks], br, ar); ai = mfma16(a[ks], bi, ai); }
              const int d = nt * 16 + fr;
#pragma unroll
              for (int j = 0; j < 4; ++j) { const int tok = 16 * wid + 4 * fq + j;
                  const float r = __builtin_amdgcn_rcpf(1.0f + __expf(-(ar[j] + bra[nt]))), ig = __builtin_amdgcn_rcpf(1.0f + __expf(-(ai[j] + bix[nt])));
                  const float log_a = -8.0f * r * spv[nt]; const float av = __expf(log_a);
                  const float x2 = 2.0f * log_a;
                  const float om2 = (x2 > -0.25f) ? -x2 * (1.0f + x2 * (0.5f + x2 * (0.16666667f + x2 * (0.041666668f + x2 * (0.0083333338f + x2 * 0.0013888889f))))) : 1.0f - av * av;
                  float mult = __builtin_amdgcn_sqrtf(fmaxf(om2, 0.f));
                  if (t0 + tok == 0) mult = 1.0f;
                  sA[tok * 64 + d] = av; sU[tok * 64 + d] = mult * (ig * bf2f((unsigned)sXb[tok * 72 + d])); }
          } }
        __syncthreads();
        { float hl = 0.f, Pp = 1.f;
          const unsigned go0 = (unsigned)((bl * SEQ + t0 + wid * 16) * 1024 + ch);
#pragma unroll 4
          for (int i = 0; i < 16; ++i) { const int tt = wid * 16 + i;
              const bf16_t omb = f2bf(1.0f - sA[tt * 64 + lane]), ub = f2bf(sU[tt * 64 + lane]);
              const float av = 1.0f - bf2f((unsigned)omb), uv = bf2f((unsigned)ub);
              OM[go0 + (unsigned)i * 1024u] = omb; UU[go0 + (unsigned)i * 1024u] = ub;
              hl = av * hl + uv; Pp *= av; }
          sS[(wid * 64 + lane) * 2] = Pp; sS[(wid * 64 + lane) * 2 + 1] = hl; }
        __syncthreads();
        if (wid == 0) { float Pt = 1.f, Ht = 0.f;
#pragma unroll
            for (int w = 0; w < 8; ++w) { const float Pw = sS[(w * 64 + lane) * 2], Hw = sS[(w * 64 + lane) * 2 + 1]; Ht = Pw * Ht + Hw; Pt *= Pw; }
            float* o = rsum + ((size_t)(bl * 64 + seg) * 1024 + ch) * 2; o[0] = Pt; o[1] = Ht; }
    }
#undef RNN_PREFETCH
    __syncthreads();
}

__device__ __forceinline__ void phase_rnn_apply(const P& p, LAS unsigned char* lds, bf16_t* z) {
    LAS float* sS = (LAS float*)lds;
    LAS float* sC = sS + 8 * 64 * 2;
    const float* rsum = (const float*)(p.ws + WS_RSUM);
    const bf16_t* OM = (const bf16_t*)(p.ws + WS_ACT); const bf16_t* UU = OM + (size_t)TC * 1024;
    const int tid = opaque_tid(), wid = tid >> 6, lane = tid & 63;
    constexpr int N_RNN = BPC * 16 * 64;
    unsigned short ra[16], ru[16], ry[16]; float pp[8], hh[8];
#define RNN1_PREFETCH(j_) do { const int seg_ = (j_) & 63, nb_ = ((j_) >> 6) & 15, bl_ = (j_) >> 10; const int ch_ = nb_ * 64 + lane; const unsigned r_ = (unsigned)(bl_ * SEQ + seg_ * 128 + wid * 16); \
        _Pragma("unroll") for (int i_ = 0; i_ < 16; ++i_) { ra[i_] = OM[(r_ + i_) * 1024u + ch_]; ru[i_] = UU[(r_ + i_) * 1024u + ch_]; ry[i_] = z[(size_t)(r_ + i_) * DIN + C_YR + ch_]; } \
        _Pragma("unroll") for (int k_ = 0; k_ < 8; ++k_) { const int s2_ = wid * 8 + k_; pp[k_] = 1.f; hh[k_] = 0.f; \
            if (s2_ < seg_) { const float2 o_ = *(const float2*)(rsum + ((size_t)(bl_ * 64 + s2_) * 1024 + ch_) * 2); pp[k_] = o_.x; hh[k_] = o_.y; } } } while (0)
    int j = blockIdx.x;
    if (j < N_RNN) RNN1_PREFETCH(j);
    for (; j < N_RNN; j += gridDim.x) {
        const int seg = j & 63, nb = (j >> 6) & 15, bl = j >> 10; const int ch = nb * 64 + lane; const unsigned r0 = (unsigned)(bl * SEQ + seg * 128 + wid * 16);
        float a16[16], u16[16], y16[16];
#pragma unroll
        for (int i = 0; i < 16; ++i) { a16[i] = 1.0f - bf2f((unsigned)ra[i]); u16[i] = bf2f((unsigned)ru[i]); y16[i] = bf2f((unsigned)ry[i]); }
        { float Pw = 1.f, Hw = 0.f;
#pragma unroll
          for (int k = 0; k < 8; ++k) { Hw = pp[k] * Hw + hh[k]; Pw *= pp[k]; }
          sC[(wid * 64 + lane) * 2] = Pw; sC[(wid * 64 + lane) * 2 + 1] = Hw; }
        if (j + (int)gridDim.x < N_RNN) RNN1_PREFETCH(j + (int)gridDim.x);
        { float hl = 0.f, Pp = 1.f;
#pragma unroll
          for (int i = 0; i < 16; ++i) { hl = a16[i] * hl + u16[i]; Pp *= a16[i]; }
          sS[(wid * 64 + lane) * 2] = Pp; sS[(wid * 64 + lane) * 2 + 1] = hl; }
        __syncthreads();
        float h = 0.f;
#pragma unroll
        for (int w = 0; w < 8; ++w) h = sC[(w * 64 + lane) * 2] * h + sC[(w * 64 + lane) * 2 + 1];
        for (int w = 0; w < wid; ++w) h = sS[(w * 64 + lane) * 2] * h + sS[(w * 64 + lane) * 2 + 1];
#pragma unroll 4
        for (int i = 0; i < 16; ++i) { h = a16[i] * h + u16[i];
            z[(size_t)(r0 + i) * DIN + C_YR + ch] = f2bf(h * gelu_tanh(y16[i])); }
        __syncthreads();
    }
#undef RNN1_PREFETCH
}

__device__ __forceinline__ void swa_item(const P& p, int l, LAS unsigned char* lds, bf16_t* z, int bl, int kvh, int qb, float Mb) {
    LAS bf16_t* sK = (LAS bf16_t*)lds;
    LAS bf16_t* sVt = sK + 256 * 72;
    LAS float* sBA = (LAS float*)(lds + 70656);
    const float* biasA = (const float*)(p.ws + WS_BIASA);
    const int tid = opaque_tid(), wid = tid >> 6, lane = tid & 63, fr = lane & 15, fq = lane >> 4;
    const size_t rq0 = (size_t)bl * SEQ + (size_t)qb * 128;
    bf16x8 q[2][4];
#pragma unroll
    for (int i = 0; i < 2; ++i) { const int tile = wid + 8 * i, g = tile >> 2, q0 = (tile & 3) * 32;
        const bf16_t* qp = z + (rq0 + q0 + fr) * DIN + C_QA + (kvh * 4 + g) * 64 + fq * 8;
        q[i][0] = *(const bf16x8*)qp; q[i][1] = *(const bf16x8*)(qp + 32); q[i][2] = *(const bf16x8*)(qp + (size_t)16 * DIN); q[i][3] = *(const bf16x8*)(qp + (size_t)16 * DIN + 32); }
    for (int i = tid; i < 256 * 8; i += NTHREADS) { const int sj = i >> 3, c8 = (i & 7) * 8; const int tk = (qb - 1) * 128 + sj;
        u32x4 kv = (u32x4){0u, 0u, 0u, 0u}, vv = (u32x4){0u, 0u, 0u, 0u};
        if (tk >= 0) { const bf16_t* rowp = z + ((size_t)bl * SEQ + tk) * DIN; kv = *(const u32x4*)(rowp + C_KA + kvh * 64 + c8); vv = *(const u32x4*)(rowp + C_VA + kvh * 64 + c8); }
        *(LAS u32x4*)(sK + sj * 72 + c8) = kv;
#pragma unroll
        for (int j = 0; j < 4; ++j) { sVt[(c8 + 2 * j) * 264 + sj] = (bf16_t)(vv[j] & 0xffffu); sVt[(c8 + 2 * j + 1) * 264 + sj] = (bf16_t)(vv[j] >> 16); } }
    for (int i = tid; i < 4 * 384; i += NTHREADS) { const int g = i / 384, diff = i - g * 384 - 128; const int hq = kvh * 4 + g;
        const float Mh = fmaxf(Mb, p.sinks[l * 8 + hq]);
        sBA[i] = (diff >= 0 && diff < 128) ? (biasA[hq * 128 + diff] - Mh) * 1.4426950408889634f : -1.0e30f; }
    __syncthreads();
#pragma unroll
    for (int i = 0; i < 2; ++i) { const int tile = wid + 8 * i, g = tile >> 2, q0 = (tile & 3) * 32; const int hq = kvh * 4 + g;
        const LAS float* pbA = sBA + g * 384 + 128 + (q0 + fr + 128 - 4 * fq - 255); const LAS float* pbB = pbA + 16;
        float lsA = 0.f, lsB = 0.f;
        f32x4 oA[4], oB[4];
#pragma unroll
        for (int nd = 0; nd < 4; ++nd) { oA[nd] = (f32x4){0.f, 0.f, 0.f, 0.f}; oB[nd] = (f32x4){0.f, 0.f, 0.f, 0.f}; }
        int kq0 = (q0 + 1) >> 6; const int kq1 = ((q0 + 159) >> 6) + 1;
        if (qb == 0 && kq0 < 2) kq0 = 2;
        for (int kq = kq0; kq < kq1; ++kq) {
            unsigned pkA[4][2], pkB[4][2];
            const LAS float* pa = pbA - kq * 64; const LAS float* pb = pbB - kq * 64;
#pragma unroll
            for (int nt = 0; nt < 4; ++nt) {
                const LAS bf16_t* kp = sK + (kq * 64 + nt * 16 + fr) * 72 + fq * 8;
                const bf16x8 k0 = *(const LAS bf16x8*)kp, k1 = *(const LAS bf16x8*)(kp + 32);
                f32x4 aA = (f32x4){0.f, 0.f, 0.f, 0.f}, aB = (f32x4){0.f, 0.f, 0.f, 0.f};
                aA = mfma16(k0, q[i][0], aA); aB = mfma16(k0, q[i][2], aB); aA = mfma16(k1, q[i][1], aA); aB = mfma16(k1, q[i][3], aB);
                float pjA[4], pjB[4];
#pragma unroll
                for (int j = 0; j < 4; ++j) {
                    const float pvA = __builtin_amdgcn_exp2f(aA[j] * 0.18033688011112042f + pa[255 - nt * 16 - j]), pvB = __builtin_amdgcn_exp2f(aB[j] * 0.18033688011112042f + pb[255 - nt * 16 - j]);
                    lsA += pvA; lsB += pvB; pjA[j] = pvA; pjB[j] = pvB; }
                pkA[nt][0] = cvt_pk_bf16(pjA[0], pjA[1]); pkA[nt][1] = cvt_pk_bf16(pjA[2], pjA[3]);
                pkB[nt][0] = cvt_pk_bf16(pjB[0], pjB[1]); pkB[nt][1] = cvt_pk_bf16(pjB[2], pjB[3]); }
#pragma unroll
            for (int tt = 0; tt < 2; ++tt) {
                u32x4 bwA, bwB; bwA[0] = pkA[2 * tt][0]; bwA[1] = pkA[2 * tt][1]; bwA[2] = pkA[2 * tt + 1][0]; bwA[3] = pkA[2 * tt + 1][1];
                bwB[0] = pkB[2 * tt][0]; bwB[1] = pkB[2 * tt][1]; bwB[2] = pkB[2 * tt + 1][0]; bwB[3] = pkB[2 * tt + 1][1];
                const bf16x8 bfA = __builtin_bit_cast(bf16x8, bwA), bfB = __builtin_bit_cast(bf16x8, bwB);
#pragma unroll
                for (int nd = 0; nd < 4; ++nd) { const LAS bf16_t* vp = sVt + (nd * 16 + fr) * 264 + kq * 64 + 32 * tt + 4 * fq;
                    const u32x2 lo = *(const LAS u32x2*)vp, hi = *(const LAS u32x2*)(vp + 16);
                    u32x4 aw; aw[0] = lo[0]; aw[1] = lo[1]; aw[2] = hi[0]; aw[3] = hi[1];
                    const bf16x8 vf = __builtin_bit_cast(bf16x8, aw);
                    oA[nd] = mfma16(vf, bfA, oA[nd]); oB[nd] = mfma16(vf, bfB, oB[nd]); } }
        }
        lsA += __shfl_xor(lsA, 16); lsA += __shfl_xor(lsA, 32); lsB += __shfl_xor(lsB, 16); lsB += __shfl_xor(lsB, 32);
        const float sinkv = p.sinks[l * 8 + hq]; const float es = __expf(sinkv - fmaxf(Mb, sinkv));
        const float invA = 1.0f / (lsA + es), invB = 1.0f / (lsB + es);
        bf16_t* opA = z + (rq0 + q0 + fr) * DIN + C_QA + hq * 64 + 4 * fq; bf16_t* opB = opA + (size_t)16 * DIN;
#pragma unroll
        for (int nd = 0; nd < 4; ++nd) { u32x2 pa2, pb2; pa2[0] = cvt_pk_bf16(oA[nd][0] * invA, oA[nd][1] * invA); pa2[1] = cvt_pk_bf16(oA[nd][2] * invA, oA[nd][3] * invA);
            pb2[0] = cvt_pk_bf16(oB[nd][0] * invB, oB[nd][1] * invB); pb2[1] = cvt_pk_bf16(oB[nd][2] * invB, oB[nd][3] * invB);
            *(u32x2*)(opA + nd * 16) = pa2; *(u32x2*)(opB + nd * 16) = pb2; }
    }
    __syncthreads();
}

constexpr int N_MSUB = 52;
__device__ const unsigned short MOBA_SUB[N_MSUB] = {269, 270, 271, 517, 549, 272, 518, 550, 770, 802, 834, 273, 519, 551, 1024, 1056, 1088, 1120, 274, 771, 803, 835, 520, 552, 275, 1025, 1057, 1089, 1121, 521, 553, 276, 772, 804, 836, 522, 554, 277, 523, 555, 278, 524, 556, 279, 280, 281, 282, 283, 284, 285, 286, 287};
__device__ __forceinline__ void moba_gate_item(const P& p, LAS unsigned char* lds, const bf16_t* z, int bl, int h, int n) {
    LAS float* sKm = (LAS float*)lds;
    LAS int* sCnt = (LAS int*)(lds + 8192);
    int* CNT = (int*)(p.ws + WS_MCNT) + (bl * 8 + h) * 32;
    unsigned* LIST = (unsigned*)(p.ws + WS_MLIST) + (size_t)(bl * 8 + h) * 32 * LCAP;
    const float* kmean = (const float*)(p.ws + WS_KMEAN) + (size_t)(bl * 8 + h) * 32 * 64;
    const int tid = opaque_tid();
    if (tid < 64) sCnt[tid] = 0;
    for (int i = tid; i < n * 64; i += NTHREADS) sKm[i] = kmean[i];
    __syncthreads();
    int s0 = -1, s1 = -1, s2 = -1, p0 = 0, p1 = 0, p2 = 0;
    if (tid < 256) {
        float qv[64];
        const bf16_t* qp = z + ((size_t)bl * SEQ + (size_t)n * 256 + tid) * DIN + C_QC + h * 64;
#pragma unroll
        for (int c = 0; c < 8; ++c) { const u32x4 raw = *(const u32x4*)(qp + c * 8); unpack8(raw, qv + c * 8); }
        float v0 = -3.0e38f, v1 = -3.0e38f, v2 = -3.0e38f;
        for (int m = 0; m < n; ++m) { float g = 0.f;
#pragma unroll
            for (int d = 0; d < 64; ++d) g += qv[d] * sKm[m * 64 + d];
            if (g > v0) { v2 = v1; s2 = s1; v1 = v0; s1 = s0; v0 = g; s0 = m; }
            else if (g > v1) { v2 = v1; s2 = s1; v1 = g; s1 = m; }
            else if (g > v2) { v2 = g; s2 = m; } }
        if (s0 >= 0) p0 = atomicAdd((int*)(sCnt + s0), 1);
        if (s1 >= 0) p1 = atomicAdd((int*)(sCnt + s1), 1);
        if (s2 >= 0) p2 = atomicAdd((int*)(sCnt + s2), 1);
    }
    __syncthreads();
    if (tid < n) { const int c = sCnt[tid]; sCnt[32 + tid] = (c > 0) ? atomicAdd(CNT + tid, c) : 0; }
    __syncthreads();
    if (tid < 256) { const unsigned qpos = (unsigned)(n * 256 + tid);
        if (s0 >= 0) LIST[(size_t)s0 * LCAP + sCnt[32 + s0] + p0] = qpos;
        if (s1 >= 0) LIST[(size_t)s1 * LCAP + sCnt[32 + s1] + p1] = qpos | (1u << 16);
        if (s2 >= 0) LIST[(size_t)s2 * LCAP + sCnt[32 + s2] + p2] = qpos | (2u << 16); }
    __syncthreads();
}

template <bool OWN>
__device__ __forceinline__ void moba_tile(unsigned ecA, unsigned ecB, bool vA, bool vB, bf16x8 qA0, bf16x8 qA1, bf16x8 qB0, bf16x8 qB1, int kqn, int m, int bl, int h, float cb,
                                          const LAS bf16_t* sK, const LAS bf16_t* sVt, const LAS float* sB2, bf16_t* PART, float* LSUM, int fr, int fq) {
    const int qposA = (int)(ecA & 0xffffu), slotA = (int)(ecA >> 16), qposB = (int)(ecB & 0xffffu), slotB = (int)(ecB >> 16);
    const int dqfA = qposA - m * 256 - 4 * fq, dqfB = qposB - m * 256 - 4 * fq;
    const bool farb = !OWN && (__all(dqfA + 4 * fq - 255 >= 1513 && dqfB + 4 * fq - 255 >= 1513) != 0);
    const LAS float* pbA = sB2 + (272 + dqfA - 255); const LAS float* pbB = sB2 + (272 + dqfB - 255);
    float lsA = 0.f, lsB = 0.f;
    f32x4 oA[4], oB[4];
#pragma unroll
    for (int nd = 0; nd < 4; ++nd) { oA[nd] = (f32x4){0.f, 0.f, 0.f, 0.f}; oB[nd] = (f32x4){0.f, 0.f, 0.f, 0.f}; }
    for (int kq = 0; kq < kqn; ++kq) {
        unsigned pkA[4][2], pkB[4][2];
        const LAS float* pa = pbA - kq * 64; const LAS float* pb = pbB - kq * 64;
#pragma unroll
        for (int nt = 0; nt < 4; ++nt) {
            const LAS bf16_t* kp = sK + (kq * 64 + nt * 16 + fr) * 72 + fq * 8;
            const bf16x8 k0 = *(const LAS bf16x8*)kp, k1 = *(const LAS bf16x8*)(kp + 32);
            f32x4 aA = (f32x4){0.f, 0.f, 0.f, 0.f}, aB = (f32x4){0.f, 0.f, 0.f, 0.f};
            aA = mfma16(k0, qA0, aA); aB = mfma16(k0, qB0, aB); aA = mfma16(k1, qA1, aA); aB = mfma16(k1, qB1, aB);
            float pjA[4], pjB[4];
#pragma unroll
            for (int j = 0; j < 4; ++j) {
                const float b2A = farb ? cb : pa[255 - nt * 16 - j], b2B = farb ? cb : pb[255 - nt * 16 - j];
                float pvA = __builtin_amdgcn_exp2f(aA[j] * 0.18033688011112042f + b2A), pvB = __builtin_amdgcn_exp2f(aB[j] * 0.18033688011112042f + b2B);
                if (OWN) { if (dqfA - (kq * 64 + nt * 16 + j) < 0) pvA = 0.f; if (dqfB - (kq * 64 + nt * 16 + j) < 0) pvB = 0.f; }
                lsA += pvA; lsB += pvB; pjA[j] = pvA; pjB[j] = pvB; }
            pkA[nt][0] = cvt_pk_bf16(pjA[0], pjA[1]); pkA[nt][1] = cvt_pk_bf16(pjA[2], pjA[3]);
            pkB[nt][0] = cvt_pk_bf16(pjB[0], pjB[1]); pkB[nt][1] = cvt_pk_bf16(pjB[2], pjB[3]); }
#pragma unroll
        for (int tt = 0; tt < 2; ++tt) {
            u32x4 bwA, bwB; bwA[0] = pkA[2 * tt][0]; bwA[1] = pkA[2 * tt][1]; bwA[2] = pkA[2 * tt + 1][0]; bwA[3] = pkA[2 * tt + 1][1];
            bwB[0] = pkB[2 * tt][0]; bwB[1] = pkB[2 * tt][1]; bwB[2] = pkB[2 * tt + 1][0]; bwB[3] = pkB[2 * tt + 1][1];
            const bf16x8 bfA = __builtin_bit_cast(bf16x8, bwA), bfB = __builtin_bit_cast(bf16x8, bwB);
#pragma unroll
            for (int nd = 0; nd < 4; ++nd) { const LAS bf16_t* vp = sVt + (nd * 16 + fr) * 264 + kq * 64 + 32 * tt + 4 * fq;
                const u32x2 lo = *(const LAS u32x2*)vp, hi = *(const LAS u32x2*)(vp + 16);
                u32x4 aw; aw[0] = lo[0]; aw[1] = lo[1]; aw[2] = hi[0]; aw[3] = hi[1];
                const bf16x8 vf = __builtin_bit_cast(bf16x8, aw);
                oA[nd] = mfma16(vf, bfA, oA[nd]); oB[nd] = mfma16(vf, bfB, oB[nd]); } }
    }
    lsA += __shfl_xor(lsA, 16); lsA += __shfl_xor(lsA, 32); lsB += __shfl_xor(lsB, 16); lsB += __shfl_xor(lsB, 32);
    if (vA) { const size_t pi = (((size_t)bl * SEQ + qposA) * 8 + h) * 4 + slotA;
        if (fq == 0) LSUM[pi] = lsA;
#pragma unroll
        for (int nd = 0; nd < 4; ++nd) { u32x2 pk2; pk2[0] = cvt_pk_bf16(oA[nd][0], oA[nd][1]); pk2[1] = cvt_pk_bf16(oA[nd][2], oA[nd][3]);
            *(u32x2*)(PART + pi * 64 + nd * 16 + 4 * fq) = pk2; } }
    if (vB) { const size_t pi = (((size_t)bl * SEQ + qposB) * 8 + h) * 4 + slotB;
        if (fq == 0) LSUM[pi] = lsB;
#pragma unroll
        for (int nd = 0; nd < 4; ++nd) { u32x2 pk2; pk2[0] = cvt_pk_bf16(oB[nd][0], oB[nd][1]); pk2[1] = cvt_pk_bf16(oB[nd][2], oB[nd][3]);
            *(u32x2*)(PART + pi * 64 + nd * 16 + 4 * fq) = pk2; } }
}
__device__ __forceinline__ void moba_attn_item(const P& p, LAS unsigned char* lds, const bf16_t* z, int bl, int h, int m, int part, int parts, float M) {
    LAS bf16_t* sK = (LAS bf16_t*)lds;
    LAS bf16_t* sVt = sK + 256 * 72;
    LAS float* sB2 = (LAS float*)(lds + 70656);
    const int tid = opaque_tid(), wid = tid >> 6, lane = tid & 63, fr = lane & 15, fq = lane >> 4;
    const bf16_t* Vtg = (const bf16_t*)(p.ws + WS_VTC) + (size_t)(bl * 8 + h) * 64 * SEQ;
    const float* biasC = (const float*)(p.ws + WS_BIASC) + h * 8192;
    const unsigned* LIST = (const unsigned*)(p.ws + WS_MLIST) + ((size_t)(bl * 8 + h) * 32 + m) * LCAP;
    bf16_t* PART = (bf16_t*)(p.ws + WS_MPART); float* LSUM = (float*)(p.ws + WS_MLSUM);
    const int cnt = ((const int*)(p.ws + WS_MCNT))[(bl * 8 + h) * 32 + m];
    const int ntl = (cnt + 31) >> 5, ntot = ntl + 8;
    const int tlo = (part * ntot) / parts, thi = ((part + 1) * ntot) / parts;
#define MOBA_ENTRY1(ix_, e, v) do { v = (ix_) < cnt; e = LIST[(ix_) < cnt ? (ix_) : (cnt > 0 ? cnt - 1 : 0)]; } while (0)
#define MOBA_ENTRY(t, ea, va, eb, vb) do { if ((t) < ntl) { MOBA_ENTRY1((t) * 32 + fr, ea, va); MOBA_ENTRY1((t) * 32 + 16 + fr, eb, vb); } \
        else { va = vb = (t) < thi; ea = (unsigned)(m * 256 + (((t) - ntl) & 7) * 32 + fr) | (3u << 16); eb = ea + 16u; } } while (0)
#define MOBA_QGATHER(e, a0, a1) do { const bf16_t* qp_ = z + ((size_t)bl * SEQ + ((e) & 0xffffu)) * DIN + C_QC + h * 64 + fq * 8; a0 = *(const bf16x8*)qp_; a1 = *(const bf16x8*)(qp_ + 32); } while (0)
#define MOBA_KQN(t) ((((((t) - ntl) & 7) * 32 + 31) >> 6) + 1)
    int t = tlo + wid;
    unsigned e0a = 0u, e0b = 0u, e1a = 0u, e1b = 0u, e2a = 0u, e2b = 0u; bool v0a = false, v0b = false, v1a = false, v1b = false, v2a = false, v2b = false;
    bf16x8 qa0, qa1, qa2, qa3, qb0, qb1, qb2, qb3, qc0, qc1, qc2, qc3;
    MOBA_ENTRY(t, e0a, v0a, e0b, v0b); MOBA_ENTRY(t + 8, e1a, v1a, e1b, v1b); MOBA_ENTRY(t + 16, e2a, v2a, e2b, v2b);
    MOBA_QGATHER(e0a, qa0, qa1); MOBA_QGATHER(e0b, qa2, qa3); MOBA_QGATHER(e1a, qb0, qb1); MOBA_QGATHER(e1b, qb2, qb3);
    qc0 = qa0; qc1 = qa1; qc2 = qa2; qc3 = qa3;
#pragma unroll
    for (int k = 0; k < 4; ++k) { const int i = tid + k * NTHREADS;
        const u32x4 kv = *(const u32x4*)(z + ((size_t)bl * SEQ + (size_t)m * 256 + (i >> 3)) * DIN + C_KC + h * 64 + (i & 7) * 8);
        const u32x4 vv = *(const u32x4*)(Vtg + (size_t)(i >> 5) * SEQ + m * 256 + (i & 31) * 8);
        *(LAS u32x4*)(sK + (i >> 3) * 72 + (i & 7) * 8) = kv; *(LAS u32x4*)(sVt + (i >> 5) * 264 + (i & 31) * 8) = vv;
    }
    { const float* b2t = (const float*)(p.ws + WS_B2T) + h * (8192 + 272);
      for (int i = tid; i < (8192 + 272) / 4; i += NTHREADS) *(LAS f32x4*)(sB2 + 4 * i) = *(const f32x4*)(b2t + 4 * i); }
    __syncthreads();
    const float cb = sB2[272 + 8191];
#define MOBA_RUN(ea, eb, va, vb, q0, q1, q2, q3) do { if (t >= ntl) moba_tile<true>(ea, eb, (va) && t < thi, (vb) && t < thi, q0, q1, q2, q3, MOBA_KQN(t), m, bl, h, cb, sK, sVt, sB2, PART, LSUM, fr, fq); \
        else moba_tile<false>(ea, eb, (va) && t < thi, (vb) && t < thi, q0, q1, q2, q3, 4, m, bl, h, cb, sK, sVt, sB2, PART, LSUM, fr, fq); } while (0)
    for (;;) {
        if (t >= thi) break;
        { const unsigned ca = e0a, cbb = e0b; const bool wa = v0a, wb = v0b; MOBA_QGATHER(e2a, qc0, qc1); MOBA_QGATHER(e2b, qc2, qc3); MOBA_ENTRY(t + 24, e0a, v0a, e0b, v0b);
          MOBA_RUN(ca, cbb, wa, wb, qa0, qa1, qa2, qa3); t += 8; }
        if (t >= thi) break;
        { const unsigned ca = e1a, cbb = e1b; const bool wa = v1a, wb = v1b; MOBA_QGATHER(e0a, qa0, qa1); MOBA_QGATHER(e0b, qa2, qa3); MOBA_ENTRY(t + 24, e1a, v1a, e1b, v1b);
          MOBA_RUN(ca, cbb, wa, wb, qb0, qb1, qb2, qb3); t += 8; }
        if (t >= thi) break;
        { const unsigned ca = e2a, cbb = e2b; const bool wa = v2a, wb = v2b; MOBA_QGATHER(e1a, qb0, qb1); MOBA_QGATHER(e1b, qb2, qb3); MOBA_ENTRY(t + 24, e2a, v2a, e2b, v2b);
          MOBA_RUN(ca, cbb, wa, wb, qc0, qc1, qc2, qc3); t += 8; }
    }
#undef MOBA_ENTRY1
#undef MOBA_ENTRY
#undef MOBA_QGATHER
#undef MOBA_KQN
#undef MOBA_RUN
    __syncthreads();
}

__device__ __forceinline__ void phase_moba_combine(const P& p, bf16_t* z) {
    const bf16_t* PART = (const bf16_t*)(p.ws + WS_MPART); const float* LSUM = (const float*)(p.ws + WS_MLSUM);
    const int tid = opaque_tid(), wid = tid >> 6, lane = tid & 63, h = lane >> 3, d8 = (lane & 7) * 8;
    for (int r0 = (blockIdx.x * 8 + wid) * 2; r0 < TC; r0 += gridDim.x * 8 * 2) {
#pragma unroll
        for (int q = 0; q < 2; ++q) { const int r = r0 + q; const int n = (r % SEQ) >> 8; const int nsel = n < 3 ? n : 3;
            const size_t pi = ((size_t)r * 8 + h) * 4;
            float acc[8], lt = LSUM[pi + 3];
            unpack8(*(const u32x4*)(PART + (pi + 3) * 64 + d8), acc);
#pragma unroll
            for (int k = 0; k < 3; ++k) if (k < nsel) { float f[8]; unpack8(*(const u32x4*)(PART + (pi + k) * 64 + d8), f); lt += LSUM[pi + k];
#pragma unroll
                for (int j = 0; j < 8; ++j) acc[j] += f[j]; }
            const float inv = 1.0f / lt; u32x4 pk;
#pragma unroll
            for (int j = 0; j < 4; ++j) pk[j] = cvt_pk_bf16(acc[2 * j] * inv, acc[2 * j + 1] * inv);
            *(u32x4*)(z + (size_t)r * DIN + C_QC + h * 64 + d8) = pk; }
    }
}

__device__ __forceinline__ void phase_act(const P& p, int l, const bf16_t* u, bf16_t* act) {
    const int tid = opaque_tid();
    if (tid >= DFF / 8) return;
    const int c0 = tid * 8;
    float wg[3][8], wv[3][8], bg[8], bv[8];
#pragma unroll
    for (int k = 0; k < 3; ++k)
#pragma unroll
        for (int j = 0; j < 8; ++j) { wg[k][j] = p.ffn_conv_w[(size_t)(l * 3 + k) * DFF2 + c0 + j]; wv[k][j] = p.ffn_conv_w[(size_t)(l * 3 + k) * DFF2 + DFF + c0 + j]; }
#pragma unroll
    for (int j = 0; j < 8; ++j) { bg[j] = p.ffn_conv_b[(size_t)l * DFF2 + c0 + j]; bv[j] = p.ffn_conv_b[(size_t)l * DFF2 + DFF + c0 + j]; }
    for (int item = blockIdx.x; item < TC / 64; item += gridDim.x) {
        const int r0 = item * 64;
        float g1[8], g2[8], v1[8], v2[8];
        if ((r0 % SEQ) == 0) {
#pragma unroll
            for (int j = 0; j < 8; ++j) { g1[j] = 0.f; g2[j] = 0.f; v1[j] = 0.f; v2[j] = 0.f; }
        } else {
            unpack8(*(const u32x4*)(u + (size_t)(r0 - 1) * DFF2 + c0), g1); unpack8(*(const u32x4*)(u + (size_t)(r0 - 2) * DFF2 + c0), g2);
            unpack8(*(const u32x4*)(u + (size_t)(r0 - 1) * DFF2 + DFF + c0), v1); unpack8(*(const u32x4*)(u + (size_t)(r0 - 2) * DFF2 + DFF + c0), v2);
        }
        for (int i0 = 0; i0 < 64; i0 += 8) {
            u32x4 rg[8], rv[8];
#pragma unroll
            for (int i = 0; i < 8; ++i) { const size_t r = (size_t)(r0 + i0 + i); rg[i] = *(const u32x4*)(u + r * DFF2 + c0); rv[i] = *(const u32x4*)(u + r * DFF2 + DFF + c0); }
#pragma unroll
            for (int i = 0; i < 8; ++i) { const size_t r = (size_t)(r0 + i0 + i);
                float g0[8], v0[8]; unpack8(rg[i], g0); unpack8(rv[i], v0);
                float o[8];
#pragma unroll
                for (int j = 0; j < 8; ++j) { const float cgv = bg[j] + wg[0][j] * g2[j] + wg[1][j] * g1[j] + wg[2][j] * g0[j]; const float cvv = bv[j] + wv[0][j] * v2[j] + wv[1][j] * v1[j] + wv[2][j] * v0[j];
                    o[j] = (cgv * __builtin_amdgcn_rcpf(1.0f + __expf(-cgv))) * cvv; g2[j] = g1[j]; g1[j] = g0[j]; v2[j] = v1[j]; v1[j] = v0[j]; }
                u32x4 pk;
#pragma unroll
                for (int j = 0; j < 4; ++j) pk[j] = pack2(o[2 * j], o[2 * j + 1]);
                *(u32x4*)(act + r * DFF + c0) = pk; }
        }
    }
}

#ifndef PHASE_MASK
#define PHASE_MASK 0xFFFFF
#endif
#define PH(k) ((PHASE_MASK >> (k)) & 1)
#ifndef REP_GRP
#define REP_GRP 0
#endif
#ifndef REP_P2
#define REP_P2 0
#endif
#ifndef REP_P8
#define REP_P8 0
#endif
#ifndef REP_MISC
#define REP_MISC 0
#endif
#ifndef DRY_MOBA
#define DRY_MOBA 0
#endif
#ifndef DRY_SWA
#define DRY_SWA 0
#endif
#ifndef DRY_RNN
#define DRY_RNN 0
#endif

#define XB_TMO      128
#define XB_XCNT(j)  (256  + 64 * (j))
#define XB_XSUB(j)  (1280 + 64 * (j))
#define XB_XGEN(j)  (2304 + 64 * (j))
#define XB_TOP      3328
#define XB_TOPGEN   3392
#define XCD_BAR_WORDS 3456
#define XB_SPIN_CAP (1u << 18)
__device__ __forceinline__ unsigned xb_ld(unsigned* p)              { return __hip_atomic_load(p, __ATOMIC_RELAXED, __HIP_MEMORY_SCOPE_AGENT); }
__device__ __forceinline__ unsigned xb_add(unsigned* p, unsigned v) { return __hip_atomic_fetch_add(p, v, __ATOMIC_RELAXED, __HIP_MEMORY_SCOPE_AGENT); }
__device__ __forceinline__ unsigned xb_xcc_id() { return (unsigned)__builtin_amdgcn_s_getreg((3 << 11) | 20) & 0xFu; }
#define XB_SPIN(cond, bar) do { unsigned _sp = 0; while (cond) { __builtin_amdgcn_s_sleep(1); \
    if ((++_sp & 255u) == 0u) { if (xb_ld(&(bar)[XB_TMO])) break; if (_sp > XB_SPIN_CAP) { atomicAdd(&(bar)[XB_TMO], 1u); break; } } } } while (0)
struct XcdBarrier { unsigned* bar; unsigned x; volatile LAS unsigned* st; };
__device__ __forceinline__ XcdBarrier xcd_barrier_post(unsigned* bar, volatile LAS unsigned* st) {
    XcdBarrier b; b.bar = bar; b.x = xb_xcc_id(); b.st = st;
    if (threadIdx.x == 0) (void)xb_add(&bar[XB_XCNT(b.x)], 1u);
    return b;
}
__device__ __forceinline__ void xcd_barrier_complete(unsigned* bar, unsigned x, unsigned& nloc, unsigned& nx) {
    const unsigned G = gridDim.x * gridDim.y * gridDim.z;
    unsigned sum, cnt, mine, sp = 0u;
    for (;;) {
        sum = 0u; cnt = 0u; mine = 0u;
#pragma unroll
        for (unsigned j = 0; j < 16; ++j) { const unsigned c = xb_ld(&bar[XB_XCNT(j)]); sum += c; cnt += (c > 0u) ? 1u : 0u; mine = (j == x) ? c : mine; }
        if (sum == G) break;
        __builtin_amdgcn_s_sleep(1);
        if ((++sp & 255u) == 0u) { if (xb_ld(&bar[XB_TMO])) break; if (sp > XB_SPIN_CAP) { atomicAdd(&bar[XB_TMO], 1u); break; } }
    }
    nloc = mine > 0u ? mine : 1u; nx = cnt > 0u ? cnt : 1u;
}
__device__ __forceinline__ void xcd_barrier(const XcdBarrier& b) {
    asm volatile("s_waitcnt vmcnt(0)" ::: "memory");
    __syncthreads();
    if (opaque_tid() == 0) {
        unsigned* bar = b.bar;
        __builtin_amdgcn_s_waitcnt(0);
        unsigned nloc = b.st[0], nx = b.st[1];
        if (nloc == 0u) { xcd_barrier_complete(bar, b.x, nloc, nx); b.st[0] = nloc; b.st[1] = nx; }
        const unsigned old = xb_add(&bar[XB_XSUB(b.x)], 1u);
        const unsigned gen = old / nloc;
        if (old + 1u == (gen + 1u) * nloc) {
            __builtin_amdgcn_fence(__ATOMIC_RELEASE, "agent");
            asm volatile("s_waitcnt vmcnt(0)" ::: "memory");
            const unsigned og = xb_add(&bar[XB_TOP], 1u);
            const unsigned tg = og / nx;
            if (og + 1u == (tg + 1u) * nx) xb_add(&bar[XB_TOPGEN], 1u);
            else XB_SPIN(xb_ld(&bar[XB_TOPGEN]) == tg, bar);
            __builtin_amdgcn_fence(__ATOMIC_ACQUIRE, "agent");
            xb_add(&bar[XB_XGEN(b.x)], 1u);
            asm volatile("s_waitcnt vmcnt(0)" ::: "memory");
        } else {
            XB_SPIN(xb_ld(&bar[XB_XGEN(b.x)]) == gen, bar);
            __builtin_amdgcn_fence(__ATOMIC_ACQUIRE, "agent");
            asm volatile("s_waitcnt vmcnt(0)" ::: "memory");
        }
    }
    __syncthreads();
}
#ifndef REP_SYNC
#define REP_SYNC 0
#endif
#define GSYNC() do { for (int _r = 0; _r < 1 + REP_SYNC; ++_r) xcd_barrier(xbar); } while (0)
__global__ void __launch_bounds__(NTHREADS, 2) fwd_megakernel(P p_arg) {
    extern __shared__ __attribute__((aligned(16))) unsigned char lds_raw[];
    LAS unsigned char* lds = (LAS unsigned char*)lds_raw;
    cg::grid_group grid = cg::this_grid();
    const int G = gridDim.x, bx = blockIdx.x;
#define RELOAD const P p = load_params(); const float* mod_l = (const float*)(p.ws + WS_MOD) + (size_t)l * NB * 6144; bf16_t* Hb = (bf16_t*)(p.ws + WS_H); bf16_t* Zb = (bf16_t*)(p.ws + WS_Z); bf16_t* ACTb = (bf16_t*)(p.ws + WS_ACT); \
    const float* xin = ((l == 0) ? p.x : p.out) + (size_t)ch * TC * DM; float* xout = p.out + (size_t)ch * TC * DM; (void)mod_l; (void)Hb; (void)Zb; (void)ACTb; (void)xin; (void)xout;

    { LAS unsigned* st = (LAS unsigned*)(lds + LDS_BYTES - 16); if (threadIdx.x == 0) { st[0] = 0u; st[1] = 0u; } __syncthreads(); }
    const XcdBarrier xbar = xcd_barrier_post((unsigned*)(p_arg.ws + WS_BAR), (volatile LAS unsigned*)(lds + LDS_BYTES - 16));
    if (PH(0)) { const P p = load_params(); phase0(p, lds); }
    grid.sync();

    for (int l = 0; l < DEPTH; ++l) {
        for (int ch = 0; ch < NCHUNK; ++ch) {
            const int b0 = ch * BPC;
            for (int rep3 = 0; rep3 < 1 + REP_MISC; ++rep3) { RELOAD
            if (PH(1)) if (ch == 0) phase_convert(p, l, lds);
            if (ch == 0) { const int gi = bx * NTHREADS + opaque_tid();
                if (gi < 8 * (8192 + 272)) { const int hh = gi / (8192 + 272), ii = gi - hh * (8192 + 272); const int dist = ii - 272;
                    ((float*)(p.ws + WS_B2T))[gi] = (((const float*)(p.ws + WS_BIASC))[hh * 8192 + (dist < 0 ? 0 : dist)] - ((const float*)(p.ws + WS_MB))[l * 2 + 1]) * 1.4426950408889634f; } }
            if (PH(2)) phase_norm(xin, p.norm_mix + l * DM, mod_l, 0, 1024, b0, Hb, p.ws + WS_H8); }
            GSYNC();
            for (int rep = 0; rep < 1 + REP_GRP; ++rep) {
            for (int rep2 = 0; rep2 < 1 + REP_P2; ++rep2) {
            if (PH(3)) { RELOAD
              { pg8::SchedPlain S{(const char*)Hb, (const char*)(p.ws + WS_WIN), DM * 2, DM * 2, DM / 64, TC / 256, C_G / 256, G, bx};
                pg8::EpiStoreBf16 E{Zb, DIN, 1 << 30, 1.0f};
                pg8::gemm_phase(lds, S, E); }
              {
                pg8::SchedPlain S{(const char*)(p.ws + WS_H8), (const char*)(p.ws + WS_WG8), DM, DM, DM / 128, TC / 256, (DIN - C_G) / 256, G, bx};
                pg8::EpiStoreBf16 E{Zb + C_G, DIN, 0, 1.0f / 64.0f};
                pg8::gemm_phase<pg8::SchedPlain, pg8::EpiStoreBf16, true>(lds, S, E); } }
            GSYNC();
            }
            { RELOAD
            if (PH(4)) phase_qknorm(p, l, Zb);
            if (PH(5)) phase_kcnorm(p, l, Zb, lds);
            if (bx == 0) { const int t_ = opaque_tid(); if (t_ < BPC * 8 * 32) ((int*)(p.ws + WS_MCNT))[t_] = 0; if (t_ == 0) *((int*)(p.ws + WS_MQ)) = 0; }
            if (PH(6)) phase_rnn0(p, l, lds, Zb); }
            GSYNC();
            { RELOAD
              for (int it = bx; it < BPC * 8 * 31; it += G) { const int n = 31 - it / (BPC * 8), h = it & 7, bl = (it >> 3) & 1; moba_gate_item(p, lds, Zb, bl, h, n); } }
            GSYNC();
            { RELOAD constexpr int N_MOBA = BPC * 8 * 32, N_SWA = BPC * 8 * 64, N_RNN = BPC * 16 * 64;
              const float Mb_a = ((const float*)(p.ws + WS_MB))[l * 2], Mb_c = ((const float*)(p.ws + WS_MB))[l * 2 + 1];
              for (int j = bx; j < BPC * 2 * 64; j += G) { if (PH(8)) { const int qb = j & 63, kvh = (j >> 6) & 1, bl = j >> 7; swa_item(p, l, lds, Zb, bl, kvh, qb, Mb_a); } }
              if (PH(9)) phase_rnn_apply(p, lds, Zb);
              if (PH(7)) {
                  int* qhead = (int*)(p.ws + WS_MQ); LAS int* sQ = (LAS int*)(lds + LDS_BYTES - 32);
                  for (;;) {
                      if (opaque_tid() == 0) *sQ = __hip_atomic_fetch_add(qhead, 1, __ATOMIC_RELAXED, __HIP_MEMORY_SCOPE_AGENT);
                      __syncthreads();
                      const int i = *sQ;
                      __syncthreads();
                      if (i >= N_MSUB * BPC * 8) break;
                      const unsigned sv = MOBA_SUB[i >> 4]; const int h = i & 7, bl = (i >> 3) & 1;
                      moba_attn_item(p, lds, Zb, bl, h, (int)(sv & 31u), (int)((sv >> 5) & 7u), (int)(sv >> 8), Mb_c); } } }
            GSYNC();
            { RELOAD phase_moba_combine(p, Zb); }
            GSYNC();
            }
            if (PH(10)) { RELOAD pg8::SchedMerge S{(const char*)Zb, (const char*)(p.ws + WS_WB), DIN * 2, 2048 * 2, TC / 256, DM / 256, G, bx};
              pg8::EpiMerge E{Zb, Hb};
              pg8::gemm_phase(lds, S, E); }
            GSYNC();
            if (PH(11)) { RELOAD pg8::SchedPlain S{(const char*)Hb, (const char*)(p.ws + WS_WOUT), DM * 2, DM * 2, DM / 64, TC / 256, DM / 256, G, bx};
              pg8::EpiResid E{xin, xout, mod_l + 2048, b0};
              pg8::gemm_phase(lds, S, E); }
            GSYNC();
            for (int rep3 = 0; rep3 < 1 + REP_MISC; ++rep3) if (PH(12)) { RELOAD phase_norm(xout, p.norm_ffn + l * DM, mod_l, 3072, 4096, b0, Hb, nullptr); }
            GSYNC();
            for (int rep2 = 0; rep2 < 1 + REP_P8; ++rep2) {
            if (PH(13)) { RELOAD pg8::SchedPlain S{(const char*)Hb, (const char*)(p.ws + WS_WUP), DM * 2, DM * 2, DM / 64, TC / 256, DFF2 / 256, G, bx};
              pg8::EpiStoreBf16 E{Zb, DFF2, 1 << 30, 1.0f};
              pg8::gemm_phase(lds, S, E); }
            GSYNC();
            }
            for (int rep3 = 0; rep3 < 1 + REP_MISC; ++rep3) if (PH(14)) { RELOAD phase_act(p, l, Zb, ACTb); }
            GSYNC();
            if (PH(15)) { RELOAD pg8::SchedPlain S{(const char*)ACTb, (const char*)(p.ws + WS_WDOWN), DFF * 2, DFF * 2, DFF / 64, TC / 256, DM / 256, G, bx};
              pg8::EpiResid E{xout, xout, mod_l + 5120, b0};
              pg8::gemm_phase(lds, S, E); }
            GSYNC();
        }
    }
}

extern "C" void kernel_launch(void* const* d_in, const int* in_sizes, int n_in, void* d_out, int out_size, void* d_ws, size_t ws_size, hipStream_t stream) {
    static int grid = 0;
    if (grid == 0) {
        if (n_in != 26 || ws_size < WS_END) { fprintf(stderr, "kernel_launch: need 26 inputs and >= %zu bytes of workspace (got %d, %zu)\n", (size_t)WS_END, n_in, ws_size); grid = -1; return; }
        int dev = 0, cus = 0, per_cu = 0;
        (void)hipGetDevice(&dev);
        (void)hipDeviceGetAttribute(&cus, hipDeviceAttributeMultiprocessorCount, dev);
        if (hipFuncSetAttribute((const void*)fwd_megakernel, hipFuncAttributeMaxDynamicSharedMemorySize, LDS_BYTES) != hipSuccess) { fprintf(stderr, "kernel_launch: hipFuncSetAttribute failed\n"); grid = -1; return; }
        if (hipOccupancyMaxActiveBlocksPerMultiprocessor(&per_cu, (const void*)fwd_megakernel, NTHREADS, LDS_BYTES) != hipSuccess || per_cu < 1) { fprintf(stderr, "kernel_launch: occupancy query gives %d\n", per_cu); per_cu = 1; (void)hipGetLastError(); }
        grid = cus * per_cu;
        fprintf(stderr, "kernel_launch: grid %d (cus %d x %d)\n", grid, cus, per_cu);
    }
    if (grid < 0) return;
    P prm{};
    const float** pp = (const float**)&prm;
    for (int i = 0; i < 26; ++i) pp[i] = (const float*)d_in[i];
    prm.out = (float*)d_out; prm.ws = (unsigned char*)d_ws;
    if (hipMemsetAsync((char*)d_ws + WS_BAR, 0, 3456 * 4, stream) != hipSuccess) { fprintf(stderr, "kernel_launch: memset of barrier words failed\n"); return; }
    void* args[] = {&prm};
    hipError_t e = hipLaunchCooperativeKernel((const void*)fwd_megakernel, dim3(grid), dim3(NTHREADS), args, LDS_BYTES, stream);
    if (e != hipSuccess) fprintf(stderr, "kernel_launch: cooperative launch failed: %s (grid %d)\n", hipGetErrorString(e), grid);
}
```

```cpp
#include <hip/hip_runtime.h>
#include <hip/hip_cooperative_groups.h>
#include <cstdio>
#include <cstdint>
namespace cg = cooperative_groups;

#define LAS __attribute__((address_space(3)))
typedef unsigned short bf16_t;
typedef short bf16x8 __attribute__((ext_vector_type(8)));
typedef float f32x4 __attribute__((ext_vector_type(4)));
typedef unsigned u32x4 __attribute__((ext_vector_type(4)));
typedef unsigned u32x2 __attribute__((ext_vector_type(2)));
typedef int i32x8 __attribute__((ext_vector_type(8)));
typedef unsigned u32x8 __attribute__((ext_vector_type(8)));

constexpr int NB = 4, SEQ = 8192, DM = 1024, NTOK = NB * SEQ, DEPTH = 4;
constexpr int DIN = 7424, DFF = 2816, DFF2 = 5632;
constexpr int C_QA = 0, C_KA = 512, C_VA = 640, C_XR = 768, C_YR = 1792, C_QC = 2816, C_KC = 3328, C_VC = 3840, C_G = 4352;
constexpr int NCHUNK = 2, TC = NTOK / NCHUNK, BPC = NB / NCHUNK;
constexpr int NTHREADS = 512;
constexpr int LDS_BYTES = 160 * 1024;
constexpr float RMS_EPS = 1e-6f;

constexpr size_t alup(size_t x) { return (x + 255) & ~(size_t)255; }
constexpr size_t WS_MOD = 0;
constexpr size_t WS_MB = alup(WS_MOD + (size_t)DEPTH * NB * 6144 * 4);
constexpr size_t WS_BIASA = alup(WS_MB + 256);
constexpr size_t WS_BIASC = alup(WS_BIASA + 8 * 128 * 4);
constexpr size_t WS_KMEAN = alup(WS_BIASC + 8 * 8192 * 4);
constexpr size_t WS_RSUM = alup(WS_KMEAN + (size_t)BPC * 8 * 32 * 64 * 4);
constexpr size_t WS_WIN = alup(WS_RSUM + (size_t)BPC * 64 * 1024 * 2 * 4);
constexpr size_t WS_WB = alup(WS_WIN + (size_t)DIN * 1024 * 2);
constexpr size_t WS_WOUT = alup(WS_WB + (size_t)1024 * 2048 * 2);
constexpr size_t WS_WUP = alup(WS_WOUT + (size_t)1024 * 1024 * 2);
constexpr size_t WS_WDOWN = alup(WS_WUP + (size_t)DFF2 * 1024 * 2);
constexpr size_t WS_GT = alup(WS_WDOWN + (size_t)1024 * DFF * 2);
constexpr size_t WS_H = alup(WS_GT + (size_t)2 * 64 * 1024 * 2);
constexpr size_t WS_Z = alup(WS_H + (size_t)TC * 1024 * 2);
constexpr size_t WS_ACT = alup(WS_Z + (size_t)TC * DIN * 2);
constexpr size_t WS_VTC = alup(WS_ACT + (size_t)TC * DFF * 2);
constexpr size_t WS_BAR = alup(WS_VTC + (size_t)BPC * 8 * 64 * SEQ * 2);
constexpr int LCAP = 8192;
constexpr size_t WS_MCNT = alup(WS_BAR + 3456 * 4);
constexpr size_t WS_MQ = alup(WS_MCNT + (size_t)BPC * 8 * 32 * 4);
constexpr size_t WS_MLIST = alup(WS_MQ + 256);
constexpr size_t WS_MPART = alup(WS_MLIST + (size_t)BPC * 8 * 32 * LCAP * 4);
constexpr size_t WS_MLSUM = alup(WS_MPART + (size_t)TC * 8 * 4 * 64 * 2);
constexpr size_t WS_H8 = alup(WS_MLSUM + (size_t)TC * 8 * 4 * 4);
constexpr size_t WS_WG8 = alup(WS_H8 + (size_t)TC * 1024);
constexpr size_t WS_B2T = alup(WS_WG8 + (size_t)3072 * 1024);
constexpr size_t WS_END = alup(WS_B2T + (size_t)8 * (8192 + 272) * 4);

struct P {
    const float *x, *c, *w_mod, *b_mod, *norm_mix, *norm_ffn, *w_in, *qnorm_a, *knorm_a, *sinks, *rnn_conv_w, *rnn_conv_b, *ga_w, *ga_b, *gx_w, *gx_b, *lam,
        *qnorm_c, *knorm_c, *rel_bias, *w_branch, *w_out, *w_up, *ffn_conv_w, *ffn_conv_b, *w_down;
    float* out; unsigned char* ws;
};

__device__ __forceinline__ P load_params() {
#if defined(__HIP_DEVICE_COMPILE__)
    unsigned long long v = (unsigned long long)__builtin_amdgcn_kernarg_segment_ptr(); asm volatile("" : "+s"(v));
    const P __attribute__((address_space(4)))* kp = (const P __attribute__((address_space(4)))*)v;
    return *kp;
#else
    return P{};
#endif
}
__device__ __forceinline__ int opaque_tid() { int t = threadIdx.x; asm volatile("" : "+v"(t)); return t; }
__device__ __forceinline__ float bf2f(unsigned v) { return __uint_as_float(v << 16); }
__device__ __forceinline__ unsigned cvt_pk_bf16(float lo, float hi) { unsigned r; asm volatile("v_cvt_pk_bf16_f32 %0, %1, %2" : "=v"(r) : "v"(lo), "v"(hi)); return r; }
__device__ __forceinline__ bf16_t f2bf(float f) { return (bf16_t)(cvt_pk_bf16(f, 0.0f) & 0xffffu); }
__device__ __forceinline__ unsigned pack2(float lo, float hi) { return cvt_pk_bf16(lo, hi); }
__device__ __forceinline__ void unpack8(const u32x4 v, float* f) {
    f[0] = bf2f(v[0] & 0xffffu); f[1] = bf2f(v[0] >> 16); f[2] = bf2f(v[1] & 0xffffu); f[3] = bf2f(v[1] >> 16);
    f[4] = bf2f(v[2] & 0xffffu); f[5] = bf2f(v[2] >> 16); f[6] = bf2f(v[3] & 0xffffu); f[7] = bf2f(v[3] >> 16);
}
__device__ __forceinline__ f32x4 mfma16(bf16x8 a, bf16x8 b, f32x4 c) { return __builtin_amdgcn_mfma_f32_16x16x32_bf16(a, b, c, 0, 0, 0); }
__device__ __forceinline__ int t5_bucket(int d) {
    if (d < 16) return d;
    const float lr = logf((float)d / 16.0f) / 4.852030263919617f;
    int large = 16 + (int)(lr * 16.0f);
    return large < 31 ? large : 31;
}
__device__ __forceinline__ float gelu_tanh(float y) { const float t = 0.7978845608028654f * (y + 0.044715f * y * y * y);
    return y * __builtin_amdgcn_rcpf(1.0f + __expf(-2.0f * t)); }
__device__ __forceinline__ float log1p_small(float x) { return (x < 0.125f) ? x * (1.0f + x * (-0.5f + x * (0.33333334f + x * (-0.25f + x * (0.2f + x * (-0.16666667f + x * 0.14285715f)))))) : __logf(1.0f + x); }
__device__ __forceinline__ float sigmoidf_(float v) { return 1.0f / (1.0f + __expf(-v)); }

namespace pg8 {
constexpr int BM = 256, BK = 64, HALF = 128, HTB = HALF * BK * 2, STAGE_BYTES = 8 * HTB, NXCD = 8, WGM = 8;
__device__ __forceinline__ int lds_byte(int r, int c) { const int st = (r >> 4) * 2 + (c >> 5), rr = r & 15, cc = c & 31, ob = rr * 64 + cc * 2; return st * 1024 + (ob ^ (((ob >> 9) & 1) << 5)); }
__device__ __forceinline__ void stage_rc(int b, int& R, int& C) { const int st = b / 1024, sb = b % 1024, swz = sb ^ (((sb >> 9) & 1) << 5); R = (st >> 1) * 16 + swz / 64; C = (st & 1) * 32 + (swz % 64) / 2; }
__device__ __forceinline__ int perm32(int rho) { const int n = rho >> 4, i = rho & 15; return 8 * (i >> 2) + 4 * n + (i & 3); }

struct Seg { const char* A; const char* B; int nt, pm, pn, pass; };

__device__ __forceinline__ bool unit_of(int i, int G, int c, int nM, int nN, int& pm, int& pn) {
    const int nwg = nM * nN; const long L = (long)i * G + c; if (L >= nwg) return false;
    int wgid = (int)L; { const int q = nwg / NXCD, r = nwg % NXCD, xcd = wgid % NXCD, off = wgid / NXCD; wgid = (xcd < r ? xcd * (q + 1) : r * (q + 1) + (xcd - r) * q) + off; }
    const int nig = WGM * nN, gid = wgid / nig, fm = gid * WGM, gsz = (nM - fm) < WGM ? (nM - fm) : WGM;
    pm = fm + ((wgid % nig) % gsz); pn = (wgid % nig) / gsz; return true;
}
struct SchedPlain {
    const char* A; const char* B; unsigned lda2, ldb2; int nt, nM, nN, G, c;
    __device__ __forceinline__ bool get(int i, Seg& s) const {
        int pm, pn; if (!unit_of(i, G, c, nM, nN, pm, pn)) return false;
        s.A = A + (size_t)pm * 256 * lda2; s.B = B + (size_t)pn * 256 * ldb2; s.nt = nt; s.pm = pm; s.pn = pn; s.pass = 0; return true;
    }
};
struct SchedMerge {
    const char* z; const char* wb; unsigned lda2, ldb2; int nM, nN, G, c;
    __device__ __forceinline__ bool get(int i, Seg& s) const {
        const int u = i / 3, ps = i - 3 * u; int pm, pn; if (!unit_of(u, G, c, nM, nN, pm, pn)) return false;
        const char* zr = z + (size_t)pm * 256 * (DIN * 2); const char* br = wb + (size_t)pn * 256 * 4096;
        s.pm = pm; s.pn = pn; s.pass = ps;
        if (ps == 0) { s.A = zr + C_QA * 2; s.B = br; s.nt = 8; }
        else if (ps == 1) { s.A = zr + C_YR * 2; s.B = br + 512 * 2; s.nt = 16; }
        else { s.A = zr + C_QC * 2; s.B = br + 1536 * 2; s.nt = 8; }
        return true;
    }
};

struct EpiStoreBf16 {
    static constexpr bool PERM = true;
    bf16_t* O; int ldc; int sig_from; float mul;
    __device__ __forceinline__ bool after(f32x4 (&acc)[2][2][4][2], const Seg& u, int wr, int wc, int fr, int fq) const {
        if (u.pn >= sig_from) {
#pragma unroll
            for (int ai = 0; ai < 2; ++ai)
#pragma unroll
                for (int bj = 0; bj < 2; ++bj)
#pragma unroll
                    for (int m = 0; m < 4; ++m)
#pragma unroll
                        for (int n = 0; n < 2; ++n)
#pragma unroll
                            for (int e = 0; e < 4; ++e) acc[ai][bj][m][n][e] = 1.0f + __builtin_amdgcn_exp2f(-1.4426950408889634f * fmaxf(acc[ai][bj][m][n][e] * mul, -60.0f));
        }
        const unsigned loff = (unsigned)((wr * 64 + fr) * ldc + wc * 32 + 8 * fq) * 2u;
        char* ub = (char*)O + ((size_t)u.pm * BM * ldc + (size_t)u.pn * BM) * 2;
#pragma unroll
        for (int ai = 0; ai < 2; ++ai)
#pragma unroll
            for (int m = 0; m < 4; ++m) { char* rb = ub + (size_t)(ai * HALF + m * 16) * ldc * 2;
#pragma unroll
                for (int bj = 0; bj < 2; ++bj) { const f32x4 v0 = acc[ai][bj][m][0], v1 = acc[ai][bj][m][1];
                    u32x4 pk; pk[0] = cvt_pk_bf16(v0[0], v0[1]); pk[1] = cvt_pk_bf16(v0[2], v0[3]); pk[2] = cvt_pk_bf16(v1[0], v1[1]); pk[3] = cvt_pk_bf16(v1[2], v1[3]);
                    { const unsigned vo = loff + (unsigned)(bj * HALF * 2); asm volatile("global_store_dwordx4 %0, %1, %2 sc1\n\ts_nop 1" :: "v"(vo), "v"(pk), "s"(rb) : "memory"); } } }
        return true;
    }
};
struct EpiResid {
    static constexpr bool PERM = false;
    const float* xin; float* xout; const float* gate; int b0;
    __device__ __forceinline__ bool after(f32x4 (&acc)[2][2][4][2], const Seg& u, int wr, int wc, int fr, int fq) const {
        const unsigned loff = (unsigned)((wr * 64 + fr) * DM + wc * 32 + 4 * fq) * 4u;
        const size_t uo = ((size_t)u.pm * BM * DM + (size_t)u.pn * BM) * 4;
        const char* ib = (const char*)xin + uo; char* ob = (char*)xout + uo;
        const char* gp = (const char*)(gate + (size_t)(b0 + (u.pm * BM) / SEQ) * 6144 + u.pn * BM);
        const unsigned goff = (unsigned)(wc * 32 + 4 * fq) * 4u;
        f32x4 gv[2][2];
#pragma unroll
        for (int bj = 0; bj < 2; ++bj)
#pragma unroll
            for (int n = 0; n < 2; ++n) gv[bj][n] = *(const f32x4*)(gp + goff + (bj * HALF + n * 16) * 4);
#pragma unroll
        for (int ai = 0; ai < 2; ++ai)
#pragma unroll
          for (int mh = 0; mh < 2; ++mh) {
            f32x4 xv[2][2][2];
#pragma unroll
            for (int m2 = 0; m2 < 2; ++m2) { const char* irb = ib + (size_t)(ai * HALF + (mh * 2 + m2) * 16) * DM * 4;
#pragma unroll
                for (int bj = 0; bj < 2; ++bj)
#pragma unroll
                    for (int n = 0; n < 2; ++n) xv[m2][bj][n] = *(const f32x4*)(irb + loff + (bj * HALF + n * 16) * 4); }
            __builtin_amdgcn_sched_barrier(0);
#pragma unroll
            for (int m2 = 0; m2 < 2; ++m2) { char* orb = ob + (size_t)(ai * HALF + (mh * 2 + m2) * 16) * DM * 4;
#pragma unroll
                for (int bj = 0; bj < 2; ++bj)
#pragma unroll
                    for (int n = 0; n < 2; ++n) *(f32x4*)(orb + loff + (bj * HALF + n * 16) * 4) = xv[m2][bj][n] + gv[bj][n] * acc[ai][bj][mh * 2 + m2][n]; }
            __builtin_amdgcn_sched_barrier(0); }
        return true;
    }
};
struct EpiMerge {
    static constexpr bool PERM = true;
    const bf16_t* z; bf16_t* O;
    __device__ __forceinline__ bool after(f32x4 (&acc)[2][2][4][2], const Seg& u, int wr, int wc, int fr, int fq) const {
        const int ps = u.pass;
        const int gA = (ps == 2) ? 2 : ps, gB = (ps == 2) ? 2 : ps + 1;
        const unsigned zoff = (unsigned)((wr * 64 + fr) * DIN + wc * 32 + 8 * fq) * 2u, ooff = (unsigned)((wr * 64 + fr) * DM + wc * 32 + 8 * fq) * 2u;
        const char* zb = (const char*)z + ((size_t)u.pm * BM * DIN + C_G + (size_t)u.pn * BM) * 2;
        const char* zA = zb + (size_t)gA * 2048; const char* zB = zb + (size_t)gB * 2048;
        char* ob = (char*)O + ((size_t)u.pm * BM * DM + (size_t)u.pn * BM) * 2;
#pragma unroll
        for (int ai = 0; ai < 2; ++ai)
#pragma unroll
          for (int mh = 0; mh < 2; ++mh) {
            u32x4 la[2][2], lb[2][2];
#pragma unroll
            for (int m2 = 0; m2 < 2; ++m2) { const size_t rz = (size_t)(ai * HALF + (mh * 2 + m2) * 16) * DIN * 2;
#pragma unroll
                for (int bj = 0; bj < 2; ++bj) { la[m2][bj] = *(const u32x4*)(zA + rz + zoff + bj * HALF * 2); lb[m2][bj] = *(const u32x4*)(zB + rz + zoff + bj * HALF * 2); } }
            __builtin_amdgcn_sched_barrier(0);
#pragma unroll
            for (int m2 = 0; m2 < 2; ++m2) { const int m = mh * 2 + m2; const size_t rO = (size_t)(ai * HALF + m * 16) * DM * 2;
#pragma unroll
                for (int bj = 0; bj < 2; ++bj) {
                    float fa[8], fb[8]; unpack8(la[m2][bj], fa); unpack8(lb[m2][bj], fb);
                    float sc[8];
#pragma unroll
                    for (int e = 0; e < 8; ++e) sc[e] = ((ps == 2) ? 1.0f : fb[e]) * __builtin_amdgcn_rcpf(fa[e]);
                    f32x4 v0 = acc[ai][bj][m][0], v1 = acc[ai][bj][m][1];
                    v0[0] *= sc[0]; v0[1] *= sc[1]; v0[2] *= sc[2]; v0[3] *= sc[3]; v1[0] *= sc[4]; v1[1] *= sc[5]; v1[2] *= sc[6]; v1[3] *= sc[7];
                    acc[ai][bj][m][0] = v0; acc[ai][bj][m][1] = v1;
                    if (ps == 2) { u32x4 pk; pk[0] = cvt_pk_bf16(v0[0], v0[1]); pk[1] = cvt_pk_bf16(v0[2], v0[3]); pk[2] = cvt_pk_bf16(v1[0], v1[1]); pk[3] = cvt_pk_bf16(v1[2], v1[3]);
                        *(u32x4*)(ob + rO + ooff + bj * HALF * 2) = pk; } } }
            __builtin_amdgcn_sched_barrier(0); }
        return ps == 2;
    }
};

template <class Sched, class Epi, bool FP8 = false, bool ALIGN_EPI = true, bool SP2 = true>
__device__ __forceinline__ void gemm_phase(LAS unsigned char* lds, const Sched& S, const Epi& E) {
    const int tid = opaque_tid(), wid = __builtin_amdgcn_readfirstlane(tid >> 6), lane = tid & 63, wr = wid >> 2, wc = wid & 3, fr = lane & 15, fq = lane >> 4;
    const unsigned cla = S.lda2, clb = S.ldb2;
    unsigned RA[2], RB[2];
#pragma unroll
    for (int i = 0; i < 2; ++i) { int R, C; stage_rc(tid * 16 + i * 8192, R, C); const int Rb = Epi::PERM ? ((R & ~31) + perm32(R & 31)) : R;
        RA[i] = (unsigned)R * cla + (unsigned)C * 2u; RB[i] = (unsigned)Rb * clb + (unsigned)C * 2u; }
    const size_t kstep = (size_t)(BK * 2);
    const unsigned ldsw = (unsigned)wid * 1024u;
    unsigned ofs_slot = (unsigned)tid * 16u;
    if constexpr (FP8) { u32x4 o4; o4[0] = RA[0]; o4[1] = RA[1]; o4[2] = RB[0]; o4[3] = RB[1]; *(LAS u32x4*)(lds + STAGE_BYTES + ofs_slot) = o4; asm volatile("" : "+v"(ofs_slot)); }
    const int aoff = lds_byte(wr * 64 + fr, fq * 8), boff = lds_byte(wc * 32 + fr, fq * 8);
#define PG8_SA(b, h) (((b) * 2 + (h)) * HTB)
#define PG8_SB(b, h) ((4 + (b) * 2 + (h)) * HTB)
#define PG8_STG(bufoff, gbase, RR, ld2) do { if constexpr (FP8) {   \
            const u32x4 _o4 = *(const LAS u32x4*)(lds + STAGE_BYTES + ofs_slot); const bool _isB = (&(RR)[0] == &RB[0]); \
            _Pragma("unroll") for (int _i = 0; _i < 2; ++_i) \
            __builtin_amdgcn_global_load_lds((const unsigned*)((const char*)(gbase) + (_isB ? _o4[2 + _i] : _o4[_i])), (LAS unsigned*)(lds + (bufoff) + ldsw + _i * 8192), 16, 0, 0); } \
        else { _Pragma("unroll") for (int _i = 0; _i < 2; ++_i) \
        __builtin_amdgcn_global_load_lds((const unsigned*)((const char*)(gbase) + (RR)[_i]), (LAS unsigned*)(lds + (bufoff) + ldsw + _i * 8192), 16, 0, 0); } } while (0)
#define PG8_LDA(dst, b, h) do { if constexpr (FP8) { _Pragma("unroll") for (int m = 0; m < 4; ++m) { \
            const u32x4 _lo = *(const LAS u32x4*)(lds + PG8_SA(b, h) + aoff + m * 2048), _hi = *(const LAS u32x4*)(lds + PG8_SA(b, h) + aoff + m * 2048 + 1024); \
            dst##_8[m] = __builtin_shufflevector(_lo, _hi, 0, 1, 2, 3, 4, 5, 6, 7); } } \
        else { _Pragma("unroll") for (int m = 0; m < 4; ++m) _Pragma("unroll") for (int k = 0; k < 2; ++k) dst[m][k] = *(const LAS bf16x8*)(lds + PG8_SA(b, h) + aoff + m * 2048 + k * 1024); } } while (0)
#define PG8_LDB(dst, b, h) do { if constexpr (FP8) { _Pragma("unroll") for (int n = 0; n < 2; ++n) { \
            const u32x4 _lo = *(const LAS u32x4*)(lds + PG8_SB(b, h) + boff + n * 2048), _hi = *(const LAS u32x4*)(lds + PG8_SB(b, h) + boff + n * 2048 + 1024); \
            dst##_8[n] = __builtin_shufflevector(_lo, _hi, 0, 1, 2, 3, 4, 5, 6, 7); } } \
        else { _Pragma("unroll") for (int n = 0; n < 2; ++n) _Pragma("unroll") for (int k = 0; k < 2; ++k) dst[n][k] = *(const LAS bf16x8*)(lds + PG8_SB(b, h) + boff + n * 2048 + k * 1024); } } while (0)
#define PG8_MMA(ai, bj, At, Bt) do { __builtin_amdgcn_s_setprio(1); \
        if constexpr (FP8) { _Pragma("unroll") for (int m = 0; m < 4; ++m) _Pragma("unroll") for (int n = 0; n < 2; ++n) \
            acc[ai][bj][m][n] = __builtin_amdgcn_mfma_scale_f32_16x16x128_f8f6f4(__builtin_bit_cast(i32x8, Bt##_8[n]), __builtin_bit_cast(i32x8, At##_8[m]), acc[ai][bj][m][n], 0, 0, 0, 0x7f7f7f7f, 0, 0x7f7f7f7f); } \
        else { _Pragma("unroll") for (int m = 0; m < 4; ++m) _Pragma("unroll") for (int n = 0; n < 2; ++n) _Pragma("unroll") for (int k = 0; k < 2; ++k) \
            acc[ai][bj][m][n] = __builtin_amdgcn_mfma_f32_16x16x32_bf16(Bt[n][k], At[m][k], acc[ai][bj][m][n], 0, 0, 0); } \
        __builtin_amdgcn_s_setprio(0); } while (0)
#define PG8_WAIT_V(n) asm volatile("s_waitcnt vmcnt(" #n ")" ::: "memory")
#define PG8_WAIT_L(n) asm volatile("s_waitcnt lgkmcnt(" #n ")" ::: "memory")
#define PG8_BAR __builtin_amdgcn_s_barrier()
#define PG8_SCHED __builtin_amdgcn_sched_barrier(0)
    Seg cur, nxt; int si = 0;
    if (!S.get(0, cur)) return;
    f32x4 acc[2][2][4][2];
#pragma unroll
    for (int a = 0; a < 2; ++a)
#pragma unroll
        for (int b = 0; b < 2; ++b)
#pragma unroll
            for (int m = 0; m < 4; ++m)
#pragma unroll
                for (int n = 0; n < 2; ++n) acc[a][b][m][n] = (f32x4){0.f, 0.f, 0.f, 0.f};
    bf16x8 At[4][2], B0[2][2], B1[2][2];
    u32x8 At_8[4], B0_8[2], B1_8[2];
    const char* cA = cur.A; const char* cB = cur.B;
    if constexpr (SP2) {
        PG8_STG(PG8_SB(0, 0), cB, RB, clb); PG8_STG(PG8_SB(0, 1), cB + (size_t)HALF * clb, RB, clb); PG8_STG(PG8_SA(0, 0), cA, RA, cla); PG8_STG(PG8_SA(0, 1), cA + (size_t)HALF * cla, RA, cla);
        if (wr == 1) PG8_BAR;
        PG8_WAIT_V(2); PG8_BAR;
        PG8_STG(PG8_SB(1, 0), cB + kstep, RB, clb); PG8_STG(PG8_SA(1, 0), cA + kstep, RA, cla); PG8_STG(PG8_SB(1, 1), cB + (size_t)HALF * clb + kstep, RB, clb);
        PG8_WAIT_V(6); PG8_BAR;
    } else {
    PG8_STG(PG8_SB(0, 0), cB, RB, clb); PG8_STG(PG8_SA(0, 0), cA, RA, cla); PG8_STG(PG8_SB(0, 1), cB + (size_t)HALF * clb, RB, clb); PG8_STG(PG8_SA(0, 1), cA + (size_t)HALF * cla, RA, cla);
    if (wr == 1) PG8_BAR;
    PG8_WAIT_V(4); PG8_BAR;
    PG8_STG(PG8_SB(1, 0), cB + kstep, RB, clb); PG8_STG(PG8_SA(1, 0), cA + kstep, RA, cla); PG8_STG(PG8_SB(1, 1), cB + (size_t)HALF * clb + kstep, RB, clb);
    PG8_WAIT_V(6); PG8_BAR;
    }
    for (;;) {
        const bool has_next = S.get(si + 1, nxt);
        const char* nA = has_next ? nxt.A : cA; const char* nB = has_next ? nxt.B : cB;
        const int nt = cur.nt;
        for (int t = 0; t < nt; t += 2) {
            const bool last = (t == nt - 2);
            const char* a1 = cA + (size_t)(t + 1) * kstep;
            const char* a2 = last ? nA : cA + (size_t)(t + 2) * kstep; const char* b2 = last ? nB : cB + (size_t)(t + 2) * kstep;
            const unsigned la2 = cla, lb2 = clb;
            const char* a3 = a2 + kstep; const char* b3 = b2 + kstep;
            if constexpr (SP2) {
            PG8_LDB(B0, 0, 0); PG8_LDB(B1, 0, 1); PG8_SCHED; PG8_LDA(At, 0, 0); PG8_STG(PG8_SA(1, 1), a1 + (size_t)HALF * cla, RA, cla);
            PG8_WAIT_V(8); PG8_WAIT_L(0); PG8_BAR; PG8_MMA(0, 0, At, B0); PG8_MMA(0, 1, At, B1); PG8_BAR; PG8_SCHED;
            PG8_LDA(At, 0, 1); PG8_STG(PG8_SB(0, 0), b2, RB, lb2); PG8_STG(PG8_SB(0, 1), b2 + (size_t)HALF * lb2, RB, lb2); PG8_STG(PG8_SA(0, 0), a2, RA, la2);
            PG8_WAIT_V(8); PG8_WAIT_L(0); PG8_BAR; PG8_MMA(1, 0, At, B0); PG8_MMA(1, 1, At, B1); PG8_BAR; PG8_SCHED;
            PG8_LDB(B0, 1, 0); PG8_LDB(B1, 1, 1); PG8_SCHED; PG8_LDA(At, 1, 0); PG8_STG(PG8_SA(0, 1), a2 + (size_t)HALF * la2, RA, la2);
            PG8_WAIT_V(8); PG8_WAIT_L(0); PG8_BAR; PG8_MMA(0, 0, At, B0); PG8_MMA(0, 1, At, B1); PG8_BAR; PG8_SCHED;
            PG8_LDA(At, 1, 1); PG8_STG(PG8_SB(1, 0), b3, RB, lb2); PG8_STG(PG8_SB(1, 1), b3 + (size_t)HALF * lb2, RB, lb2); PG8_STG(PG8_SA(1, 0), a3, RA, la2);
            PG8_WAIT_V(8); PG8_WAIT_L(0); PG8_BAR; PG8_MMA(1, 0, At, B0); PG8_MMA(1, 1, At, B1); PG8_BAR; PG8_SCHED;
            } else {
            PG8_LDB(B0, 0, 0); PG8_SCHED; PG8_LDA(At, 0, 0); PG8_STG(PG8_SA(1, 1), a1 + (size_t)HALF * cla, RA, cla);
            PG8_WAIT_L(8); PG8_BAR; PG8_WAIT_L(0); PG8_MMA(0, 0, At, B0); PG8_BAR; PG8_SCHED;
            PG8_LDB(B1, 0, 1); PG8_STG(PG8_SB(0, 0), b2, RB, lb2);
            PG8_BAR; PG8_WAIT_L(0); PG8_MMA(0, 1, At, B1); PG8_BAR;
            PG8_LDA(At, 0, 1); PG8_STG(PG8_SA(0, 0), a2, RA, la2);
            PG8_BAR; PG8_WAIT_L(0); PG8_MMA(1, 0, At, B0); PG8_BAR; PG8_SCHED;
            PG8_STG(PG8_SB(0, 1), b2 + (size_t)HALF * lb2, RB, lb2);
            PG8_WAIT_V(6); PG8_BAR; PG8_MMA(1, 1, At, B1); PG8_BAR;
            PG8_LDB(B0, 1, 0); PG8_SCHED; PG8_LDA(At, 1, 0); PG8_STG(PG8_SA(0, 1), a2 + (size_t)HALF * la2, RA, la2);
            PG8_WAIT_L(8); PG8_BAR; PG8_WAIT_L(0); PG8_MMA(0, 0, At, B0); PG8_BAR; PG8_SCHED;
            PG8_LDB(B1, 1, 1); PG8_STG(PG8_SB(1, 0), b3, RB, lb2);
            PG8_BAR; PG8_WAIT_L(0); PG8_MMA(0, 1, At, B1); PG8_BAR;
            PG8_LDA(At, 1, 1); PG8_STG(PG8_SA(1, 0), a3, RA, la2);
            PG8_BAR; PG8_WAIT_L(0); PG8_MMA(1, 0, At, B0); PG8_BAR; PG8_SCHED;
            PG8_STG(PG8_SB(1, 1), b3 + (size_t)HALF * lb2, RB, lb2);
            PG8_WAIT_V(6); PG8_BAR; PG8_MMA(1, 1, At, B1); PG8_BAR;
            }
        }
        if constexpr (ALIGN_EPI) { if (wr == 0) PG8_BAR; }
        const bool done = E.after(acc, cur, wr, wc, fr, fq);
        if (!has_next) break;
        if (done) {
#pragma unroll
            for (int a = 0; a < 2; ++a)
#pragma unroll
                for (int b = 0; b < 2; ++b)
#pragma unroll
                    for (int m = 0; m < 4; ++m)
#pragma unroll
                        for (int n = 0; n < 2; ++n) acc[a][b][m][n] = (f32x4){0.f, 0.f, 0.f, 0.f};
        }
        cur = nxt; cA = nA; cB = nB; ++si;
        if constexpr (ALIGN_EPI) { if (wr == 1) PG8_BAR; }
    }
    PG8_WAIT_V(0);
    if constexpr (!ALIGN_EPI) { if (wr == 0) PG8_BAR; }
    PG8_BAR;
#undef PG8_SA
#undef PG8_SB
#undef PG8_STG
#undef PG8_LDA
#undef PG8_LDB
#undef PG8_MMA
#undef PG8_WAIT_V
#undef PG8_WAIT_L
#undef PG8_BAR
#undef PG8_SCHED
}
}

__device__ __forceinline__ void phase0(const P& p, LAS unsigned char* lds) {
    float* mod = (float*)(p.ws + WS_MOD);
    LAS float* sc = (LAS float*)lds;
    LAS float* red = sc + 4096;
    const int tid = opaque_tid();
    for (int i = tid; i < 4096; i += NTHREADS) { const float v = p.c[i]; sc[i] = v / (1.0f + __expf(-v)); }
    __syncthreads();
    const int cl = tid & 63, kg = tid >> 6;
    for (int item = blockIdx.x; item < DEPTH * 96; item += gridDim.x) {
        const int l = item / 96, j = (item % 96) * 64 + cl;
        const float* w = p.w_mod + (size_t)l * 1024 * 6144 + j;
        float a0 = 0.f, a1 = 0.f, a2 = 0.f, a3 = 0.f;
#pragma unroll 8
        for (int k = kg * 128; k < kg * 128 + 128; ++k) { const float wv = w[(size_t)k * 6144]; a0 += sc[k] * wv; a1 += sc[1024 + k] * wv; a2 += sc[2048 + k] * wv; a3 += sc[3072 + k] * wv; }
        red[(kg * 64 + cl) * 4 + 0] = a0; red[(kg * 64 + cl) * 4 + 1] = a1; red[(kg * 64 + cl) * 4 + 2] = a2; red[(kg * 64 + cl) * 4 + 3] = a3;
        __syncthreads();
        if (tid < 256) { const int b = tid >> 6, c2 = tid & 63; float s = 0.f;
#pragma unroll
            for (int g = 0; g < 8; ++g) s += red[(g * 64 + c2) * 4 + b];
            const int jj = (item % 96) * 64 + c2; mod[(size_t)(l * 4 + b) * 6144 + jj] = s + p.b_mod[l * 6144 + jj]; }
        __syncthreads();
    }
    float* biasA = (float*)(p.ws + WS_BIASA); float* biasC = (float*)(p.ws + WS_BIASC);
    if (blockIdx.x == gridDim.x - 1 && tid < DEPTH) {
        float biasmax = 0.f, ga = 0.f, gc = 0.f;
        for (int i = 0; i < 32 * 16; ++i) biasmax = fmaxf(biasmax, fabsf(p.rel_bias[i]));
        for (int d = 0; d < 64; ++d) { ga = fmaxf(ga, fabsf(p.qnorm_a[tid * 64 + d] * p.knorm_a[tid * 64 + d])); gc = fmaxf(gc, fabsf(p.qnorm_c[tid * 64 + d] * p.knorm_c[tid * 64 + d])); }
        float* mb = (float*)(p.ws + WS_MB); mb[tid * 2] = 8.0f * 1.03f * ga + biasmax; mb[tid * 2 + 1] = 8.0f * 1.03f * gc + biasmax; }
    for (int i = blockIdx.x * NTHREADS + tid; i < 8 * 8192; i += gridDim.x * NTHREADS) { const int h = i >> 13, d = i & 8191; biasC[i] = p.rel_bias[t5_bucket(d) * 16 + 8 + h]; }
    for (int i = blockIdx.x * NTHREADS + tid; i < 8 * 128; i += gridDim.x * NTHREADS) { const int h = i >> 7, d = i & 127; biasA[i] = p.rel_bias[t5_bucket(d) * 16 + h]; }
}

__device__ __forceinline__ void phase_norm(const float* xsrc, const float* gain, const float* mod_l, int shift_off, int scale_off, int b0, bf16_t* H, unsigned char* H8) {
    const int tid = opaque_tid(), wid = tid >> 6, lane = tid & 63;
    constexpr int RPW = TC / (256 * 8);
    const int wglob = blockIdx.x * 8 + wid, nw = gridDim.x * 8;
    for (int r0 = wglob * 4; r0 < TC; r0 += nw * 4) {
        f32x4 v[4][4]; float ss[4];
#pragma unroll
        for (int q = 0; q < 4; ++q) { const f32x4* xr = (const f32x4*)(xsrc + (size_t)(r0 + q) * DM);
#pragma unroll
            for (int i = 0; i < 4; ++i) v[q][i] = xr[lane + 64 * i]; }
#pragma unroll
        for (int q = 0; q < 4; ++q) { float a = 0.f;
#pragma unroll
            for (int i = 0; i < 4; ++i) a += v[q][i][0] * v[q][i][0] + v[q][i][1] * v[q][i][1] + v[q][i][2] * v[q][i][2] + v[q][i][3] * v[q][i][3];
            ss[q] = a; }
#pragma unroll
        for (int off = 32; off >= 1; off >>= 1) {
#pragma unroll
            for (int q = 0; q < 4; ++q) ss[q] += __shfl_xor(ss[q], off); }
        const float* mb = mod_l + (size_t)(b0 + r0 / SEQ) * 6144;
#pragma unroll
        for (int i = 0; i < 4; ++i) { const int col = (lane + 64 * i) * 4;
            const f32x4 g = *(const f32x4*)(gain + col), sc = *(const f32x4*)(mb + scale_off + col), sh = *(const f32x4*)(mb + shift_off + col);
#pragma unroll
            for (int q = 0; q < 4; ++q) { const float rinv = rsqrtf(ss[q] * (1.0f / 1024.0f) + RMS_EPS);
                float h[4];
#pragma unroll
                for (int e = 0; e < 4; ++e) h[e] = (v[q][i][e] * rinv * g[e]) * (1.0f + sc[e]) + sh[e];
                u32x2 pk; pk[0] = cvt_pk_bf16(h[0], h[1]); pk[1] = cvt_pk_bf16(h[2], h[3]);
                *(u32x2*)(H + (size_t)(r0 + q) * DM + col) = pk;
                if (H8) { unsigned p8 = 0u; p8 = __builtin_amdgcn_cvt_pk_fp8_f32(h[0], h[1], p8, false); p8 = __builtin_amdgcn_cvt_pk_fp8_f32(h[2], h[3], p8, true);
                    *(unsigned*)(H8 + (size_t)(r0 + q) * DM + col) = p8; } } }
    }
    (void)RPW;
}

__device__ __forceinline__ void phase_convert(const P& p, int l, LAS unsigned char* lds) {
    LAS float* t = (LAS float*)lds;
    constexpr int NJ = 8;
    const float* srcs[NJ] = { p.w_in + (size_t)l * 1024 * DIN, p.w_branch + (size_t)l * 2048 * 1024, p.w_out + (size_t)l * 1024 * 1024, p.w_up + (size_t)l * 1024 * DFF2,
        p.w_down + (size_t)l * DFF * 1024, p.ga_w + (size_t)l * 1024 * 64, p.gx_w + (size_t)l * 1024 * 64, p.w_in + (size_t)l * 1024 * DIN + C_G };
    const int Ks[NJ] = { 1024, 2048, 1024, 1024, DFF, 1024, 1024, 1024 };
    const int Ns[NJ] = { C_G, 1024, 1024, DFF2, 1024, 64, 64, 3072 };
    const int Ls[NJ] = { DIN, 1024, 1024, DFF2, 1024, 64, 64, DIN };
    const size_t dsts[NJ] = { WS_WIN, WS_WB, WS_WOUT, WS_WUP, WS_WDOWN, WS_GT, WS_GT + (size_t)64 * 1024 * 2, WS_WG8 };
    const int tid = opaque_tid();
    const int r = tid >> 4, c4 = (tid & 15) * 4, n = tid >> 3, kk = (tid & 7) * 8;
    int base = 0;
#pragma unroll
    for (int j = 0; j < NJ; ++j) {
        const int tn = Ns[j] / 64, ntile = (Ks[j] / 64) * tn;
        const float* src = srcs[j]; const int ldn = Ls[j], ldk = Ks[j]; bf16_t* dst = (bf16_t*)(p.ws + dsts[j]);
        int ti = (int)blockIdx.x - (base % (int)gridDim.x); if (ti < 0) ti += gridDim.x;
        f32x4 v0 = (f32x4){0.f, 0.f, 0.f, 0.f}, v1 = v0;
        if (ti < ntile) { const int kt = ti / tn, nn = ti - kt * tn; const float* sp = src + (size_t)(kt * 64 + r) * ldn + nn * 64 + c4; v0 = *(const f32x4*)sp; v1 = *(const f32x4*)(sp + (size_t)32 * ldn); }
        for (; ti < ntile; ti += gridDim.x) {
            const int kt = ti / tn, nn = ti - kt * tn;
            t[r * 65 + c4 + 0] = v0[0]; t[r * 65 + c4 + 1] = v0[1]; t[r * 65 + c4 + 2] = v0[2]; t[r * 65 + c4 + 3] = v0[3];
            t[(r + 32) * 65 + c4 + 0] = v1[0]; t[(r + 32) * 65 + c4 + 1] = v1[1]; t[(r + 32) * 65 + c4 + 2] = v1[2]; t[(r + 32) * 65 + c4 + 3] = v1[3];
            __syncthreads();
            const int tnx = ti + (int)gridDim.x;
            if (tnx < ntile) { const int kt2 = tnx / tn, nn2 = tnx - kt2 * tn; const float* sp = src + (size_t)(kt2 * 64 + r) * ldn + nn2 * 64 + c4; v0 = *(const f32x4*)sp; v1 = *(const f32x4*)(sp + (size_t)32 * ldn); }
            if (j == 7) { u32x2 p8; p8[0] = 0u; p8[1] = 0u;
#pragma unroll
                for (int q = 0; q < 2; ++q) { p8[q] = __builtin_amdgcn_cvt_pk_fp8_f32(t[(kk + 4 * q) * 65 + n] * 64.0f, t[(kk + 4 * q + 1) * 65 + n] * 64.0f, p8[q], false);
                    p8[q] = __builtin_amdgcn_cvt_pk_fp8_f32(t[(kk + 4 * q + 2) * 65 + n] * 64.0f, t[(kk + 4 * q + 3) * 65 + n] * 64.0f, p8[q], true); }
                *(u32x2*)((unsigned char*)dst + (size_t)(nn * 64 + n) * ldk + kt * 64 + kk) = p8; }
            else { u32x4 pk;
#pragma unroll
                for (int q = 0; q < 4; ++q) pk[q] = cvt_pk_bf16(t[(kk + 2 * q) * 65 + n], t[(kk + 2 * q + 1) * 65 + n]);
                *(u32x4*)(dst + (size_t)(nn * 64 + n) * ldk + kt * 64 + kk) = pk; }
            __syncthreads();
        }
        base += ntile;
    }
}

__device__ __forceinline__ void phase_qknorm(const P& p, int l, bf16_t* z) {
    const int tid = opaque_tid(), wid = tid >> 6, lane = tid & 63, g8 = lane & 7;
    float gqa[8], gka[8], gqc[8];
#pragma unroll
    for (int j = 0; j < 8; ++j) { gqa[j] = p.qnorm_a[l * 64 + g8 * 8 + j]; gka[j] = p.knorm_a[l * 64 + g8 * 8 + j]; gqc[j] = p.qnorm_c[l * 64 + g8 * 8 + j]; }
    for (int r0 = (blockIdx.x * 8 + wid) * 4; r0 < TC; r0 += gridDim.x * 8 * 4) {
        u32x4 raw[4][3];
#pragma unroll
        for (int q = 0; q < 4; ++q) { const bf16_t* rowp = z + (size_t)(r0 + q) * DIN;
            raw[q][0] = *(const u32x4*)(rowp + C_QA + lane * 8); raw[q][1] = *(const u32x4*)(rowp + C_KA + (lane & 15) * 8); raw[q][2] = *(const u32x4*)(rowp + C_QC + lane * 8); }
#pragma unroll
        for (int q = 0; q < 4; ++q) { bf16_t* rowp = z + (size_t)(r0 + q) * DIN;
#pragma unroll
            for (int it = 0; it < 3; ++it) {
                const int col = (it == 0) ? C_QA + lane * 8 : (it == 1) ? C_KA + (lane & 15) * 8 : C_QC + lane * 8;
                float f[8]; unpack8(raw[q][it], f);
                float ss = 0.f;
#pragma unroll
                for (int j = 0; j < 8; ++j) ss += f[j] * f[j];
                ss += __shfl_xor(ss, 1); ss += __shfl_xor(ss, 2); ss += __shfl_xor(ss, 4);
                const float rinv = rsqrtf(ss * (1.0f / 64.0f) + RMS_EPS);
                u32x4 pk;
#pragma unroll
                for (int j = 0; j < 4; ++j) { const float g0 = (it == 0) ? gqa[2 * j] : (it == 1) ? gka[2 * j] : gqc[2 * j], g1 = (it == 0) ? gqa[2 * j + 1] : (it == 1) ? gka[2 * j + 1] : gqc[2 * j + 1];
                    pk[j] = cvt_pk_bf16(f[2 * j] * rinv * g0, f[2 * j + 1] * rinv * g1); }
                if (it != 1 || lane < 16) *(u32x4*)(rowp + col) = pk;
            } }
    }
}
__device__ __forceinline__ void phase_kcnorm(const P& p, int l, bf16_t* z, LAS unsigned char* lds) {
    LAS float* red = (LAS float*)lds;
    LAS bf16_t* sT = (LAS bf16_t*)(lds + 16384);
    float* kmean = (float*)(p.ws + WS_KMEAN);
    const int tid = opaque_tid(), g8 = tid & 7, tg = tid >> 3;
    float gk[8];
#pragma unroll
    for (int j = 0; j < 8; ++j) gk[j] = p.knorm_c[l * 64 + g8 * 8 + j];
    for (int item = blockIdx.x; item < BPC * 8 * 32; item += gridDim.x) {
        const int m = item & 31, h = (item >> 5) & 7, bl = item >> 8;
        bf16_t* kbase = z + ((size_t)bl * SEQ + m * 256 + tg) * DIN + C_KC + h * 64 + g8 * 8;
        u32x4 kraw[4], vraw[4];
#pragma unroll
        for (int ps = 0; ps < 4; ++ps) kraw[ps] = *(const u32x4*)(kbase + (size_t)ps * 64 * DIN);
#pragma unroll
        for (int k = 0; k < 4; ++k) { const int i = tid + k * NTHREADS, kj = i >> 3, c8 = (i & 7) * 8;
            vraw[k] = *(const u32x4*)(z + ((size_t)bl * SEQ + m * 256 + kj) * DIN + C_VC + h * 64 + c8); }
        float ms[8];
#pragma unroll
        for (int j = 0; j < 8; ++j) ms[j] = 0.f;
#pragma unroll
        for (int ps = 0; ps < 4; ++ps) {
            float f[8]; unpack8(kraw[ps], f);
            float ss = 0.f;
#pragma unroll
            for (int j = 0; j < 8; ++j) ss += f[j] * f[j];
            ss += __shfl_xor(ss, 1); ss += __shfl_xor(ss, 2); ss += __shfl_xor(ss, 4);
            const float rinv = rsqrtf(ss * (1.0f / 64.0f) + RMS_EPS);
            float y[8];
#pragma unroll
            for (int j = 0; j < 8; ++j) { y[j] = f[j] * rinv * gk[j]; ms[j] += y[j]; }
            u32x4 pk;
#pragma unroll
            for (int j = 0; j < 4; ++j) pk[j] = cvt_pk_bf16(y[2 * j], y[2 * j + 1]);
            *(u32x4*)(kbase + (size_t)ps * 64 * DIN) = pk;
        }
#pragma unroll
        for (int j = 0; j < 8; ++j) red[tg * 64 + g8 * 8 + j] = ms[j];
#pragma unroll
        for (int k = 0; k < 4; ++k) { const int i = tid + k * NTHREADS, kj = i >> 3, c8 = (i & 7) * 8; *(LAS u32x4*)(sT + kj * 72 + c8) = vraw[k]; }
        __syncthreads();
        if (tid < 64) { float sm = 0.f; for (int g = 0; g < 64; ++g) sm += red[g * 64 + tid]; kmean[((size_t)(bl * 8 + h) * 32 + m) * 64 + tid] = sm * (1.0f / 256.0f); }
        {
            bf16_t* Vtg = (bf16_t*)(p.ws + WS_VTC) + (size_t)(bl * 8 + h) * 64 * SEQ;
            const int d = tid >> 3, tgp = tid & 7;
#pragma unroll
            for (int g = 0; g < 4; ++g) { const int t8 = tgp * 32 + g * 8; u32x4 pk;
#pragma unroll
                for (int j = 0; j < 4; ++j) pk[j] = (unsigned)sT[(t8 + 2 * j) * 72 + d] | ((unsigned)sT[(t8 + 2 * j + 1) * 72 + d] << 16);
                *(u32x4*)(Vtg + (size_t)d * SEQ + m * 256 + t8) = pk; }
        }
        __syncthreads();
    }
}

__device__ __forceinline__ void phase_rnn0(const P& p, int l, LAS unsigned char* lds, const bf16_t* z) {
    LAS float* sX = (LAS float*)lds;
    LAS float* sA = sX + 131 * 64 + 64;
    LAS float* sU = sA + 128 * 64;
    LAS float* sS = sU + 128 * 64;
    LAS bf16_t* sXb = (LAS bf16_t*)(sS + 8 * 64 * 2);
    LAS bf16_t* sGt = sXb + 128 * 72;
    float* rsum = (float*)(p.ws + WS_RSUM);
    const bf16_t* Gt = (const bf16_t*)(p.ws + WS_GT);
    bf16_t* OM = (bf16_t*)(p.ws + WS_ACT); bf16_t* UU = OM + (size_t)TC * 1024;
    const int tid = opaque_tid(), wid = tid >> 6, lane = tid & 63, fr = lane & 15, fq = lane >> 4;
    const int nbg = (int)gridDim.x >> 4;
    const int nb = blockIdx.x & 15, first = (int)blockIdx.x >> 4;
    if (first >= nbg) return;
    for (int i = tid; i < 2 * 64 * 8; i += NTHREADS) { const int g = i >> 9, d = (i >> 3) & 63, c8 = (i & 7) * 8;
        *(LAS u32x4*)(sGt + (g * 64 + d) * 72 + c8) = *(const u32x4*)(Gt + (size_t)g * 64 * 1024 + (size_t)d * 1024 + nb * 64 + c8); }
    const int ch = nb * 64 + lane;
    const float w0 = p.rnn_conv_w[(size_t)(l * 4 + 0) * 1024 + ch], w1 = p.rnn_conv_w[(size_t)(l * 4 + 1) * 1024 + ch], w2 = p.rnn_conv_w[(size_t)(l * 4 + 2) * 1024 + ch],
                w3 = p.rnn_conv_w[(size_t)(l * 4 + 3) * 1024 + ch], cb = p.rnn_conv_b[l * 1024 + ch];
    float bra[4], bix[4], spv[4];
#pragma unroll
    for (int nt = 0; nt < 4; ++nt) { const int chd = nb * 64 + nt * 16 + fr; bra[nt] = p.ga_b[l * 1024 + chd]; bix[nt] = p.gx_b[l * 1024 + chd];
        const float lamv = p.lam[l * 1024 + chd]; spv[nt] = (lamv > 15.f) ? __expf(-lamv) : log1p_small(__expf(-lamv)); }
    u32x4 xr[3];
#define RNN_PREFETCH(idx_) do { const int bl_ = (idx_) >> 6, t0_ = ((idx_) & 63) * 128; _Pragma("unroll") for (int k_ = 0; k_ < 3; ++k_) { const int i_ = tid + k_ * NTHREADS; const int rr_ = i_ >> 3, c8_ = (i_ & 7) * 8, t_ = t0_ - 3 + rr_; \
        xr[k_] = (u32x4){0u, 0u, 0u, 0u}; if (i_ < 131 * 8 && t_ >= 0) xr[k_] = *(const u32x4*)(z + ((size_t)bl_ * SEQ + t_) * DIN + C_XR + nb * 64 + c8_); } } while (0)
    RNN_PREFETCH(first);
    for (int idx = first; idx < BPC * 64; idx += nbg) {
        const int bl = idx >> 6, seg = idx & 63, t0 = seg * 128;
#pragma unroll
        for (int k = 0; k < 3; ++k) { const int i = tid + k * NTHREADS; if (i < 131 * 8) { const int rr = i >> 3, c8 = (i & 7) * 8; float f[8]; unpack8(xr[k], f);
            *(LAS f32x4*)(sX + rr * 64 + c8) = (f32x4){f[0], f[1], f[2], f[3]}; *(LAS f32x4*)(sX + rr * 64 + c8 + 4) = (f32x4){f[4], f[5], f[6], f[7]}; } }
        __syncthreads();
        if (idx + nbg < BPC * 64) RNN_PREFETCH(idx + nbg);
#pragma unroll
        for (int i = 0; i < 16; ++i) { const int tt = wid * 16 + i;
            const float xc = cb + w0 * sX[(tt + 0) * 64 + lane] + w1 * sX[(tt + 1) * 64 + lane] + w2 * sX[(tt + 2) * 64 + lane] + w3 * sX[(tt + 3) * 64 + lane];
            sXb[tt * 72 + lane] = f2bf(xc); }
        __syncthreads();
        { bf16x8 a[2];
#pragma unroll
          for (int ks = 0; ks < 2; ++ks) a[ks] = *(const LAS bf16x8*)(sXb + (16 * wid + fr) * 72 + ks * 32 + fq * 8);
#pragma unroll
          for (int nt = 0; nt < 4; ++nt) {
              f32x4 ar = (f32x4){0.f, 0.f, 0.f, 0.f}, ai = (f32x4){0.f, 0.f, 0.f, 0.f};
#pragma unroll
              for (int ks = 0; ks < 2; ++ks) {
                  const bf16x8 br = *(const LAS bf16x8*)(sGt + (nt * 16 + fr) * 72 + ks * 32 + fq * 8);
                  const bf16x8 bi = *(const LAS bf16x8*)(sGt + (64 + nt * 16 + fr) * 72 + ks * 32 + fq * 8);
                  ar = mfma16(a[ks], br, ar); ai = mfma16(a[ks], bi, ai); }
              const int d = nt * 16 + fr;
#pragma unroll
              for (int j = 0; j < 4; ++j) { const int tok = 16 * wid + 4 * fq + j;
                  const float r = __builtin_amdgcn_rcpf(1.0f + __expf(-(ar[j] + bra[nt]))), ig = __builtin_amdgcn_rcpf(1.0f + __expf(-(ai[j] + bix[nt])));
                  const float log_a = -8.0f * r * spv[nt]; const float av = __expf(log_a);
                  const float om2 = 1.0f - av * av;
                  float mult = __builtin_amdgcn_sqrtf(fmaxf(om2, 0.f));
                  if (t0 + tok == 0) mult = 1.0f;
                  sA[tok * 64 + d] = av; sU[tok * 64 + d] = mult * (ig * bf2f((unsigned)sXb[tok * 72 + d])); }
          } }
        __syncthreads();
        { float hl = 0.f, Pp = 1.f;
          const unsigned go0 = (unsigned)((bl * SEQ + t0 + wid * 16) * 1024 + ch);
#pragma unroll 4
          for (int i = 0; i < 16; ++i) { const int tt = wid * 16 + i;
              const bf16_t omb = f2bf(1.0f - sA[tt * 64 + lane]), ub = f2bf(sU[tt * 64 + lane]);
              const float av = 1.0f - bf2f((unsigned)omb), uv = bf2f((unsigned)ub);
              OM[go0 + (unsigned)i * 1024u] = omb; UU[go0 + (unsigned)i * 1024u] = ub;
              hl = av * hl + uv; Pp *= av; }
          sS[(wid * 64 + lane) * 2] = Pp; sS[(wid * 64 + lane) * 2 + 1] = hl; }
        __syncthreads();
        if (wid == 0) { float Pt = 1.f, Ht = 0.f;
#pragma unroll
            for (int w = 0; w < 8; ++w) { const float Pw = sS[(w * 64 + lane) * 2], Hw = sS[(w * 64 + lane) * 2 + 1]; Ht = Pw * Ht + Hw; Pt *= Pw; }
            float* o = rsum + ((size_t)(bl * 64 + seg) * 1024 + ch) * 2; o[0] = Pt; o[1] = Ht; }
    }
#undef RNN_PREFETCH
    __syncthreads();
}

__device__ __forceinline__ void phase_rnn_apply(const P& p, LAS unsigned char* lds, bf16_t* z) {
    LAS float* sS = (LAS float*)lds;
    LAS float* sC = sS + 8 * 64 * 2;
    const float* rsum = (const float*)(p.ws + WS_RSUM);
    const bf16_t* OM = (const bf16_t*)(p.ws + WS_ACT); const bf16_t* UU = OM + (size_t)TC * 1024;
    const int tid = opaque_tid(), wid = tid >> 6, lane = tid & 63;
    constexpr int N_RNN = BPC * 16 * 64;
    unsigned short ra[16], ru[16], ry[16]; float pp[8], hh[8];
#define RNN1_PREFETCH(j_) do { const int seg_ = (j_) & 63, nb_ = ((j_) >> 6) & 15, bl_ = (j_) >> 10; const int ch_ = nb_ * 64 + lane; const unsigned r_ = (unsigned)(bl_ * SEQ + seg_ * 128 + wid * 16); \
        _Pragma("unroll") for (int i_ = 0; i_ < 16; ++i_) { ra[i_] = OM[(r_ + i_) * 1024u + ch_]; ru[i_] = UU[(r_ + i_) * 1024u + ch_]; ry[i_] = z[(size_t)(r_ + i_) * DIN + C_YR + ch_]; } \
        _Pragma("unroll") for (int k_ = 0; k_ < 8; ++k_) { const int s2_ = wid * 8 + k_; pp[k_] = 1.f; hh[k_] = 0.f; \
            if (s2_ < seg_) { const float2 o_ = *(const float2*)(rsum + ((size_t)(bl_ * 64 + s2_) * 1024 + ch_) * 2); pp[k_] = o_.x; hh[k_] = o_.y; } } } while (0)
    int j = blockIdx.x;
    if (j < N_RNN) RNN1_PREFETCH(j);
    for (; j < N_RNN; j += gridDim.x) {
        const int seg = j & 63, nb = (j >> 6) & 15, bl = j >> 10; const int ch = nb * 64 + lane; const unsigned r0 = (unsigned)(bl * SEQ + seg * 128 + wid * 16);
        float a16[16], u16[16], y16[16];
#pragma unroll
        for (int i = 0; i < 16; ++i) { a16[i] = 1.0f - bf2f((unsigned)ra[i]); u16[i] = bf2f((unsigned)ru[i]); y16[i] = bf2f((unsigned)ry[i]); }
        { float Pw = 1.f, Hw = 0.f;
#pragma unroll
          for (int k = 0; k < 8; ++k) { Hw = pp[k] * Hw + hh[k]; Pw *= pp[k]; }
          sC[(wid * 64 + lane) * 2] = Pw; sC[(wid * 64 + lane) * 2 + 1] = Hw; }
        if (j + (int)gridDim.x < N_RNN) RNN1_PREFETCH(j + (int)gridDim.x);
        { float hl = 0.f, Pp = 1.f;
#pragma unroll
          for (int i = 0; i < 16; ++i) { hl = a16[i] * hl + u16[i]; Pp *= a16[i]; }
          sS[(wid * 64 + lane) * 2] = Pp; sS[(wid * 64 + lane) * 2 + 1] = hl; }
        __syncthreads();
        float h = 0.f;
#pragma unroll
        for (int w = 0; w < 8; ++w) h = sC[(w * 64 + lane) * 2] * h + sC[(w * 64 + lane) * 2 + 1];
        for (int w = 0; w < wid; ++w) h = sS[(w * 64 + lane) * 2] * h + sS[(w * 64 + lane) * 2 + 1];
#pragma unroll 4
        for (int i = 0; i < 16; ++i) { h = a16[i] * h + u16[i];
            z[(size_t)(r0 + i) * DIN + C_YR + ch] = f2bf(h * gelu_tanh(y16[i])); }
        __syncthreads();
    }
#undef RNN1_PREFETCH
}

__device__ __forceinline__ void swa_item(const P& p, int l, LAS unsigned char* lds, bf16_t* z, int bl, int kvh, int qb, float Mb) {
    LAS bf16_t* sK = (LAS bf16_t*)lds;
    LAS bf16_t* sVt = sK + 256 * 72;
    LAS float* sBA = (LAS float*)(lds + 70656);
    const float* biasA = (const float*)(p.ws + WS_BIASA);
    const int tid = opaque_tid(), wid = tid >> 6, lane = tid & 63, fr = lane & 15, fq = lane >> 4;
    const size_t rq0 = (size_t)bl * SEQ + (size_t)qb * 128;
    bf16x8 q[2][4];
#pragma unroll
    for (int i = 0; i < 2; ++i) { const int tile = wid + 8 * i, g = tile >> 2, q0 = (tile & 3) * 32;
        const bf16_t* qp = z + (rq0 + q0 + fr) * DIN + C_QA + (kvh * 4 + g) * 64 + fq * 8;
        q[i][0] = *(const bf16x8*)qp; q[i][1] = *(const bf16x8*)(qp + 32); q[i][2] = *(const bf16x8*)(qp + (size_t)16 * DIN); q[i][3] = *(const bf16x8*)(qp + (size_t)16 * DIN + 32); }
    for (int i = tid; i < 256 * 8; i += NTHREADS) { const int sj = i >> 3, c8 = (i & 7) * 8; const int tk = (qb - 1) * 128 + sj;
        u32x4 kv = (u32x4){0u, 0u, 0u, 0u}, vv = (u32x4){0u, 0u, 0u, 0u};
        if (tk >= 0) { const bf16_t* rowp = z + ((size_t)bl * SEQ + tk) * DIN; kv = *(const u32x4*)(rowp + C_KA + kvh * 64 + c8); vv = *(const u32x4*)(rowp + C_VA + kvh * 64 + c8); }
        *(LAS u32x4*)(sK + sj * 72 + c8) = kv;
#pragma unroll
        for (int j = 0; j < 4; ++j) { sVt[(c8 + 2 * j) * 264 + sj] = (bf16_t)(vv[j] & 0xffffu); sVt[(c8 + 2 * j + 1) * 264 + sj] = (bf16_t)(vv[j] >> 16); } }
    for (int i = tid; i < 4 * 384; i += NTHREADS) { const int g = i / 384, diff = i - g * 384 - 128; const int hq = kvh * 4 + g;
        const float Mh = fmaxf(Mb, p.sinks[l * 8 + hq]);
        sBA[i] = (diff >= 0 && diff < 128) ? (biasA[hq * 128 + diff] - Mh) * 1.4426950408889634f : -1.0e30f; }
    __syncthreads();
#pragma unroll
    for (int i = 0; i < 2; ++i) { const int tile = wid + 8 * i, g = tile >> 2, q0 = (tile & 3) * 32; const int hq = kvh * 4 + g;
        const LAS float* pbA = sBA + g * 384 + 128 + (q0 + fr + 128 - 4 * fq - 255); const LAS float* pbB = pbA + 16;
        float lsA = 0.f, lsB = 0.f;
        f32x4 oA[4], oB[4];
#pragma unroll
        for (int nd = 0; nd < 4; ++nd) { oA[nd] = (f32x4){0.f, 0.f, 0.f, 0.f}; oB[nd] = (f32x4){0.f, 0.f, 0.f, 0.f}; }
        int kq0 = (q0 + 1) >> 6; const int kq1 = ((q0 + 159) >> 6) + 1;
        if (qb == 0 && kq0 < 2) kq0 = 2;
        for (int kq = kq0; kq < kq1; ++kq) {
            unsigned pkA[4][2], pkB[4][2];
            const LAS float* pa = pbA - kq * 64; const LAS float* pb = pbB - kq * 64;
#pragma unroll
            for (int nt = 0; nt < 4; ++nt) {
                const LAS bf16_t* kp = sK + (kq * 64 + nt * 16 + fr) * 72 + fq * 8;
                const bf16x8 k0 = *(const LAS bf16x8*)kp, k1 = *(const LAS bf16x8*)(kp + 32);
                f32x4 aA = (f32x4){0.f, 0.f, 0.f, 0.f}, aB = (f32x4){0.f, 0.f, 0.f, 0.f};
                aA = mfma16(k0, q[i][0], aA); aB = mfma16(k0, q[i][2], aB); aA = mfma16(k1, q[i][1], aA); aB = mfma16(k1, q[i][3], aB);
                float pjA[4], pjB[4];
#pragma unroll
                for (int j = 0; j < 4; ++j) {
                    const float pvA = __builtin_amdgcn_exp2f(aA[j] * 0.18033688011112042f + pa[255 - nt * 16 - j]), pvB = __builtin_amdgcn_exp2f(aB[j] * 0.18033688011112042f + pb[255 - nt * 16 - j]);
                    lsA += pvA; lsB += pvB; pjA[j] = pvA; pjB[j] = pvB; }
                pkA[nt][0] = cvt_pk_bf16(pjA[0], pjA[1]); pkA[nt][1] = cvt_pk_bf16(pjA[2], pjA[3]);
                pkB[nt][0] = cvt_pk_bf16(pjB[0], pjB[1]); pkB[nt][1] = cvt_pk_bf16(pjB[2], pjB[3]); }
#pragma unroll
            for (int tt = 0; tt < 2; ++tt) {
                u32x4 bwA, bwB; bwA[0] = pkA[2 * tt][0]; bwA[1] = pkA[2 * tt][1]; bwA[2] = pkA[2 * tt + 1][0]; bwA[3] = pkA[2 * tt + 1][1];
                bwB[0] = pkB[2 * tt][0]; bwB[1] = pkB[2 * tt][1]; bwB[2] = pkB[2 * tt + 1][0]; bwB[3] = pkB[2 * tt + 1][1];
                const bf16x8 bfA = __builtin_bit_cast(bf16x8, bwA), bfB = __builtin_bit_cast(bf16x8, bwB);
#pragma unroll
                for (int nd = 0; nd < 4; ++nd) { const LAS bf16_t* vp = sVt + (nd * 16 + fr) * 264 + kq * 64 + 32 * tt + 4 * fq;
                    const u32x2 lo = *(const LAS u32x2*)vp, hi = *(const LAS u32x2*)(vp + 16);
                    u32x4 aw; aw[0] = lo[0]; aw[1] = lo[1]; aw[2] = hi[0]; aw[3] = hi[1];
                    const bf16x8 vf = __builtin_bit_cast(bf16x8, aw);
                    oA[nd] = mfma16(vf, bfA, oA[nd]); oB[nd] = mfma16(vf, bfB, oB[nd]); } }
        }
        lsA += __shfl_xor(lsA, 16); lsA += __shfl_xor(lsA, 32); lsB += __shfl_xor(lsB, 16); lsB += __shfl_xor(lsB, 32);
        const float sinkv = p.sinks[l * 8 + hq]; const float es = __expf(sinkv - fmaxf(Mb, sinkv));
        const float invA = 1.0f / (lsA + es), invB = 1.0f / (lsB + es);
        bf16_t* opA = z + (rq0 + q0 + fr) * DIN + C_QA + hq * 64 + 4 * fq; bf16_t* opB = opA + (size_t)16 * DIN;
#pragma unroll
        for (int nd = 0; nd < 4; ++nd) { u32x2 pa2, pb2; pa2[0] = cvt_pk_bf16(oA[nd][0] * invA, oA[nd][1] * invA); pa2[1] = cvt_pk_bf16(oA[nd][2] * invA, oA[nd][3] * invA);
            pb2[0] = cvt_pk_bf16(oB[nd][0] * invB, oB[nd][1] * invB); pb2[1] = cvt_pk_bf16(oB[nd][2] * invB, oB[nd][3] * invB);
            *(u32x2*)(opA + nd * 16) = pa2; *(u32x2*)(opB + nd * 16) = pb2; }
    }
    __syncthreads();
}

constexpr int N_MSUB = 52;
__device__ const unsigned short MOBA_SUB[N_MSUB] = {269, 270, 271, 517, 549, 272, 518, 550, 770, 802, 834, 273, 519, 551, 1024, 1056, 1088, 1120, 274, 771, 803, 835, 520, 552, 275, 1025, 1057, 1089, 1121, 521, 553, 276, 772, 804, 836, 522, 554, 277, 523, 555, 278, 524, 556, 279, 280, 281, 282, 283, 284, 285, 286, 287};
__device__ __forceinline__ void moba_gate_item(const P& p, LAS unsigned char* lds, const bf16_t* z, int bl, int h, int n) {
    LAS float* sKm = (LAS float*)lds;
    LAS int* sCnt = (LAS int*)(lds + 8192);
    int* CNT = (int*)(p.ws + WS_MCNT) + (bl * 8 + h) * 32;
    unsigned* LIST = (unsigned*)(p.ws + WS_MLIST) + (size_t)(bl * 8 + h) * 32 * LCAP;
    const float* kmean = (const float*)(p.ws + WS_KMEAN) + (size_t)(bl * 8 + h) * 32 * 64;
    const int tid = opaque_tid();
    if (tid < 64) sCnt[tid] = 0;
    for (int i = tid; i < n * 64; i += NTHREADS) sKm[i] = kmean[i];
    __syncthreads();
    int s0 = -1, s1 = -1, s2 = -1, p0 = 0, p1 = 0, p2 = 0;
    if (tid < 256) {
        float qv[64];
        const bf16_t* qp = z + ((size_t)bl * SEQ + (size_t)n * 256 + tid) * DIN + C_QC + h * 64;
#pragma unroll
        for (int c = 0; c < 8; ++c) { const u32x4 raw = *(const u32x4*)(qp + c * 8); unpack8(raw, qv + c * 8); }
        float v0 = -3.0e38f, v1 = -3.0e38f, v2 = -3.0e38f;
        for (int m = 0; m < n; ++m) { float g = 0.f;
#pragma unroll
            for (int d = 0; d < 64; ++d) g += qv[d] * sKm[m * 64 + d];
            if (g > v0) { v2 = v1; s2 = s1; v1 = v0; s1 = s0; v0 = g; s0 = m; }
            else if (g > v1) { v2 = v1; s2 = s1; v1 = g; s1 = m; }
            else if (g > v2) { v2 = g; s2 = m; } }
        if (s0 >= 0) p0 = atomicAdd((int*)(sCnt + s0), 1);
        if (s1 >= 0) p1 = atomicAdd((int*)(sCnt + s1), 1);
        if (s2 >= 0) p2 = atomicAdd((int*)(sCnt + s2), 1);
    }
    __syncthreads();
    if (tid < n) { const int c = sCnt[tid]; sCnt[32 + tid] = (c > 0) ? atomicAdd(CNT + tid, c) : 0; }
    __syncthreads();
    if (tid < 256) { const unsigned qpos = (unsigned)(n * 256 + tid);
        if (s0 >= 0) LIST[(size_t)s0 * LCAP + sCnt[32 + s0] + p0] = qpos;
        if (s1 >= 0) LIST[(size_t)s1 * LCAP + sCnt[32 + s1] + p1] = qpos | (1u << 16);
        if (s2 >= 0) LIST[(size_t)s2 * LCAP + sCnt[32 + s2] + p2] = qpos | (2u << 16); }
    __syncthreads();
}

template <bool OWN>
__device__ __forceinline__ void moba_tile(unsigned ecA, unsigned ecB, bool vA, bool vB, bf16x8 qA0, bf16x8 qA1, bf16x8 qB0, bf16x8 qB1, int kqn, int m, int bl, int h, float cb,
                                          const LAS bf16_t* sK, const LAS bf16_t* sVt, const LAS float* sB2, bf16_t* PART, float* LSUM, int fr, int fq) {
    const int qposA = (int)(ecA & 0xffffu), slotA = (int)(ecA >> 16), qposB = (int)(ecB & 0xffffu), slotB = (int)(ecB >> 16);
    const int dqfA = qposA - m * 256 - 4 * fq, dqfB = qposB - m * 256 - 4 * fq;
    const bool farb = !OWN && (__all(dqfA + 4 * fq - 255 >= 1513 && dqfB + 4 * fq - 255 >= 1513) != 0);
    const LAS float* pbA = sB2 + (272 + dqfA - 255); const LAS float* pbB = sB2 + (272 + dqfB - 255);
    float lsA = 0.f, lsB = 0.f;
    f32x4 oA[4], oB[4];
#pragma unroll
    for (int nd = 0; nd < 4; ++nd) { oA[nd] = (f32x4){0.f, 0.f, 0.f, 0.f}; oB[nd] = (f32x4){0.f, 0.f, 0.f, 0.f}; }
    for (int kq = 0; kq < kqn; ++kq) {
        unsigned pkA[4][2], pkB[4][2];
        const LAS float* pa = pbA - kq * 64; const LAS float* pb = pbB - kq * 64;
#pragma unroll
        for (int nt = 0; nt < 4; ++nt) {
            const LAS bf16_t* kp = sK + (kq * 64 + nt * 16 + fr) * 72 + fq * 8;
            const bf16x8 k0 = *(const LAS bf16x8*)kp, k1 = *(const LAS bf16x8*)(kp + 32);
            f32x4 aA = (f32x4){0.f, 0.f, 0.f, 0.f}, aB = (f32x4){0.f, 0.f, 0.f, 0.f};
            aA = mfma16(k0, qA0, aA); aB = mfma16(k0, qB0, aB); aA = mfma16(k1, qA1, aA); aB = mfma16(k1, qB1, aB);
            float pjA[4], pjB[4];
#pragma unroll
            for (int j = 0; j < 4; ++j) {
                const float b2A = farb ? cb : pa[255 - nt * 16 - j], b2B = farb ? cb : pb[255 - nt * 16 - j];
                float pvA = __builtin_amdgcn_exp2f(aA[j] * 0.18033688011112042f + b2A), pvB = __builtin_amdgcn_exp2f(aB[j] * 0.18033688011112042f + b2B);
                if (OWN) { if (dqfA - (kq * 64 + nt * 16 + j) < 0) pvA = 0.f; if (dqfB - (kq * 64 + nt * 16 + j) < 0) pvB = 0.f; }
                lsA += pvA; lsB += pvB; pjA[j] = pvA; pjB[j] = pvB; }
            pkA[nt][0] = cvt_pk_bf16(pjA[0], pjA[1]); pkA[nt][1] = cvt_pk_bf16(pjA[2], pjA[3]);
            pkB[nt][0] = cvt_pk_bf16(pjB[0], pjB[1]); pkB[nt][1] = cvt_pk_bf16(pjB[2], pjB[3]); }
#pragma unroll
        for (int tt = 0; tt < 2; ++tt) {
            u32x4 bwA, bwB; bwA[0] = pkA[2 * tt][0]; bwA[1] = pkA[2 * tt][1]; bwA[2] = pkA[2 * tt + 1][0]; bwA[3] = pkA[2 * tt + 1][1];
            bwB[0] = pkB[2 * tt][0]; bwB[1] = pkB[2 * tt][1]; bwB[2] = pkB[2 * tt + 1][0]; bwB[3] = pkB[2 * tt + 1][1];
            const bf16x8 bfA = __builtin_bit_cast(bf16x8, bwA), bfB = __builtin_bit_cast(bf16x8, bwB);
#pragma unroll
            for (int nd = 0; nd < 4; ++nd) { const LAS bf16_t* vp = sVt + (nd * 16 + fr) * 264 + kq * 64 + 32 * tt + 4 * fq;
                const u32x2 lo = *(const LAS u32x2*)vp, hi = *(const LAS u32x2*)(vp + 16);
                u32x4 aw; aw[0] = lo[0]; aw[1] = lo[1]; aw[2] = hi[0]; aw[3] = hi[1];
                const bf16x8 vf = __builtin_bit_cast(bf16x8, aw);
                oA[nd] = mfma16(vf, bfA, oA[nd]); oB[nd] = mfma16(vf, bfB, oB[nd]); } }
    }
    lsA += __shfl_xor(lsA, 16); lsA += __shfl_xor(lsA, 32); lsB += __shfl_xor(lsB, 16); lsB += __shfl_xor(lsB, 32);
    if (vA) { const size_t pi = (((size_t)bl * SEQ + qposA) * 8 + h) * 4 + slotA;
        if (fq == 0) LSUM[pi] = lsA;
#pragma unroll
        for (int nd = 0; nd < 4; ++nd) { u32x2 pk2; pk2[0] = cvt_pk_bf16(oA[nd][0], oA[nd][1]); pk2[1] = cvt_pk_bf16(oA[nd][2], oA[nd][3]);
            *(u32x2*)(PART + pi * 64 + nd * 16 + 4 * fq) = pk2; } }
    if (vB) { const size_t pi = (((size_t)bl * SEQ + qposB) * 8 + h) * 4 + slotB;
        if (fq == 0) LSUM[pi] = lsB;
#pragma unroll
        for (int nd = 0; nd < 4; ++nd) { u32x2 pk2; pk2[0] = cvt_pk_bf16(oB[nd][0], oB[nd][1]); pk2[1] = cvt_pk_bf16(oB[nd][2], oB[nd][3]);
            *(u32x2*)(PART + pi * 64 + nd * 16 + 4 * fq) = pk2; } }
}
__device__ __forceinline__ void moba_attn_item(const P& p, LAS unsigned char* lds, const bf16_t* z, int bl, int h, int m, int part, int parts, float M) {
    LAS bf16_t* sK = (LAS bf16_t*)lds;
    LAS bf16_t* sVt = sK + 256 * 72;
    LAS float* sB2 = (LAS float*)(lds + 70656);
    const int tid = opaque_tid(), wid = tid >> 6, lane = tid & 63, fr = lane & 15, fq = lane >> 4;
    const bf16_t* Vtg = (const bf16_t*)(p.ws + WS_VTC) + (size_t)(bl * 8 + h) * 64 * SEQ;
    const float* biasC = (const float*)(p.ws + WS_BIASC) + h * 8192;
    const unsigned* LIST = (const unsigned*)(p.ws + WS_MLIST) + ((size_t)(bl * 8 + h) * 32 + m) * LCAP;
    bf16_t* PART = (bf16_t*)(p.ws + WS_MPART); float* LSUM = (float*)(p.ws + WS_MLSUM);
    u32x4 kvr[4], vvr[4];
#pragma unroll
    for (int k = 0; k < 4; ++k) { const int i = tid + k * NTHREADS;
        kvr[k] = *(const u32x4*)(z + ((size_t)bl * SEQ + (size_t)m * 256 + (i >> 3)) * DIN + C_KC + h * 64 + (i & 7) * 8);
        vvr[k] = *(const u32x4*)(Vtg + (size_t)(i >> 5) * SEQ + m * 256 + (i & 31) * 8); }
    const int cnt = ((const int*)(p.ws + WS_MCNT))[(bl * 8 + h) * 32 + m];
    const int ntl = (cnt + 31) >> 5, ntot = ntl + 8;
    const int tlo = (part * ntot) / parts, thi = ((part + 1) * ntot) / parts;
#define MOBA_ENTRY1(ix_, e, v) do { v = (ix_) < cnt; e = LIST[(ix_) < cnt ? (ix_) : (cnt > 0 ? cnt - 1 : 0)]; } while (0)
#define MOBA_ENTRY(t, ea, va, eb, vb) do { if ((t) < ntl) { MOBA_ENTRY1((t) * 32 + fr, ea, va); MOBA_ENTRY1((t) * 32 + 16 + fr, eb, vb); } \
        else { va = vb = (t) < thi; ea = (unsigned)(m * 256 + (((t) - ntl) & 7) * 32 + fr) | (3u << 16); eb = ea + 16u; } } while (0)
#define MOBA_QGATHER(e, a0, a1) do { const bf16_t* qp_ = z + ((size_t)bl * SEQ + ((e) & 0xffffu)) * DIN + C_QC + h * 64 + fq * 8; a0 = *(const bf16x8*)qp_; a1 = *(const bf16x8*)(qp_ + 32); } while (0)
#define MOBA_KQN(t) ((((((t) - ntl) & 7) * 32 + 31) >> 6) + 1)
    int t = tlo + wid;
    unsigned e0a = 0u, e0b = 0u, e1a = 0u, e1b = 0u, e2a = 0u, e2b = 0u; bool v0a = false, v0b = false, v1a = false, v1b = false, v2a = false, v2b = false;
    bf16x8 qa0, qa1, qa2, qa3, qb0, qb1, qb2, qb3, qc0, qc1, qc2, qc3;
    MOBA_ENTRY(t, e0a, v0a, e0b, v0b); MOBA_ENTRY(t + 8, e1a, v1a, e1b, v1b); MOBA_ENTRY(t + 16, e2a, v2a, e2b, v2b);
    MOBA_QGATHER(e0a, qa0, qa1); MOBA_QGATHER(e0b, qa2, qa3); MOBA_QGATHER(e1a, qb0, qb1); MOBA_QGATHER(e1b, qb2, qb3);
    qc0 = qa0; qc1 = qa1; qc2 = qa2; qc3 = qa3;
#pragma unroll
    for (int k = 0; k < 4; ++k) { const int i = tid + k * NTHREADS;
        *(LAS u32x4*)(sK + (i >> 3) * 72 + (i & 7) * 8) = kvr[k]; *(LAS u32x4*)(sVt + (i >> 5) * 264 + (i & 31) * 8) = vvr[k]; }
    { const float* b2t = (const float*)(p.ws + WS_B2T) + h * (8192 + 272);
      for (int i = tid; i < (8192 + 272) / 4; i += NTHREADS) *(LAS f32x4*)(sB2 + 4 * i) = *(const f32x4*)(b2t + 4 * i); }
    __syncthreads();
    const float cb = sB2[272 + 8191];
#define MOBA_RUN(ea, eb, va, vb, q0, q1, q2, q3) do { if (t >= ntl) moba_tile<true>(ea, eb, (va) && t < thi, (vb) && t < thi, q0, q1, q2, q3, MOBA_KQN(t), m, bl, h, cb, sK, sVt, sB2, PART, LSUM, fr, fq); \
        else moba_tile<false>(ea, eb, (va) && t < thi, (vb) && t < thi, q0, q1, q2, q3, 4, m, bl, h, cb, sK, sVt, sB2, PART, LSUM, fr, fq); } while (0)
    for (;;) {
        if (t >= thi) break;
        { const unsigned ca = e0a, cbb = e0b; const bool wa = v0a, wb = v0b; MOBA_QGATHER(e2a, qc0, qc1); MOBA_QGATHER(e2b, qc2, qc3); MOBA_ENTRY(t + 24, e0a, v0a, e0b, v0b);
          MOBA_RUN(ca, cbb, wa, wb, qa0, qa1, qa2, qa3); t += 8; }
        if (t >= thi) break;
        { const unsigned ca = e1a, cbb = e1b; const bool wa = v1a, wb = v1b; MOBA_QGATHER(e0a, qa0, qa1); MOBA_QGATHER(e0b, qa2, qa3); MOBA_ENTRY(t + 24, e1a, v1a, e1b, v1b);
          MOBA_RUN(ca, cbb, wa, wb, qb0, qb1, qb2, qb3); t += 8; }
        if (t >= thi) break;
        { const unsigned ca = e2a, cbb = e2b; const bool wa = v2a, wb = v2b; MOBA_QGATHER(e1a, qb0, qb1); MOBA_QGATHER(e1b, qb2, qb3); MOBA_ENTRY(t + 24, e2a, v2a, e2b, v2b);
          MOBA_RUN(ca, cbb, wa, wb, qc0, qc1, qc2, qc3); t += 8; }
    }
#undef MOBA_ENTRY1
#undef MOBA_ENTRY
#undef MOBA_QGATHER
#undef MOBA_KQN
#undef MOBA_RUN
    __syncthreads();
}

__device__ __forceinline__ void phase_moba_combine(const P& p, bf16_t* z) {
    const bf16_t* PART = (const bf16_t*)(p.ws + WS_MPART); const float* LSUM = (const float*)(p.ws + WS_MLSUM);
    const int tid = opaque_tid(), wid = tid >> 6, lane = tid & 63, h = lane >> 3, d8 = (lane & 7) * 8;
    for (int r0 = (blockIdx.x * 8 + wid) * 2; r0 < TC; r0 += gridDim.x * 8 * 2) {
#pragma unroll
        for (int q = 0; q < 2; ++q) { const int r = r0 + q; const int n = (r % SEQ) >> 8; const int nsel = n < 3 ? n : 3;
            const size_t pi = ((size_t)r * 8 + h) * 4;
            float acc[8], lt = LSUM[pi + 3];
            unpack8(*(const u32x4*)(PART + (pi + 3) * 64 + d8), acc);
#pragma unroll
            for (int k = 0; k < 3; ++k) if (k < nsel) { float f[8]; unpack8(*(const u32x4*)(PART + (pi + k) * 64 + d8), f); lt += LSUM[pi + k];
#pragma unroll
                for (int j = 0; j < 8; ++j) acc[j] += f[j]; }
            const float inv = 1.0f / lt; u32x4 pk;
#pragma unroll
            for (int j = 0; j < 4; ++j) pk[j] = cvt_pk_bf16(acc[2 * j] * inv, acc[2 * j + 1] * inv);
            *(u32x4*)(z + (size_t)r * DIN + C_QC + h * 64 + d8) = pk; }
    }
}

__device__ __forceinline__ void phase_act(const P& p, int l, const bf16_t* u, bf16_t* act) {
    const int tid = opaque_tid();
    if (tid >= DFF / 8) return;
    const int c0 = tid * 8;
    float wg[3][8], wv[3][8], bg[8], bv[8];
#pragma unroll
    for (int k = 0; k < 3; ++k)
#pragma unroll
        for (int j = 0; j < 8; ++j) { wg[k][j] = p.ffn_conv_w[(size_t)(l * 3 + k) * DFF2 + c0 + j]; wv[k][j] = p.ffn_conv_w[(size_t)(l * 3 + k) * DFF2 + DFF + c0 + j]; }
#pragma unroll
    for (int j = 0; j < 8; ++j) { bg[j] = p.ffn_conv_b[(size_t)l * DFF2 + c0 + j]; bv[j] = p.ffn_conv_b[(size_t)l * DFF2 + DFF + c0 + j]; }
    for (int item = blockIdx.x; item < TC / 64; item += gridDim.x) {
        const int r0 = item * 64;
        float g1[8], g2[8], v1[8], v2[8];
        if ((r0 % SEQ) == 0) {
#pragma unroll
            for (int j = 0; j < 8; ++j) { g1[j] = 0.f; g2[j] = 0.f; v1[j] = 0.f; v2[j] = 0.f; }
        } else {
            unpack8(*(const u32x4*)(u + (size_t)(r0 - 1) * DFF2 + c0), g1); unpack8(*(const u32x4*)(u + (size_t)(r0 - 2) * DFF2 + c0), g2);
            unpack8(*(const u32x4*)(u + (size_t)(r0 - 1) * DFF2 + DFF + c0), v1); unpack8(*(const u32x4*)(u + (size_t)(r0 - 2) * DFF2 + DFF + c0), v2);
        }
        for (int i0 = 0; i0 < 64; i0 += 8) {
            u32x4 rg[8], rv[8];
#pragma unroll
            for (int i = 0; i < 8; ++i) { const size_t r = (size_t)(r0 + i0 + i); rg[i] = *(const u32x4*)(u + r * DFF2 + c0); rv[i] = *(const u32x4*)(u + r * DFF2 + DFF + c0); }
#pragma unroll
            for (int i = 0; i < 8; ++i) { const size_t r = (size_t)(r0 + i0 + i);
                float g0[8], v0[8]; unpack8(rg[i], g0); unpack8(rv[i], v0);
                float o[8];
#pragma unroll
                for (int j = 0; j < 8; ++j) { const float cgv = bg[j] + wg[0][j] * g2[j] + wg[1][j] * g1[j] + wg[2][j] * g0[j]; const float cvv = bv[j] + wv[0][j] * v2[j] + wv[1][j] * v1[j] + wv[2][j] * v0[j];
                    o[j] = (cgv * __builtin_amdgcn_rcpf(1.0f + __expf(-cgv))) * cvv; g2[j] = g1[j]; g1[j] = g0[j]; v2[j] = v1[j]; v1[j] = v0[j]; }
                u32x4 pk;
#pragma unroll
                for (int j = 0; j < 4; ++j) pk[j] = pack2(o[2 * j], o[2 * j + 1]);
                *(u32x4*)(act + r * DFF + c0) = pk; }
        }
    }
}

#ifndef PHASE_MASK
#define PHASE_MASK 0xFFFFF
#endif
#define PH(k) ((PHASE_MASK >> (k)) & 1)
#ifndef REP_GRP
#define REP_GRP 0
#endif
#ifndef REP_P2
#define REP_P2 0
#endif
#ifndef REP_P8
#define REP_P8 0
#endif
#ifndef REP_MISC
#define REP_MISC 0
#endif
#ifndef DRY_MOBA
#define DRY_MOBA 0
#endif
#ifndef DRY_SWA
#define DRY_SWA 0
#endif
#ifndef DRY_RNN
#define DRY_RNN 0
#endif

#define XB_TMO      128
#define XB_XCNT(j)  (256  + 64 * (j))
#define XB_XSUB(j)  (1280 + 64 * (j))
#define XB_XGEN(j)  (2304 + 64 * (j))
#define XB_TOP      3328
#define XB_TOPGEN   3392
#define XCD_BAR_WORDS 3456
#define XB_SPIN_CAP (1u << 18)
__device__ __forceinline__ unsigned xb_ld(unsigned* p)              { return __hip_atomic_load(p, __ATOMIC_RELAXED, __HIP_MEMORY_SCOPE_AGENT); }
__device__ __forceinline__ unsigned xb_add(unsigned* p, unsigned v) { return __hip_atomic_fetch_add(p, v, __ATOMIC_RELAXED, __HIP_MEMORY_SCOPE_AGENT); }
__device__ __forceinline__ unsigned xb_xcc_id() { return (unsigned)__builtin_amdgcn_s_getreg((3 << 11) | 20) & 0xFu; }
#define XB_SPIN(cond, bar) do { unsigned _sp = 0; while (cond) { __builtin_amdgcn_s_sleep(1); \
    if ((++_sp & 255u) == 0u) { if (xb_ld(&(bar)[XB_TMO])) break; if (_sp > XB_SPIN_CAP) { atomicAdd(&(bar)[XB_TMO], 1u); break; } } } } while (0)
struct XcdBarrier { unsigned* bar; unsigned x; volatile LAS unsigned* st; };
__device__ __forceinline__ XcdBarrier xcd_barrier_post(unsigned* bar, volatile LAS unsigned* st) {
    XcdBarrier b; b.bar = bar; b.x = xb_xcc_id(); b.st = st;
    if (threadIdx.x == 0) (void)xb_add(&bar[XB_XCNT(b.x)], 1u);
    return b;
}
__device__ __forceinline__ void xcd_barrier_complete(unsigned* bar, unsigned x, unsigned& nloc, unsigned& nx) {
    const unsigned G = gridDim.x * gridDim.y * gridDim.z;
    unsigned sum, cnt, mine, sp = 0u;
    for (;;) {
        sum = 0u; cnt = 0u; mine = 0u;
#pragma unroll
        for (unsigned j = 0; j < 16; ++j) { const unsigned c = xb_ld(&bar[XB_XCNT(j)]); sum += c; cnt += (c > 0u) ? 1u : 0u; mine = (j == x) ? c : mine; }
        if (sum == G) break;
        __builtin_amdgcn_s_sleep(1);
        if ((++sp & 255u) == 0u) { if (xb_ld(&bar[XB_TMO])) break; if (sp > XB_SPIN_CAP) { atomicAdd(&bar[XB_TMO], 1u); break; } }
    }
    nloc = mine > 0u ? mine : 1u; nx = cnt > 0u ? cnt : 1u;
}
__device__ __forceinline__ void xcd_barrier(const XcdBarrier& b) {
    asm volatile("s_waitcnt vmcnt(0)" ::: "memory");
    __syncthreads();
    if (opaque_tid() == 0) {
        unsigned* bar = b.bar;
        __builtin_amdgcn_s_waitcnt(0);
        unsigned nloc = b.st[0], nx = b.st[1];
        if (nloc == 0u) { xcd_barrier_complete(bar, b.x, nloc, nx); b.st[0] = nloc; b.st[1] = nx; }
        const unsigned old = xb_add(&bar[XB_XSUB(b.x)], 1u);
        const unsigned gen = old / nloc;
        if (old + 1u == (gen + 1u) * nloc) {
            __builtin_amdgcn_fence(__ATOMIC_RELEASE, "agent");
            asm volatile("s_waitcnt vmcnt(0)" ::: "memory");
            const unsigned og = xb_add(&bar[XB_TOP], 1u);
            const unsigned tg = og / nx;
            if (og + 1u == (tg + 1u) * nx) xb_add(&bar[XB_TOPGEN], 1u);
            else XB_SPIN(xb_ld(&bar[XB_TOPGEN]) == tg, bar);
            __builtin_amdgcn_fence(__ATOMIC_ACQUIRE, "agent");
            xb_add(&bar[XB_XGEN(b.x)], 1u);
            asm volatile("s_waitcnt vmcnt(0)" ::: "memory");
        } else {
            XB_SPIN(xb_ld(&bar[XB_XGEN(b.x)]) == gen, bar);
            __builtin_amdgcn_fence(__ATOMIC_ACQUIRE, "agent");
            asm volatile("s_waitcnt vmcnt(0)" ::: "memory");
        }
    }
    __syncthreads();
}
#ifndef REP_SYNC
#define REP_SYNC 0
#endif
#define GSYNC() do { for (int _r = 0; _r < 1 + REP_SYNC; ++_r) xcd_barrier(xbar); } while (0)
__global__ void __launch_bounds__(NTHREADS, 2) fwd_megakernel(P p_arg) {
    extern __shared__ __attribute__((aligned(16))) unsigned char lds_raw[];
    LAS unsigned char* lds = (LAS unsigned char*)lds_raw;
    cg::grid_group grid = cg::this_grid();
    const int G = gridDim.x, bx = blockIdx.x;
#define RELOAD const P p = load_params(); const float* mod_l = (const float*)(p.ws + WS_MOD) + (size_t)l * NB * 6144; bf16_t* Hb = (bf16_t*)(p.ws + WS_H); bf16_t* Zb = (bf16_t*)(p.ws + WS_Z); bf16_t* ACTb = (bf16_t*)(p.ws + WS_ACT); \
    const float* xin = ((l == 0) ? p.x : p.out) + (size_t)ch * TC * DM; float* xout = p.out + (size_t)ch * TC * DM; (void)mod_l; (void)Hb; (void)Zb; (void)ACTb; (void)xin; (void)xout;

    { LAS unsigned* st = (LAS unsigned*)(lds + LDS_BYTES - 16); if (threadIdx.x == 0) { st[0] = 0u; st[1] = 0u; } __syncthreads(); }
    const XcdBarrier xbar = xcd_barrier_post((unsigned*)(p_arg.ws + WS_BAR), (volatile LAS unsigned*)(lds + LDS_BYTES - 16));
    if (PH(0)) { const P p = load_params(); phase0(p, lds); }
    grid.sync();

    for (int l = 0; l < DEPTH; ++l) {
        for (int ch = 0; ch < NCHUNK; ++ch) {
            const int b0 = ch * BPC;
            for (int rep3 = 0; rep3 < 1 + REP_MISC; ++rep3) { RELOAD
            if (PH(1)) if (ch == 0) phase_convert(p, l, lds);
            if (ch == 0) { const int gi = bx * NTHREADS + opaque_tid();
                if (gi < 8 * (8192 + 272)) { const int hh = gi / (8192 + 272), ii = gi - hh * (8192 + 272); const int dist = ii - 272;
                    ((float*)(p.ws + WS_B2T))[gi] = (((const float*)(p.ws + WS_BIASC))[hh * 8192 + (dist < 0 ? 0 : dist)] - ((const float*)(p.ws + WS_MB))[l * 2 + 1]) * 1.4426950408889634f; } }
            if (PH(2)) phase_norm(xin, p.norm_mix + l * DM, mod_l, 0, 1024, b0, Hb, p.ws + WS_H8); }
            GSYNC();
            for (int rep = 0; rep < 1 + REP_GRP; ++rep) {
            for (int rep2 = 0; rep2 < 1 + REP_P2; ++rep2) {
            if (PH(3)) { RELOAD
              { pg8::SchedPlain S{(const char*)Hb, (const char*)(p.ws + WS_WIN), DM * 2, DM * 2, DM / 64, TC / 256, C_G / 256, G, bx};
                pg8::EpiStoreBf16 E{Zb, DIN, 1 << 30, 1.0f};
                pg8::gemm_phase(lds, S, E); }
              {
                pg8::SchedPlain S{(const char*)(p.ws + WS_H8), (const char*)(p.ws + WS_WG8), DM, DM, DM / 128, TC / 256, (DIN - C_G) / 256, G, bx};
                pg8::EpiStoreBf16 E{Zb + C_G, DIN, 0, 1.0f / 64.0f};
                pg8::gemm_phase<pg8::SchedPlain, pg8::EpiStoreBf16, true>(lds, S, E); } }
            GSYNC();
            }
            { RELOAD
            if (PH(4)) phase_qknorm(p, l, Zb);
            if (PH(5)) phase_kcnorm(p, l, Zb, lds);
            if (bx == 0) { const int t_ = opaque_tid(); if (t_ < BPC * 8 * 32) ((int*)(p.ws + WS_MCNT))[t_] = 0; if (t_ == 0) *((int*)(p.ws + WS_MQ)) = 0; }
            if (PH(6)) phase_rnn0(p, l, lds, Zb); }
            GSYNC();
            { RELOAD
              for (int it = bx; it < BPC * 8 * 31; it += G) { const int n = 31 - it / (BPC * 8), h = it & 7, bl = (it >> 3) & 1; moba_gate_item(p, lds, Zb, bl, h, n); } }
            GSYNC();
            { RELOAD constexpr int N_MOBA = BPC * 8 * 32, N_SWA = BPC * 8 * 64, N_RNN = BPC * 16 * 64;
              const float Mb_a = ((const float*)(p.ws + WS_MB))[l * 2], Mb_c = ((const float*)(p.ws + WS_MB))[l * 2 + 1];
              for (int j = bx; j < BPC * 2 * 64; j += G) { if (PH(8)) { const int qb = j & 63, kvh = (j >> 6) & 1, bl = j >> 7; swa_item(p, l, lds, Zb, bl, kvh, qb, Mb_a); } }
              if (PH(9)) phase_rnn_apply(p, lds, Zb);
              if (PH(7)) {
                  int* qhead = (int*)(p.ws + WS_MQ); LAS int* sQ = (LAS int*)(lds + LDS_BYTES - 32);
                  for (;;) {
                      if (opaque_tid() == 0) *sQ = __hip_atomic_fetch_add(qhead, 1, __ATOMIC_RELAXED, __HIP_MEMORY_SCOPE_AGENT);
                      __syncthreads();
                      const int i = *sQ;
                      __syncthreads();
                      if (i >= N_MSUB * BPC * 8) break;
                      const unsigned sv = MOBA_SUB[i >> 4]; const int h = i & 7, bl = (i >> 3) & 1;
                      moba_attn_item(p, lds, Zb, bl, h, (int)(sv & 31u), (int)((sv >> 5) & 7u), (int)(sv >> 8), Mb_c); } } }
            GSYNC();
            { RELOAD phase_moba_combine(p, Zb); }
            GSYNC();
            }
            if (PH(10)) { RELOAD pg8::SchedMerge S{(const char*)Zb, (const char*)(p.ws + WS_WB), DIN * 2, 2048 * 2, TC / 256, DM / 256, G, bx};
              pg8::EpiMerge E{Zb, Hb};
              pg8::gemm_phase(lds, S, E); }
            GSYNC();
            if (PH(11)) { RELOAD pg8::SchedPlain S{(const char*)Hb, (const char*)(p.ws + WS_WOUT), DM * 2, DM * 2, DM / 64, TC / 256, DM / 256, G, bx};
              pg8::EpiResid E{xin, xout, mod_l + 2048, b0};
              pg8::gemm_phase(lds, S, E); }
            GSYNC();
            for (int rep3 = 0; rep3 < 1 + REP_MISC; ++rep3) if (PH(12)) { RELOAD phase_norm(xout, p.norm_ffn + l * DM, mod_l, 3072, 4096, b0, Hb, nullptr); }
            GSYNC();
            for (int rep2 = 0; rep2 < 1 + REP_P8; ++rep2) {
            if (PH(13)) { RELOAD pg8::SchedPlain S{(const char*)Hb, (const char*)(p.ws + WS_WUP), DM * 2, DM * 2, DM / 64, TC / 256, DFF2 / 256, G, bx};
              pg8::EpiStoreBf16 E{Zb, DFF2, 1 << 30, 1.0f};
              pg8::gemm_phase(lds, S, E); }
            GSYNC();
            }
            for (int rep3 = 0; rep3 < 1 + REP_MISC; ++rep3) if (PH(14)) { RELOAD phase_act(p, l, Zb, ACTb); }
            GSYNC();
            if (PH(15)) { RELOAD pg8::SchedPlain S{(const char*)ACTb, (const char*)(p.ws + WS_WDOWN), DFF * 2, DFF * 2, DFF / 64, TC / 256, DM / 256, G, bx};
              pg8::EpiResid E{xout, xout, mod_l + 5120, b0};
              pg8::gemm_phase(lds, S, E); }
            GSYNC();
        }
    }
}

extern "C" void kernel_launch(void* const* d_in, const int* in_sizes, int n_in, void* d_out, int out_size, void* d_ws, size_t ws_size, hipStream_t stream) {
    static int grid = 0;
    if (grid == 0) {
        if (n_in != 26 || ws_size < WS_END) { fprintf(stderr, "kernel_launch: need 26 inputs and >= %zu bytes of workspace (got %d, %zu)\n", (size_t)WS_END, n_in, ws_size); grid = -1; return; }
        int dev = 0, cus = 0, per_cu = 0;
        (void)hipGetDevice(&dev);
        (void)hipDeviceGetAttribute(&cus, hipDeviceAttributeMultiprocessorCount, dev);
        if (hipFuncSetAttribute((const void*)fwd_megakernel, hipFuncAttributeMaxDynamicSharedMemorySize, LDS_BYTES) != hipSuccess) { fprintf(stderr, "kernel_launch: hipFuncSetAttribute failed\n"); grid = -1; return; }
        if (hipOccupancyMaxActiveBlocksPerMultiprocessor(&per_cu, (const void*)fwd_megakernel, NTHREADS, LDS_BYTES) != hipSuccess || per_cu < 1) { fprintf(stderr, "kernel_launch: occupancy query gives %d\n", per_cu); per_cu = 1; (void)hipGetLastError(); }
        grid = cus * per_cu;
        fprintf(stderr, "kernel_launch: grid %d (cus %d x %d)\n", grid, cus, per_cu);
    }
    if (grid < 0) return;
    P prm{};
    const float** pp = (const float**)&prm;
    for (int i = 0; i < 26; ++i) pp[i] = (const float*)d_in[i];
    prm.out = (float*)d_out; prm.ws = (unsigned char*)d_ws;
    if (hipMemsetAsync((char*)d_ws + WS_BAR, 0, 3456 * 4, stream) != hipSuccess) { fprintf(stderr, "kernel_launch: memset of barrier words failed\n"); return; }
    void* args[] = {&prm};
    hipError_t e = hipLaunchCooperativeKernel((const void*)fwd_megakernel, dim3(grid), dim3(NTHREADS), args, LDS_BYTES, stream);
    if (e != hipSuccess) fprintf(stderr, "kernel_launch: cooperative launch failed: %s (grid %d)\n", hipGetErrorString(e), grid);
}
```
